# Optimizing an MI355X kernel written in HIP

```python
import math
import jax, jax.numpy as jnp
from jax import lax
import numpy as np

D_MODEL = 1024
BATCH = 16
SEQ = 2048
DEPTH = 1

NSA_HEADS = 8
NSA_KV_GROUPS = 2
NSA_HEADS_PER_GROUP = NSA_HEADS // NSA_KV_GROUPS
HEAD_DIM = 64
NSA_Q_WIDTH = NSA_HEADS * HEAD_DIM
NSA_KV_WIDTH = NSA_KV_GROUPS * HEAD_DIM
CMP_BLOCK = 32
CMP_STRIDE = 16
CMP_HIDDEN = 2 * HEAD_DIM
SEL_BLOCK = 64
SEL_TOPN = 8
SEL_QBLOCK = 64
WINDOW = 256
WIN_QBLOCK = 128
ATTN_SCALE = HEAD_DIM ** -0.5

MLSTM_HEADS = 4
MLSTM_HEAD_DIM = 128
MLSTM_WIDTH = MLSTM_HEADS * MLSTM_HEAD_DIM
MLSTM_CHUNK = 128
CONV_WIDTH = 4

N_EXPERTS = 32
TOP_K = 4
D_EXPERT = D_MODEL
SWIGLU_LIMIT = 7.0
SWIGLU_ALPHA = 1.702
MOE_BLOCK = 256

RMS_EPS = 1e-5
LN_EPS = 1e-5

IN_SIZES = (NSA_Q_WIDTH, 6 * NSA_KV_WIDTH, 3 * NSA_HEADS, MLSTM_WIDTH, MLSTM_WIDTH, 2 * MLSTM_HEADS, 2 * D_MODEL)
IN_WIDTH = sum(IN_SIZES)
IN_SPLITS = [int(v) for v in np.cumsum(IN_SIZES)[:-1]]

kernel_name = 'hybrid_nsa_mlstm_moe_block'


def rms_norm(x, g):
    xf = x.astype(jnp.float32)
    y = xf * lax.rsqrt(jnp.mean(xf * xf, axis=-1, keepdims=True) + RMS_EPS)
    return (y * g.astype(jnp.float32)).astype(x.dtype)


def alibi_slopes(n_heads):
    return jnp.asarray(2.0 ** (-8.0 * np.arange(1, n_heads + 1) / n_heads), jnp.float32)


def masked_softmax(s, mask):
    s = jnp.where(mask, s, -jnp.inf)
    m = jnp.max(s, axis=-1, keepdims=True)
    m = jnp.where(jnp.isfinite(m), m, 0.0)
    p = jnp.where(mask, jnp.exp(s - m), 0.0)
    return p / jnp.maximum(jnp.sum(p, axis=-1, keepdims=True), 1e-30)


def compress_blocks(kv, pe, w1, w2):
    S = kv.shape[1]
    n_cmp = (S - CMP_BLOCK) // CMP_STRIDE + 1
    idx = np.arange(n_cmp)[:, None] * CMP_STRIDE + np.arange(CMP_BLOCK)[None, :]
    blocks = kv[:, idx] + pe[None, None, :, None, :]
    hid = jax.nn.gelu(jnp.einsum('bnlgd,lde->bnge', blocks, w1))
    return jnp.einsum('bnge,ed->bngd', hid, w2)


def compressed_branch(qg, kc, vc, slopes):
    S = qg.shape[1]
    n_cmp = kc.shape[1]
    t = np.arange(S)[:, None]
    start = np.arange(n_cmp)[None, :] * CMP_STRIDE
    mask = (start + CMP_BLOCK - 1) <= t
    dist = (t - start - (CMP_BLOCK - 1) / 2.0).astype(np.float32)
    s = jnp.einsum('bsghd,bngd->bghsn', qg, kc).astype(jnp.float32) * ATTN_SCALE
    s = s - slopes[None, :, :, None, None] * dist
    p = masked_softmax(s, mask)
    o = jnp.einsum('bghsn,bngd->bsghd', p.astype(vc.dtype), vc)
    return o, p


def selection_overlap(n_cmp, n_slc):
    cs = np.arange(n_cmp)[:, None] * CMP_STRIDE
    ss = np.arange(n_slc)[None, :] * SEL_BLOCK
    ov = np.clip(np.minimum(cs + CMP_BLOCK, ss + SEL_BLOCK) - np.maximum(cs, ss), 0, None)
    return jnp.asarray(ov / CMP_BLOCK, jnp.float32)


def selected_branch(qg, k_slc, v_slc, p_cmp, slopes):
    B, S, G, HPG, dh = qg.shape
    n_slc = S // SEL_BLOCK
    n_cmp = p_cmp.shape[-1]
    top_n = min(SEL_TOPN, n_slc)
    score = jnp.einsum('bghsn,nj->bgsj', p_cmp, selection_overlap(n_cmp, n_slc))
    t = np.arange(S)
    cur = t // SEL_BLOCK
    j = np.arange(n_slc)[None, :]
    forced = (j == cur[:, None]) | (j == 0)
    future = j > cur[:, None]
    score = jnp.where(forced, jnp.inf, jnp.where(future, -jnp.inf, score))
    _, idx = lax.top_k(score, top_n)
    valid = idx <= jnp.asarray(cur)[:, None]
    kb = k_slc.reshape(B, n_slc, SEL_BLOCK, G, dh).transpose(0, 3, 1, 2, 4)
    vb = v_slc.reshape(B, n_slc, SEL_BLOCK, G, dh).transpose(0, 3, 1, 2, 4)
    nq = S // SEL_QBLOCK

    def to_chunks(a, axis):
        shp = a.shape
        a = a.reshape(shp[:axis] + (nq, SEL_QBLOCK) + shp[axis + 1:])
        return jnp.moveaxis(a, axis, 0)

    q_c = to_chunks(qg, 1)
    idx_c = to_chunks(idx, 2)
    val_c = to_chunks(valid, 2)
    t_c = jnp.arange(S, dtype=jnp.int32).reshape(nq, SEL_QBLOCK)
    gather = jax.vmap(jax.vmap(lambda blocks, ix: blocks[ix]))
    offs = jnp.arange(SEL_BLOCK, dtype=jnp.int32)
    flat = (B, G, HPG, SEL_QBLOCK, top_n * SEL_BLOCK)

    def one_chunk(args):
        qc, ic, vc_, tc = args
        kg = gather(kb, ic)
        vg = gather(vb, ic)
        dist = tc[None, None, :, None, None] - (ic[..., None] * SEL_BLOCK + offs)
        mask = vc_[..., None] & (dist >= 0)
        s = jnp.einsum('bqghd,bgqnld->bghqnl', qc, kg).astype(jnp.float32) * ATTN_SCALE
        s = s - slopes[None, :, :, None, None, None] * dist[:, :, None].astype(jnp.float32)
        m6 = jnp.broadcast_to(mask[:, :, None], s.shape)
        p = masked_softmax(s.reshape(flat), m6.reshape(flat)).reshape(s.shape)
        return jnp.einsum('bghqnl,bgqnld->bqghd', p.astype(vg.dtype), vg)

    o = lax.map(one_chunk, (q_c, idx_c, val_c, t_c))
    return jnp.moveaxis(o, 0, 1).reshape(B, S, G, HPG, dh)


def window_branch(qg, k_win, v_win, slopes):
    B, S, G, HPG, dh = qg.shape
    nb = S // WIN_QBLOCK
    span = WINDOW + WIN_QBLOCK
    pad = ((0, 0), (WINDOW, 0), (0, 0), (0, 0))
    kp = jnp.pad(k_win, pad)
    vp = jnp.pad(v_win, pad)
    idx = np.arange(nb)[:, None] * WIN_QBLOCK + np.arange(span)[None, :]
    kb = kp[:, idx]
    vb = vp[:, idx]
    qb = qg.reshape(B, nb, WIN_QBLOCK, G, HPG, dh)
    qpos = np.arange(WIN_QBLOCK)[:, None]
    kpos = np.arange(span)[None, :]
    dist = qpos - kpos + WINDOW
    kabs = np.arange(nb)[:, None, None] * WIN_QBLOCK - WINDOW + kpos[None]
    mask = (dist >= 0) & (dist < WINDOW) & (kabs >= 0)
    s = jnp.einsum('biqghd,bikgd->bghiqk', qb, kb).astype(jnp.float32) * ATTN_SCALE
    s = s - slopes[None, :, :, None, None, None] * dist.astype(np.float32)
    p = masked_softmax(s, mask)
    o = jnp.einsum('bghiqk,bikgd->biqghd', p.astype(vb.dtype), vb)
    return o.reshape(B, S, G, HPG, dh)


def mlstm_branch(x_m, i_pre, f_pre, o_pre, conv_w, conv_b, wq, wk, wv, f_bias, norm_g):
    B, S, C = x_m.shape
    H, dh = MLSTM_HEADS, MLSTM_HEAD_DIM
    xc = lax.conv_general_dilated(x_m, conv_w[:, None, :], window_strides=(1,), padding=[(CONV_WIDTH - 1, 0)],
                                  dimension_numbers=('NWC', 'WIO', 'NWC'), feature_group_count=C)
    xc = jax.nn.silu(xc + conv_b)
    xch = xc.reshape(B, S, H, dh)
    xmh = x_m.reshape(B, S, H, dh)
    q = jnp.einsum('bshd,hde->bhse', xch, wq).astype(jnp.float32)
    k = jnp.einsum('bshd,hde->bhse', xch, wk).astype(jnp.float32) / math.sqrt(dh)
    v = jnp.einsum('bshd,hde->bhse', xmh, wv).astype(jnp.float32)
    ig = i_pre.astype(jnp.float32).transpose(0, 2, 1)
    lf = jax.nn.log_sigmoid((f_pre + f_bias).astype(jnp.float32)).transpose(0, 2, 1)
    L = MLSTM_CHUNK
    nc = S // L

    def chunks(a):
        a = a.reshape(a.shape[:2] + (nc, L) + a.shape[3:])
        return jnp.moveaxis(a, 2, 0)

    causal = np.tril(np.ones((L, L), dtype=bool))

    def step(carry, inp):
        Cm, nm, mm = carry
        qc, kc, vc, ic, fc = inp
        F = jnp.cumsum(fc, axis=-1)
        logD = jnp.where(causal, F[..., :, None] - F[..., None, :] + ic[..., None, :], -jnp.inf)
        inter = F + mm[..., None]
        m_t = jnp.maximum(inter, jnp.max(logD, axis=-1))
        Dm = jnp.exp(logD - m_t[..., None])
        wi = jnp.exp(inter - m_t)
        qk = jnp.einsum('bhtd,bhsd->bhts', qc, kc) * Dm
        num = wi[..., None] * jnp.einsum('bhtd,bhde->bhte', qc, Cm) + jnp.einsum('bhts,bhse->bhte', qk, vc)
        den = wi * jnp.einsum('bhtd,bhd->bht', qc, nm) + jnp.sum(qk, axis=-1)
        h = num / jnp.maximum(jnp.abs(den), jnp.exp(-m_t))[..., None]
        FL = F[..., -1]
        logw = FL[..., None] - F + ic
        m_new = jnp.maximum(FL + mm, jnp.max(logw, axis=-1))
        decay = jnp.exp(FL + mm - m_new)
        w = jnp.exp(logw - m_new[..., None])
        C_new = decay[..., None, None] * Cm + jnp.einsum('bhs,bhsd,bhse->bhde', w, kc, vc)
        n_new = decay[..., None] * nm + jnp.einsum('bhs,bhsd->bhd', w, kc)
        return (C_new, n_new, m_new), h

    init = (jnp.zeros((B, H, dh, dh), jnp.float32), jnp.zeros((B, H, dh), jnp.float32), jnp.zeros((B, H), jnp.float32))
    _, hs = lax.scan(step, init, (chunks(q), chunks(k), chunks(v), chunks(ig), chunks(lf)))
    h = jnp.moveaxis(hs, 0, 2).reshape(B, H, S, dh).transpose(0, 2, 1, 3)
    mu = jnp.mean(h, axis=-1, keepdims=True)
    var = jnp.mean(jnp.square(h - mu), axis=-1, keepdims=True)
    hn = ((h - mu) * lax.rsqrt(var + LN_EPS)).reshape(B, S, C) * norm_g.astype(jnp.float32)
    return (jax.nn.sigmoid(o_pre.astype(jnp.float32)) * hn).astype(x_m.dtype)


def moe_ffn(h, router_w, router_b, w_up, b_up, w_down, b_down):
    B, S, D = h.shape
    T = B * S
    R = T * TOP_K
    xt = h.reshape(T, D)
    logits = (xt @ router_w + router_b).astype(jnp.float32)
    top_v, top_e = lax.top_k(logits, TOP_K)
    wts = jax.nn.softmax(top_v, axis=-1)
    e_flat = top_e.reshape(R)
    onehot = jax.nn.one_hot(e_flat, N_EXPERTS, dtype=jnp.int32)
    rank = jnp.sum((jnp.cumsum(onehot, axis=0) - 1) * onehot, axis=-1)
    counts = jnp.sum(onehot, axis=0)
    padded = (counts + MOE_BLOCK - 1) // MOE_BLOCK * MOE_BLOCK
    pends = jnp.cumsum(padded)
    dest = (pends - padded)[e_flat] + rank
    n_blocks = (R + N_EXPERTS * (MOE_BLOCK - 1) + MOE_BLOCK - 1) // MOE_BLOCK
    P = n_blocks * MOE_BLOCK
    xpad = jnp.zeros((P, D), h.dtype).at[dest].set(jnp.repeat(xt, TOP_K, axis=0))
    block_start = jnp.arange(n_blocks, dtype=jnp.int32) * MOE_BLOCK
    block_e = jnp.minimum(jnp.searchsorted(pends, block_start, side='right'), N_EXPERTS - 1)

    def expert_block(args):
        xb, e = args
        gu = xb @ w_up[e] + b_up[e]
        g, lin = jnp.split(gu, 2, axis=-1)
        g = jnp.minimum(g, SWIGLU_LIMIT)
        lin = jnp.clip(lin, -SWIGLU_LIMIT, SWIGLU_LIMIT)
        a = g * jax.nn.sigmoid(SWIGLU_ALPHA * g) * (lin + 1.0)
        return a @ w_down[e] + b_down[e]

    ypad = lax.map(expert_block, (xpad.reshape(n_blocks, MOE_BLOCK, D), block_e)).reshape(P, D)
    y_rows = ypad[dest].reshape(T, TOP_K, D)
    out = jnp.einsum('tk,tkd->td', wts.astype(y_rows.dtype), y_rows)
    return out.reshape(B, S, D)


def hybrid_layer(x, c, ada_w, ada_b, norm1_g, w_in, b_in, cmp_pe_k, cmp_w1_k, cmp_w2_k, cmp_pe_v, cmp_w1_v, cmp_w2_v,
                 ml_conv_w, ml_conv_b, ml_wq, ml_wk, ml_wv, ml_f_bias, ml_norm_g, proj_a, proj_b, w_out, norm2_g,
                 router_w, router_b, exp_w_up, exp_b_up, exp_w_down, exp_b_down):
    B, S, D = x.shape
    G, HPG = NSA_KV_GROUPS, NSA_HEADS_PER_GROUP
    mod = jax.nn.silu(c) @ ada_w + ada_b
    shift1, scale1, gate1, shift2, scale2, gate2 = jnp.split(mod[:, None, :], 6, axis=-1)
    h = rms_norm(x, norm1_g) * (1.0 + scale1) + shift1
    proj = h @ w_in + b_in
    q, kv, g_nsa, x_m, o_pre, if_pre, g_merge = jnp.split(proj, IN_SPLITS, axis=-1)
    qg = q.reshape(B, S, G, HPG, HEAD_DIM)
    k_cmp, v_cmp, k_slc, v_slc, k_win, v_win = [a.reshape(B, S, G, HEAD_DIM) for a in jnp.split(kv, 6, axis=-1)]
    slopes = alibi_slopes(NSA_HEADS).reshape(G, HPG)
    kc = compress_blocks(k_cmp, cmp_pe_k, cmp_w1_k, cmp_w2_k)
    vc = compress_blocks(v_cmp, cmp_pe_v, cmp_w1_v, cmp_w2_v)
    o_cmp, p_cmp = compressed_branch(qg, kc, vc, slopes)
    o_slc = selected_branch(qg, k_slc, v_slc, p_cmp, slopes)
    o_win = window_branch(qg, k_win, v_win, slopes)
    bg = jax.nn.sigmoid(g_nsa).reshape(B, S, 3, G, HPG, 1)
    o_nsa = (bg[:, :, 0] * o_cmp + bg[:, :, 1] * o_slc + bg[:, :, 2] * o_win).reshape(B, S, NSA_Q_WIDTH)
    i_pre, f_pre = jnp.split(if_pre, 2, axis=-1)
    y_ml = mlstm_branch(x_m, i_pre, f_pre, o_pre, ml_conv_w, ml_conv_b, ml_wq, ml_wk, ml_wv, ml_f_bias, ml_norm_g)
    g_a, g_b = jnp.split(jax.nn.sigmoid(g_merge), 2, axis=-1)
    mixed = (g_a * (o_nsa @ proj_a) + g_b * (y_ml @ proj_b)) @ w_out
    x = x + gate1 * mixed
    h2 = rms_norm(x, norm2_g) * (1.0 + scale2) + shift2
    x = x + gate2 * moe_ffn(h2, router_w, router_b, exp_w_up, exp_b_up, exp_w_down, exp_b_down)
    return x


def setup_inputs(seed: int = 0) -> dict:
    key = jax.random.key(seed)
    keys = iter(jax.random.split(key, 40))

    def nrm(shape, scale):
        return jax.random.normal(next(keys), shape, jnp.float32) * scale

    L, D = DEPTH, D_MODEL
    return {
        'x': nrm((BATCH, SEQ, D), 1.0),
        'c': nrm((BATCH, D), 1.0),
        'ada_w': nrm((L, D, 6 * D), 0.5 * D ** -0.5),
        'ada_b': nrm((L, 6 * D), 0.02),
        'norm1_g': 1.0 + nrm((L, D), 0.05),
        'w_in': nrm((L, D, IN_WIDTH), D ** -0.5),
        'b_in': nrm((L, IN_WIDTH), 0.02),
        'cmp_pe_k': nrm((L, CMP_BLOCK, HEAD_DIM), 0.02),
        'cmp_w1_k': nrm((L, CMP_BLOCK, HEAD_DIM, CMP_HIDDEN), (CMP_BLOCK * HEAD_DIM) ** -0.5),
        'cmp_w2_k': nrm((L, CMP_HIDDEN, HEAD_DIM), CMP_HIDDEN ** -0.5),
        'cmp_pe_v': nrm((L, CMP_BLOCK, HEAD_DIM), 0.02),
        'cmp_w1_v': nrm((L, CMP_BLOCK, HEAD_DIM, CMP_HIDDEN), (CMP_BLOCK * HEAD_DIM) ** -0.5),
        'cmp_w2_v': nrm((L, CMP_HIDDEN, HEAD_DIM), CMP_HIDDEN ** -0.5),
        'ml_conv_w': nrm((L, CONV_WIDTH, MLSTM_WIDTH), CONV_WIDTH ** -0.5),
        'ml_conv_b': nrm((L, MLSTM_WIDTH), 0.02),
        'ml_wq': nrm((L, MLSTM_HEADS, MLSTM_HEAD_DIM, MLSTM_HEAD_DIM), MLSTM_HEAD_DIM ** -0.5),
        'ml_wk': nrm((L, MLSTM_HEADS, MLSTM_HEAD_DIM, MLSTM_HEAD_DIM), MLSTM_HEAD_DIM ** -0.5),
        'ml_wv': nrm((L, MLSTM_HEADS, MLSTM_HEAD_DIM, MLSTM_HEAD_DIM), MLSTM_HEAD_DIM ** -0.5),
        'ml_f_bias': jnp.linspace(3.0, 6.0, MLSTM_HEADS, dtype=jnp.float32)[None, :] + nrm((L, MLSTM_HEADS), 0.1),
        'ml_norm_g': 1.0 + nrm((L, MLSTM_WIDTH), 0.05),
        'proj_a': nrm((L, NSA_Q_WIDTH, D), NSA_Q_WIDTH ** -0.5),
        'proj_b': nrm((L, MLSTM_WIDTH, D), MLSTM_WIDTH ** -0.5),
        'w_out': nrm((L, D, D), D ** -0.5),
        'norm2_g': 1.0 + nrm((L, D), 0.05),
        'router_w': nrm((L, D, N_EXPERTS), D ** -0.5),
        'router_b': nrm((L, N_EXPERTS), 0.01),
        'exp_w_up': nrm((L, N_EXPERTS, D, 2 * D_EXPERT), D ** -0.5),
        'exp_b_up': nrm((L, N_EXPERTS, 2 * D_EXPERT), 0.02),
        'exp_w_down': nrm((L, N_EXPERTS, D_EXPERT, D), D_EXPERT ** -0.5),
        'exp_b_down': nrm((L, N_EXPERTS, D), 0.02),
        'final_g': 1.0 + nrm((D,), 0.05),
    }


def reference(x, c, ada_w, ada_b, norm1_g, w_in, b_in, cmp_pe_k, cmp_w1_k, cmp_w2_k, cmp_pe_v, cmp_w1_v, cmp_w2_v,
              ml_conv_w, ml_conv_b, ml_wq, ml_wk, ml_wv, ml_f_bias, ml_norm_g, proj_a, proj_b, w_out, norm2_g,
              router_w, router_b, exp_w_up, exp_b_up, exp_w_down, exp_b_down, final_g):
    for l in range(DEPTH):
        x = hybrid_layer(x, c, ada_w[l], ada_b[l], norm1_g[l], w_in[l], b_in[l],
                         cmp_pe_k[l], cmp_w1_k[l], cmp_w2_k[l], cmp_pe_v[l], cmp_w1_v[l], cmp_w2_v[l],
                         ml_conv_w[l], ml_conv_b[l], ml_wq[l], ml_wk[l], ml_wv[l], ml_f_bias[l], ml_norm_g[l],
                         proj_a[l], proj_b[l], w_out[l], norm2_g[l],
                         router_w[l], router_b[l], exp_w_up[l], exp_b_up[l], exp_w_down[l], exp_b_down[l])
    return rms_norm(x, final_g)
```

```cpp
#include <hip/hip_runtime.h>
#include <hip/hip_cooperative_groups.h>
#include <cstdio>
#include <cstdint>
namespace cg = cooperative_groups;

#define LAS __attribute__((address_space(3)))
typedef unsigned short bf16;
typedef float f32x4 __attribute__((ext_vector_type(4)));
typedef float f32x2 __attribute__((ext_vector_type(2)));
typedef unsigned u32x4 __attribute__((ext_vector_type(4)));
typedef unsigned u32x2 __attribute__((ext_vector_type(2)));
typedef short bf16x8 __attribute__((ext_vector_type(8)));
typedef short s16x4 __attribute__((ext_vector_type(4)));

constexpr int NB = 16, S = 2048, D = 1024, T = NB * S;
constexpr int NPROJ = 4608;
constexpr int C_Q = 512, C_KCMP = 1024, C_VCMP = 1152, C_KSLC = 1280, C_VSLC = 1408, C_KWIN = 1536, C_VWIN = 1664;
constexpr int C_XM = 0, C_SMALL = 1792, C_OPRE = 2048, C_GA = 2560, C_GB = 3584;
constexpr int NPROJ_A = 512, NPROJ_B = 4096;
constexpr int PP = 2048, GP = 2560;
constexpr int G_OPRE = 0, G_GA = 512, G_GB = 1536;
constexpr int IN_W = 4384;
constexpr int NCMP = 127;
constexpr int NEXP = 32, PMAX = 544 * 256;
constexpr int NTHREADS = 512, NWAVES = 8;
constexpr int LDS_BYTES = 147456;

constexpr size_t MiB = 1u << 20;
constexpr size_t WS_CTL = 0;
constexpr size_t WS_MODP = 1 * MiB;
constexpr size_t WS_MOD = 7 * MiB;
constexpr size_t WS_BIN = 8 * MiB;
constexpr size_t WS_BLKE = 8 * MiB + 64 * 1024;
constexpr size_t WS_OFFS = 8 * MiB + 128 * 1024;
constexpr size_t WS_SMALL = 9 * MiB;
constexpr size_t WS_RE = 13 * MiB;
constexpr size_t WS_RW = WS_RE + 512 * 1024;
constexpr size_t WS_RS = WS_RW + 512 * 1024;
constexpr size_t WS_DEST = WS_RS + 512 * 1024;
constexpr size_t WS_ROWIDX = 17 * MiB;
constexpr size_t WS_SELM = 15 * MiB;
constexpr size_t WS_KC = 16 * MiB;
constexpr size_t WS_KCB = 16 * MiB;
constexpr size_t WS_W1T = 21 * MiB;
constexpr size_t WS_W2T = 22 * MiB;
constexpr size_t WS_CPE = 22 * MiB + 64 * 1024;
constexpr size_t WS_WQT = 23 * MiB;
constexpr size_t WS_RWT = 23 * MiB + 512 * 1024;
constexpr size_t WS_NLOC = 19 * MiB;
constexpr size_t WS_MLOC = 19 * MiB + 512 * 1024;
constexpr size_t WS_FLAST = WS_MLOC + 4096;
constexpr size_t WS_MIN = WS_FLAST + 4096;
constexpr size_t WS_NIN = 20 * MiB;
constexpr size_t WS_WIN = 24 * MiB;
constexpr size_t WS_WPA = 33 * MiB, WS_WOUT = 35 * MiB;
constexpr size_t WS_WUP = 40 * MiB;
constexpr size_t WS_WDN = 168 * MiB;
constexpr size_t WS_XN = 232 * MiB;
constexpr size_t WS_PROJ = 296 * MiB;
constexpr size_t WS_GATE8 = 424 * MiB;
constexpr size_t WS_QML = 584 * MiB, WS_KML = 616 * MiB, WS_VML = 648 * MiB;
constexpr size_t WS_CLOC = 680 * MiB, WS_CIN = 744 * MiB;
constexpr size_t WS_OACC = 808 * MiB;
constexpr size_t WS_ACT = 584 * MiB;
constexpr size_t WS_OY = 872 * MiB;
constexpr size_t WS_END = 936 * MiB;

__device__ __forceinline__ unsigned f2bf(float f) { unsigned u = __builtin_bit_cast(unsigned, f); return (u + 0x7fffu + ((u >> 16) & 1u)) >> 16; }
typedef __bf16 bf16x2_t __attribute__((ext_vector_type(2)));
__device__ __forceinline__ unsigned pk2(float lo, float hi) { const f32x2 v = {lo, hi}; return __builtin_bit_cast(unsigned, __builtin_convertvector(v, bf16x2_t)); }
__device__ __forceinline__ float bf2f(bf16 v) { return __builtin_bit_cast(float, (unsigned)v << 16); }
__device__ __forceinline__ float bflo(unsigned w) { return __builtin_bit_cast(float, w << 16); }
__device__ __forceinline__ float bfhi(unsigned w) { return __builtin_bit_cast(float, w & 0xffff0000u); }
__device__ __forceinline__ float sigmoidf_(float x) { return __builtin_amdgcn_rcpf(1.0f + __expf(-x)); }
__device__ __forceinline__ float wave_sum(float v) {
#pragma unroll
    for (int o = 1; o < 64; o <<= 1) v += __shfl_xor(v, o);
    return v;
}
#define LDS_WAIT() asm volatile("s_waitcnt lgkmcnt(0)" ::: "memory")
__device__ __forceinline__ unsigned pk4_fp8(float a, float b, float c, float d) { int w = 0; w = __builtin_amdgcn_cvt_pk_fp8_f32(a, b, w, false); w = __builtin_amdgcn_cvt_pk_fp8_f32(c, d, w, true); return (unsigned)w; }
__device__ __forceinline__ int opaque_i(int x) { asm volatile("" : "+v"(x)); return x; }

namespace pg8 {
constexpr int BM = 256, BK = 64, HALF = 128, HTB = HALF * BK * 2, STAGE_BYTES = 8 * HTB, NXCD = 8, WGM = 8;
__host__ __device__ __forceinline__ int lds_byte(int r, int c) { const int st = (r >> 4) * 2 + (c >> 5), rr = r & 15, cc = c & 31, ob = rr * 64 + cc * 2; return st * 1024 + (ob ^ (((ob >> 9) & 1) << 5)); }
__host__ __device__ __forceinline__ void stage_rc(int b, int& R, int& C) { const int st = b / 1024, sb = b % 1024, swz = sb ^ (((sb >> 9) & 1) << 5); R = (st >> 1) * 16 + swz / 64; C = (st & 1) * 32 + (swz % 64) / 2; }
__host__ __device__ __forceinline__ int perm32(int rho) { const int n = rho >> 4, i = rho & 15; return 8 * (i >> 2) + 4 * n + (i & 3); }

struct Unit { int pm, pn, brow, e; };
struct Gemm { const bf16* A; const bf16* Bt; int K; };

struct StaticOrder {
    static constexpr bool GATHER = false;
    int nM, nN, nwg, G, c;
    __device__ void init(int M, int N, int G_, int c_) { nM = M / BM; nN = N / BM; nwg = nM * nN; G = G_; c = c_; }
    __device__ bool next(int i, Unit& u) const {
        const long L = (long)i * G + c; if (L >= nwg) return false;
        int wgid = (int)L; { const int q = nwg / NXCD, r = nwg % NXCD, xcd = wgid % NXCD, off = wgid / NXCD; wgid = (xcd < r ? xcd * (q + 1) : r * (q + 1) + (xcd - r) * q) + off; }
        const int nig = WGM * nN, gid = wgid / nig, fm = gid * WGM, gsz = (nM - fm) < WGM ? (nM - fm) : WGM;
        u.pm = fm + ((wgid % nig) % gsz); u.pn = (wgid % nig) / gsz; u.brow = u.pn * BM; u.e = 0; return true;
    }
};
template <bool GATHER_> struct MoeOrderT {
    static constexpr bool GATHER = GATHER_;
    const int* blk_e; const int* rows; int nblk, nN, nPerE, x, y, ny;
    __device__ bool next(int i, Unit& u) const {
        const int l = i * ny + y, rb = l / nN, pn = l - rb * nN, pm = rb * 8 + x;
        if (pm >= nblk) return false;
        const int e = __builtin_amdgcn_readfirstlane(blk_e[pm]);
        u.pm = pm; u.pn = pn; u.e = e; u.brow = e * nPerE + pn * BM; return true;
    }
};
typedef MoeOrderT<false> MoeOrder;
typedef MoeOrderT<true> MoeOrderG;

__device__ __forceinline__ unsigned cvt_pk_bf16(float lo, float hi) { unsigned r; asm volatile("v_cvt_pk_bf16_f32 %0, %1, %2" : "=v"(r) : "v"(lo), "v"(hi)); return r; }

typedef int v8i __attribute__((ext_vector_type(8)));
typedef int v4i __attribute__((ext_vector_type(4)));
template <class Epi, class Sched, bool ALIGN_EPI, bool SP2, bool FP8 = false>
__device__ __forceinline__ void gemm_phase(LAS unsigned char* lds, const Gemm g, const Sched& S, const Epi& E) {
    constexpr int ESZ = FP8 ? 1 : 2;
    const int tid = opaque_i(threadIdx.x), wid = __builtin_amdgcn_readfirstlane(tid >> 6), lane = tid & 63, wr = wid >> 2, wc = wid & 3, fr = lane & 15, fq = lane >> 4;
    const int K = g.K, nt = (K * ESZ) / 128;
    unsigned voffA[2], voffB[2];
#pragma unroll
    for (int i = 0; i < 2; ++i) { int R, C; stage_rc(tid * 16 + i * 8192, R, C); const int Rb = Epi::PERM ? ((R & ~31) + perm32(R & 31)) : R;
        voffA[i] = (unsigned)(R * K * ESZ + C * 2); voffB[i] = (unsigned)(Rb * K * ESZ + C * 2); }
    const size_t kstep = (size_t)(BK * 2);
    const size_t hstep = (size_t)HALF * K * ESZ;
    const size_t tstep = 2 * hstep;
    const size_t rstep = (size_t)K * ESZ;
    const unsigned ldsw = (unsigned)wid * 1024u;
    const int aoff = lds_byte(wr * 64 + fr, fq * 8), boff = lds_byte(wc * 32 + fr, fq * 8);
#define PG8_SA(b, h) (((b) * 2 + (h)) * HTB)
#define PG8_SB(b, h) ((4 + (b) * 2 + (h)) * HTB)
#define PG8_STAGE(bufoff, gbase, voff) do { _Pragma("unroll") for (int _i = 0; _i < 2; ++_i) \
        __builtin_amdgcn_global_load_lds((const unsigned*)((const char*)(gbase) + (voff)[_i]), (LAS unsigned*)(lds + (bufoff) + ldsw + _i * 8192), 16, 0, 0); } while (0)
#define PG8_LDA(dst, b, h) do { _Pragma("unroll") for (int m = 0; m < 4; ++m) { const v4i lo_ = *(const LAS v4i*)(lds + PG8_SA(b, h) + aoff + m * 2048), hi_ = *(const LAS v4i*)(lds + PG8_SA(b, h) + aoff + m * 2048 + 1024); dst[m] = __builtin_shufflevector(lo_, hi_, 0, 1, 2, 3, 4, 5, 6, 7); } } while (0)
#define PG8_LDB(dst, b, h) do { _Pragma("unroll") for (int n = 0; n < 2; ++n) { const v4i lo_ = *(const LAS v4i*)(lds + PG8_SB(b, h) + boff + n * 2048), hi_ = *(const LAS v4i*)(lds + PG8_SB(b, h) + boff + n * 2048 + 1024); dst[n] = __builtin_shufflevector(lo_, hi_, 0, 1, 2, 3, 4, 5, 6, 7); } } while (0)
#define PG8_MMA(ai, bj, At, Bt) do { __builtin_amdgcn_s_setprio(1); _Pragma("unroll") for (int m = 0; m < 4; ++m) _Pragma("unroll") for (int n = 0; n < 2; ++n) { \
        if constexpr (FP8) asm volatile("v_mfma_scale_f32_16x16x128_f8f6f4 %0, %1, %2, %0, %3, %4 op_sel_hi:[0,0,0]" : "+v"(acc[ai][bj][m][n]) : "v"(Bt[n]), "v"(At[m]), "v"(sclW), "v"(sclX)); \
        else { acc[ai][bj][m][n] = __builtin_amdgcn_mfma_f32_16x16x32_bf16(__builtin_bit_cast(bf16x8, __builtin_shufflevector(Bt[n], Bt[n], 0, 1, 2, 3)), __builtin_bit_cast(bf16x8, __builtin_shufflevector(At[m], At[m], 0, 1, 2, 3)), acc[ai][bj][m][n], 0, 0, 0); \
               acc[ai][bj][m][n] = __builtin_amdgcn_mfma_f32_16x16x32_bf16(__builtin_bit_cast(bf16x8, __builtin_shufflevector(Bt[n], Bt[n], 4, 5, 6, 7)), __builtin_bit_cast(bf16x8, __builtin_shufflevector(At[m], At[m], 4, 5, 6, 7)), acc[ai][bj][m][n], 0, 0, 0); } } __builtin_amdgcn_s_setprio(0); } while (0)
#define PG8_WAIT_V(n) asm volatile("s_waitcnt vmcnt(" #n ")" ::: "memory")
#define PG8_WAIT_L(n) asm volatile("s_waitcnt lgkmcnt(" #n ")" ::: "memory")
#define PG8_BAR __builtin_amdgcn_s_barrier()
#define PG8_SCHED __builtin_amdgcn_sched_barrier(0)
    int sclW = 0x7a7a7a7a, sclX = 0x7f7f7f7f; asm volatile("" : "+v"(sclW), "+v"(sclX));
    Unit cur, nxt; int ui = 0;
    if (!S.next(0, cur)) return;
    unsigned vC[2][2], vN[2][2];
#define PG8_ROWOFFS(dst, pm_) do { if constexpr (Sched::GATHER) { _Pragma("unroll") for (int _h = 0; _h < 2; ++_h) _Pragma("unroll") for (int _i = 0; _i < 2; ++_i) { int R_, C_; stage_rc(tid * 16 + _i * 8192, R_, C_); \
        dst[_h][_i] = (unsigned)(S.rows[(pm_) * BM + _h * HALF + R_] * K * ESZ + C_ * 2); } } } while (0)
#define PG8_STAGE_A(bufoff, plain_ptr, koff, h, nx) do { if constexpr (Sched::GATHER) { _Pragma("unroll") for (int _i = 0; _i < 2; ++_i) { const unsigned vo_ = (nx) ? vN[h][_i] : vC[h][_i]; \
        __builtin_amdgcn_global_load_lds((const unsigned*)((const char*)g.A + (koff) + vo_), (LAS unsigned*)(lds + (bufoff) + ldsw + _i * 8192), 16, 0, 0); } } \
        else { PG8_STAGE(bufoff, plain_ptr, voffA); } } while (0)
    PG8_ROWOFFS(vC, cur.pm);
    f32x4 acc[2][2][4][2];
#pragma unroll
    for (int a = 0; a < 2; ++a)
#pragma unroll
        for (int b = 0; b < 2; ++b)
#pragma unroll
            for (int m = 0; m < 4; ++m)
#pragma unroll
                for (int n = 0; n < 2; ++n) acc[a][b][m][n] = (f32x4){0.f, 0.f, 0.f, 0.f};
    v8i At[4], B0[2], B1[2];
    const char* cA = (const char*)g.A + (size_t)cur.pm * tstep; const char* cB = (const char*)g.Bt + (size_t)cur.brow * rstep;
    if constexpr (SP2) {
        PG8_STAGE(PG8_SB(0, 0), cB, voffB); PG8_STAGE(PG8_SB(0, 1), cB + hstep, voffB); PG8_STAGE_A(PG8_SA(0, 0), cA, 0, 0, false); PG8_STAGE_A(PG8_SA(0, 1), cA + hstep, 0, 1, false);
        if (wr == 1) PG8_BAR;
        PG8_WAIT_V(2); PG8_BAR;
        PG8_STAGE(PG8_SB(1, 0), cB + kstep, voffB); PG8_STAGE_A(PG8_SA(1, 0), cA + kstep, kstep, 0, false); PG8_STAGE(PG8_SB(1, 1), cB + hstep + kstep, voffB);
        PG8_WAIT_V(6); PG8_BAR;
    } else {
        PG8_STAGE(PG8_SB(0, 0), cB, voffB); PG8_STAGE(PG8_SA(0, 0), cA, voffA); PG8_STAGE(PG8_SB(0, 1), cB + hstep, voffB); PG8_STAGE(PG8_SA(0, 1), cA + hstep, voffA);
        if (wr == 1) PG8_BAR;
        PG8_WAIT_V(4); PG8_BAR;
        PG8_STAGE(PG8_SB(1, 0), cB + kstep, voffB); PG8_STAGE(PG8_SA(1, 0), cA + kstep, voffA); PG8_STAGE(PG8_SB(1, 1), cB + hstep + kstep, voffB);
        PG8_WAIT_V(6); PG8_BAR;
    }
    for (;;) {
        const bool has_next = S.next(ui + 1, nxt);
        if constexpr (Sched::GATHER) { if (has_next) { PG8_ROWOFFS(vN, nxt.pm); } else { vN[0][0] = vC[0][0]; vN[0][1] = vC[0][1]; vN[1][0] = vC[1][0]; vN[1][1] = vC[1][1]; } }
        const char* nA = has_next ? (const char*)g.A + (size_t)nxt.pm * tstep : cA; const char* nB = has_next ? (const char*)g.Bt + (size_t)nxt.brow * rstep : cB;
#pragma nounroll
        for (int t = 0; t < nt; t += 2) {
            if constexpr (Epi::MIDK > 0) { if (t == Epi::MIDK) E.mid(acc, cur, wr, wc, fr, fq); }
            const bool last = (t == nt - 2);
            const char* a1 = cA + (size_t)(t + 1) * kstep;
            const char* a2 = last ? nA : cA + (size_t)(t + 2) * kstep; const char* b2 = last ? nB : cB + (size_t)(t + 2) * kstep;
            const char* a3 = a2 + kstep; const char* b3 = b2 + kstep;
            const size_t k1 = (size_t)(t + 1) * kstep, k2 = last ? 0 : (size_t)(t + 2) * kstep;
            if constexpr (SP2) {
            PG8_LDB(B0, 0, 0); PG8_LDB(B1, 0, 1); PG8_SCHED; PG8_LDA(At, 0, 0); PG8_STAGE_A(PG8_SA(1, 1), a1 + hstep, k1, 1, false);
            PG8_WAIT_V(8); PG8_WAIT_L(0); PG8_BAR; PG8_MMA(0, 0, At, B0); PG8_MMA(0, 1, At, B1); PG8_BAR; PG8_SCHED;
            PG8_LDA(At, 0, 1); PG8_STAGE(PG8_SB(0, 0), b2, voffB); PG8_STAGE(PG8_SB(0, 1), b2 + hstep, voffB); PG8_STAGE_A(PG8_SA(0, 0), a2, k2, 0, last);
            PG8_WAIT_V(8); PG8_WAIT_L(0); PG8_BAR; PG8_MMA(1, 0, At, B0); PG8_MMA(1, 1, At, B1); PG8_BAR; PG8_SCHED;
            PG8_LDB(B0, 1, 0); PG8_LDB(B1, 1, 1); PG8_SCHED; PG8_LDA(At, 1, 0); PG8_STAGE_A(PG8_SA(0, 1), a2 + hstep, k2, 1, last);
            PG8_WAIT_V(8); PG8_WAIT_L(0); PG8_BAR; PG8_MMA(0, 0, At, B0); PG8_MMA(0, 1, At, B1); PG8_BAR; PG8_SCHED;
            PG8_LDA(At, 1, 1); PG8_STAGE(PG8_SB(1, 0), b3, voffB); PG8_STAGE(PG8_SB(1, 1), b3 + hstep, voffB); PG8_STAGE_A(PG8_SA(1, 0), a3, k2 + kstep, 0, last);
            PG8_WAIT_V(8); PG8_WAIT_L(0); PG8_BAR; PG8_MMA(1, 0, At, B0); PG8_MMA(1, 1, At, B1); PG8_BAR; PG8_SCHED;
            } else {
            PG8_LDB(B0, 0, 0); PG8_SCHED; PG8_LDA(At, 0, 0); PG8_STAGE(PG8_SA(1, 1), a1 + hstep, voffA);
            PG8_WAIT_L(8); PG8_BAR; PG8_WAIT_L(0); PG8_MMA(0, 0, At, B0); PG8_BAR; PG8_SCHED;
            PG8_LDB(B1, 0, 1); PG8_STAGE(PG8_SB(0, 0), b2, voffB);
            PG8_BAR; PG8_WAIT_L(0); PG8_MMA(0, 1, At, B1); PG8_BAR;
            PG8_LDA(At, 0, 1); PG8_STAGE(PG8_SA(0, 0), a2, voffA);
            PG8_BAR; PG8_WAIT_L(0); PG8_MMA(1, 0, At, B0); PG8_BAR; PG8_SCHED;
            PG8_STAGE(PG8_SB(0, 1), b2 + hstep, voffB);
            PG8_WAIT_V(6); PG8_BAR; PG8_MMA(1, 1, At, B1); PG8_BAR;
            PG8_LDB(B0, 1, 0); PG8_SCHED; PG8_LDA(At, 1, 0); PG8_STAGE(PG8_SA(0, 1), a2 + hstep, voffA);
            PG8_WAIT_L(8); PG8_BAR; PG8_WAIT_L(0); PG8_MMA(0, 0, At, B0); PG8_BAR; PG8_SCHED;
            PG8_LDB(B1, 1, 1); PG8_STAGE(PG8_SB(1, 0), b3, voffB);
            PG8_BAR; PG8_WAIT_L(0); PG8_MMA(0, 1, At, B1); PG8_BAR;
            PG8_LDA(At, 1, 1); PG8_STAGE(PG8_SA(1, 0), a3, voffA);
            PG8_BAR; PG8_WAIT_L(0); PG8_MMA(1, 0, At, B0); PG8_BAR; PG8_SCHED;
            PG8_STAGE(PG8_SB(1, 1), b3 + hstep, voffB);
            PG8_WAIT_V(6); PG8_BAR; PG8_MMA(1, 1, At, B1); PG8_BAR;
            }
        }
        if constexpr (ALIGN_EPI) { if (wr == 0) PG8_BAR; }
        if constexpr (FP8) asm volatile("s_nop 15\n\ts_nop 15" ::: "memory");
        E(acc, cur, wr, wc, fr, fq);
        if (!has_next) break;
#pragma unroll
        for (int a = 0; a < 2; ++a)
#pragma unroll
            for (int b = 0; b < 2; ++b)
#pragma unroll
                for (int m = 0; m < 4; ++m)
#pragma unroll
                    for (int n = 0; n < 2; ++n) acc[a][b][m][n] = (f32x4){0.f, 0.f, 0.f, 0.f};
        cur = nxt; cA = nA; cB = nB; ++ui;
        if constexpr (Sched::GATHER) { vC[0][0] = vN[0][0]; vC[0][1] = vN[0][1]; vC[1][0] = vN[1][0]; vC[1][1] = vN[1][1]; }
        if constexpr (ALIGN_EPI) { if (wr == 1) PG8_BAR; }
    }
    PG8_WAIT_V(0);
    if constexpr (!ALIGN_EPI) { if (wr == 0) PG8_BAR; }
    PG8_BAR;
#undef PG8_SA
#undef PG8_SB
#undef PG8_STAGE
#undef PG8_STAGE_A
#undef PG8_ROWOFFS
#undef PG8_LDA
#undef PG8_LDB
#undef PG8_MMA
#undef PG8_WAIT_V
#undef PG8_WAIT_L
#undef PG8_BAR
#undef PG8_SCHED
}

typedef const f32x4 (&AccRef)[2][2][4][2];
struct EpiProj {
    static constexpr int MIDK = 0;
    static constexpr bool PERM = true;
    bf16* O; float* small; const float* bias; unsigned char* G8; int coloff, smtile, gtile;
    __device__ __forceinline__ void operator()(AccRef acc, const Unit& u, int wr, int wc, int fr, int fq) const {
        const int row0 = u.pm * BM + wr * 64 + fr, col0 = u.pn * BM + wc * 32 + 8 * fq;
        f32x4 bv[2][2];
#pragma unroll
        for (int bj = 0; bj < 2; ++bj)
#pragma unroll
            for (int n = 0; n < 2; ++n) bv[bj][n] = *(const f32x4*)(bias + col0 + bj * HALF + 4 * n);
        const bool sm = (u.pn == smtile) && (wc == 0);
        const bool tog = u.pn >= gtile;
#pragma unroll
        for (int ai = 0; ai < 2; ++ai)
#pragma unroll
            for (int m = 0; m < 4; ++m) { const int row = row0 + ai * HALF + m * 16; bf16* rowp = O + (size_t)row * PP + col0;
                unsigned char* gp = G8 + (size_t)row * GP + (col0 - gtile * BM);
#pragma unroll
                for (int bj = 0; bj < 2; ++bj) { const f32x4 v0 = acc[ai][bj][m][0] + bv[bj][0], v1 = acc[ai][bj][m][1] + bv[bj][1];
                    if (tog) { u32x2 w8; w8.x = pk4_fp8(v0[0], v0[1], v0[2], v0[3]); w8.y = pk4_fp8(v1[0], v1[1], v1[2], v1[3]); *(u32x2*)(gp + bj * HALF) = w8; }
                    else { u32x4 w; w.x = cvt_pk_bf16(v0[0], v0[1]); w.y = cvt_pk_bf16(v0[2], v0[3]); w.z = cvt_pk_bf16(v1[0], v1[1]); w.w = cvt_pk_bf16(v1[2], v1[3]);
                        *(u32x4*)(rowp + bj * HALF) = w; }
                    if (bj == 0 && sm) { *(f32x4*)(small + (size_t)row * 32 + 8 * fq) = v0; *(f32x4*)(small + (size_t)row * 32 + 8 * fq + 4) = v1; } } }
    }
};
struct EpiMix2 {
    static constexpr int MIDK = 8;
    static constexpr bool PERM = true;
    bf16* O; const unsigned char* g8;
    __device__ __forceinline__ void mid(f32x4 (&acc)[2][2][4][2], const Unit& u, int wr, int wc, int fr, int fq) const {
        int z = 0; asm volatile("" : "+v"(z));
        const int row0 = u.pm * BM + wr * 64 + fr + z, col0 = u.pn * BM + wc * 32 + 8 * fq;
#pragma unroll
        for (int ai = 0; ai < 2; ++ai)
#pragma unroll
            for (int m = 0; m < 4; ++m) { const unsigned char* gp = g8 + (size_t)(row0 + ai * HALF + m * 16) * GP + col0;
#pragma unroll
                for (int bj = 0; bj < 2; ++bj) { const u32x2 ga8 = *(const u32x2*)(gp + G_GA + bj * HALF), gb8 = *(const u32x2*)(gp + G_GB + bj * HALF);
                    float fa[8], fb[8]; { const f32x2 a0 = __builtin_amdgcn_cvt_pk_f32_fp8((int)ga8.x, false), a1 = __builtin_amdgcn_cvt_pk_f32_fp8((int)ga8.x, true), a2 = __builtin_amdgcn_cvt_pk_f32_fp8((int)ga8.y, false), a3 = __builtin_amdgcn_cvt_pk_f32_fp8((int)ga8.y, true);
                        const f32x2 b0 = __builtin_amdgcn_cvt_pk_f32_fp8((int)gb8.x, false), b1 = __builtin_amdgcn_cvt_pk_f32_fp8((int)gb8.x, true), b2 = __builtin_amdgcn_cvt_pk_f32_fp8((int)gb8.y, false), b3 = __builtin_amdgcn_cvt_pk_f32_fp8((int)gb8.y, true);
                        fa[0] = a0.x; fa[1] = a0.y; fa[2] = a1.x; fa[3] = a1.y; fa[4] = a2.x; fa[5] = a2.y; fa[6] = a3.x; fa[7] = a3.y; fb[0] = b0.x; fb[1] = b0.y; fb[2] = b1.x; fb[3] = b1.y; fb[4] = b2.x; fb[5] = b2.y; fb[6] = b3.x; fb[7] = b3.y; }
                    float r[8];
#define MIXR(i, av, bv) r[i] = (1.0f + fminf(__expf(-(bv)), 1e20f)) * __builtin_amdgcn_rcpf(1.0f + __expf(-(av)))
                    MIXR(0, fa[0], fb[0]); MIXR(1, fa[1], fb[1]); MIXR(2, fa[2], fb[2]); MIXR(3, fa[3], fb[3]); MIXR(4, fa[4], fb[4]); MIXR(5, fa[5], fb[5]); MIXR(6, fa[6], fb[6]); MIXR(7, fa[7], fb[7]);
#undef MIXR
#pragma unroll
                    for (int j = 0; j < 4; ++j) { acc[ai][bj][m][0][j] *= r[j]; acc[ai][bj][m][1][j] *= r[4 + j]; } }
                __builtin_amdgcn_sched_barrier(0); }
    }
    __device__ __forceinline__ void operator()(AccRef acc, const Unit& u, int wr, int wc, int fr, int fq) const {
        const int row0 = u.pm * BM + wr * 64 + fr, col0 = u.pn * BM + wc * 32 + 8 * fq;
#pragma unroll
        for (int ai = 0; ai < 2; ++ai)
#pragma unroll
            for (int m = 0; m < 4; ++m) { const int row = row0 + ai * HALF + m * 16; bf16* rowp = O + (size_t)row * D + col0;
                const unsigned char* gp = g8 + (size_t)row * GP + G_GB + col0;
#pragma unroll
                for (int bj = 0; bj < 2; ++bj) { const u32x2 gb8 = *(const u32x2*)(gp + bj * HALF);
                    const f32x2 b0 = __builtin_amdgcn_cvt_pk_f32_fp8((int)gb8.x, false), b1 = __builtin_amdgcn_cvt_pk_f32_fp8((int)gb8.x, true), b2 = __builtin_amdgcn_cvt_pk_f32_fp8((int)gb8.y, false), b3 = __builtin_amdgcn_cvt_pk_f32_fp8((int)gb8.y, true);
                    float r[8];
#define MIXG(bv) __builtin_amdgcn_rcpf(1.0f + fminf(__expf(-(bv)), 1e20f))
                    r[0] = MIXG(b0.x) * acc[ai][bj][m][0][0]; r[1] = MIXG(b0.y) * acc[ai][bj][m][0][1]; r[2] = MIXG(b1.x) * acc[ai][bj][m][0][2]; r[3] = MIXG(b1.y) * acc[ai][bj][m][0][3];
                    r[4] = MIXG(b2.x) * acc[ai][bj][m][1][0]; r[5] = MIXG(b2.y) * acc[ai][bj][m][1][1]; r[6] = MIXG(b3.x) * acc[ai][bj][m][1][2]; r[7] = MIXG(b3.y) * acc[ai][bj][m][1][3];
#undef MIXG
                    u32x4 w; w.x = cvt_pk_bf16(r[0], r[1]); w.y = cvt_pk_bf16(r[2], r[3]); w.z = cvt_pk_bf16(r[4], r[5]); w.w = cvt_pk_bf16(r[6], r[7]);
                    *(u32x4*)(rowp + bj * HALF) = w; } }
    }
};
struct EpiWout {
    static constexpr int MIDK = 0;
    static constexpr bool PERM = true;
    const float* x; bf16* out; const float* gate;
    __device__ __forceinline__ void operator()(AccRef acc, const Unit& u, int wr, int wc, int fr, int fq) const {
        const int row0 = u.pm * BM + wr * 64 + fr, col0 = u.pn * BM + wc * 32 + 8 * fq, b = u.pm >> 3;
        f32x4 gv[2][2];
#pragma unroll
        for (int bj = 0; bj < 2; ++bj)
#pragma unroll
            for (int n = 0; n < 2; ++n) gv[bj][n] = *(const f32x4*)(gate + (size_t)b * 6144 + col0 + bj * HALF + 4 * n);
#pragma unroll
        for (int ai = 0; ai < 2; ++ai)
#pragma unroll
            for (int m = 0; m < 4; ++m) { const size_t off = (size_t)(row0 + ai * HALF + m * 16) * D + col0;
#pragma unroll
                for (int bj = 0; bj < 2; ++bj) { const f32x4 x0 = *(const f32x4*)(x + off + bj * HALF), x1 = *(const f32x4*)(x + off + bj * HALF + 4);
                    const f32x4 v0 = x0 + gv[bj][0] * acc[ai][bj][m][0], v1 = x1 + gv[bj][1] * acc[ai][bj][m][1];
                    u32x4 w; w.x = cvt_pk_bf16(v0[0], v0[1]); w.y = cvt_pk_bf16(v0[2], v0[3]); w.z = cvt_pk_bf16(v1[0], v1[1]); w.w = cvt_pk_bf16(v1[2], v1[3]);
                    *(u32x4*)(out + off + bj * HALF) = w; } }
    }
};
struct EpiNull {
    static constexpr int MIDK = 0;
    static constexpr bool PERM = false;
    float* sink;
    __device__ __forceinline__ void operator()(AccRef acc, const Unit& u, int wr, int wc, int fr, int fq) const {
        f32x4 s = (f32x4){0.f, 0.f, 0.f, 0.f};
#pragma unroll
        for (int ai = 0; ai < 2; ++ai)
#pragma unroll
            for (int bj = 0; bj < 2; ++bj)
#pragma unroll
                for (int m = 0; m < 4; ++m)
#pragma unroll
                    for (int n = 0; n < 2; ++n) s += acc[ai][bj][m][n];
        if (s[0] == 1.2345e30f) sink[0] = s[1] + s[2] + s[3];
    }
};
struct EpiSwiglu {
    static constexpr int MIDK = 0;
    static constexpr bool PERM = true;
    bf16* O; const float* bup;
    __device__ __forceinline__ void operator()(AccRef acc, const Unit& u, int wr, int wc, int fr, int fq) const {
        const int row0 = u.pm * BM + wr * 64 + fr, lc = wc * 32 + 8 * fq, hc = u.pn * HALF + lc;
        const float* bp = bup + (size_t)u.e * 2048 + hc;
        f32x4 bg[2], bl[2];
#pragma unroll
        for (int n = 0; n < 2; ++n) { bg[n] = *(const f32x4*)(bp + 4 * n); bl[n] = *(const f32x4*)(bp + 1024 + 4 * n); }
#pragma unroll
        for (int ai = 0; ai < 2; ++ai)
#pragma unroll
            for (int m = 0; m < 4; ++m) { const int row = row0 + ai * HALF + m * 16;
                float r[8];
#pragma unroll
                for (int n = 0; n < 2; ++n)
#pragma unroll
                    for (int j = 0; j < 4; ++j) { float gg = acc[ai][0][m][n][j] + bg[n][j], ll = acc[ai][1][m][n][j] + bl[n][j];
                        gg = fminf(gg, 7.0f); ll = fminf(fmaxf(ll, -7.0f), 7.0f);
                        r[4 * n + j] = gg * sigmoidf_(1.702f * gg) * (ll + 1.0f); }
                u32x2 w; w.x = pk4_fp8(r[0], r[1], r[2], r[3]); w.y = pk4_fp8(r[4], r[5], r[6], r[7]);
                *(u32x2*)((unsigned char*)O + (size_t)row * D + hc) = w; }
    }
};
struct EpiDown {
    static constexpr int MIDK = 0;
    static constexpr bool PERM = true;
    bf16* O; const float* bdn;
    __device__ __forceinline__ void operator()(AccRef acc, const Unit& u, int wr, int wc, int fr, int fq) const {
        const int row0 = u.pm * BM + wr * 64 + fr, col0 = u.pn * BM + wc * 32 + 8 * fq;
        f32x4 bv[2][2];
#pragma unroll
        for (int bj = 0; bj < 2; ++bj)
#pragma unroll
            for (int n = 0; n < 2; ++n) bv[bj][n] = *(const f32x4*)(bdn + (size_t)u.e * D + col0 + bj * HALF + 4 * n);
#pragma unroll
        for (int ai = 0; ai < 2; ++ai)
#pragma unroll
            for (int m = 0; m < 4; ++m) { bf16* rowp = O + (size_t)(row0 + ai * HALF + m * 16) * D + col0;
#pragma unroll
                for (int bj = 0; bj < 2; ++bj) { const f32x4 v0 = acc[ai][bj][m][0] + bv[bj][0], v1 = acc[ai][bj][m][1] + bv[bj][1];
                    u32x4 w; w.x = cvt_pk_bf16(v0[0], v0[1]); w.y = cvt_pk_bf16(v0[2], v0[3]); w.z = cvt_pk_bf16(v1[0], v1[1]); w.w = cvt_pk_bf16(v1[2], v1[3]);
                    *(u32x4*)(rowp + bj * HALF) = w; } }
    }
};
}

struct Args { const float* in[31]; float* out; unsigned char* ws; };

struct Frame {
    LAS unsigned char* lds;
    unsigned char* ws;
    const float* const* in;
    float* out;
    int tid, lane, wave, G, bid;
};

__device__ __forceinline__ int map_in(int d) {
    if (d < 512) return 1304 + d;
    if (d < 1792) return d - 512;
    if (d < 1816) return 1280 + (d - 1792);
    if (d < 1824) return 2328 + (d - 1816);
    if (d < 2048) return -1;
    if (d < 2560) return 1816 + (d - 2048);
    return 2336 + (d - 2560);
}
__device__ __forceinline__ int map_up(int r) { return ((r >> 7) & 1) * 1024 + (r >> 8) * 128 + (r & 127); }

template <int MAP>
__device__ __forceinline__ void transpose_item(const float* W, int ldw, int K, bf16* WT, int nblk, int item, LAS float* scr, int lane, int ldt = 0) {
    if (ldt == 0) ldt = K;
    const int kb = item / nblk, nb = item - kb * nblk, k0 = 64 * kb, n0 = 32 * nb;
    const int r = lane >> 3, c4 = (lane & 7) * 4, nd = n0 + c4;
    const int sc = MAP == 0 ? nd : (MAP == 1 ? map_in(nd) : map_up(nd));
    f32x4 v[8];
#pragma unroll
    for (int i = 0; i < 8; ++i) v[i] = sc >= 0 ? *(const f32x4*)(W + (size_t)(k0 + 8 * i + r) * ldw + sc) : (f32x4){0.f, 0.f, 0.f, 0.f};
#pragma unroll
    for (int i = 0; i < 8; ++i) { LAS float* p = scr + (8 * i + r) * 33 + c4; p[0] = v[i].x; p[1] = v[i].y; p[2] = v[i].z; p[3] = v[i].w; }
    LDS_WAIT();
    const int c = lane & 7;
#pragma unroll
    for (int j = 0; j < 4; ++j) { const int n = (lane >> 3) + 8 * j; const LAS float* s = scr + (8 * c) * 33 + n;
        u32x4 o; o.x = pk2(s[0 * 33], s[1 * 33]); o.y = pk2(s[2 * 33], s[3 * 33]); o.z = pk2(s[4 * 33], s[5 * 33]); o.w = pk2(s[6 * 33], s[7 * 33]);
        *(u32x4*)(WT + (size_t)(n0 + n) * ldt + k0 + 8 * c) = o; }
    LDS_WAIT();
}

template <int MAP>
__device__ __forceinline__ void transpose_item8(const float* W, int ldw, int K, unsigned char* WT, int nblk, int item, LAS float* scr, int lane) {
    const int kb = item / nblk, nb = item - kb * nblk, k0 = 64 * kb, n0 = 32 * nb;
    const int r = lane >> 3, c4 = (lane & 7) * 4, nd = n0 + c4;
    const int sc = MAP == 0 ? nd : (MAP == 1 ? map_in(nd) : map_up(nd));
    f32x4 v[8];
#pragma unroll
    for (int i = 0; i < 8; ++i) v[i] = sc >= 0 ? *(const f32x4*)(W + (size_t)(k0 + 8 * i + r) * ldw + sc) : (f32x4){0.f, 0.f, 0.f, 0.f};
#pragma unroll
    for (int i = 0; i < 8; ++i) { LAS float* p = scr + (8 * i + r) * 33 + c4; p[0] = v[i].x; p[1] = v[i].y; p[2] = v[i].z; p[3] = v[i].w; }
    LDS_WAIT();
    const int c = lane & 7;
#pragma unroll
    for (int j = 0; j < 4; ++j) { const int n = (lane >> 3) + 8 * j; const LAS float* s = scr + (8 * c) * 33 + n;
        u32x2 o; o.x = pk4_fp8(32.f * s[0 * 33], 32.f * s[1 * 33], 32.f * s[2 * 33], 32.f * s[3 * 33]); o.y = pk4_fp8(32.f * s[4 * 33], 32.f * s[5 * 33], 32.f * s[6 * 33], 32.f * s[7 * 33]);
        *(u32x2*)(WT + (size_t)(n0 + n) * K + k0 + 8 * c) = o; }
    LDS_WAIT();
}

__device__ __forceinline__ void p0_adaln(Frame& F) {
    const float* c = F.in[1]; const float* ada_w = F.in[2];
    float* modp = (float*)(F.ws + WS_MODP);
    LAS float* sl = (LAS float*)F.lds;
    for (int u = F.bid; u < 192; u += F.G) {
        const int ks = u / 12, cc = u - ks * 12, j = cc * 512 + F.tid;
        __syncthreads();
        for (int i = F.tid; i < 1024; i += NTHREADS) { const int b = i >> 6, kk = i & 63; const float v = c[b * 1024 + ks * 64 + kk]; sl[i] = v / (1.0f + __expf(-v)); }
        __syncthreads();
        float acc[16];
#pragma unroll
        for (int b = 0; b < 16; ++b) acc[b] = 0.f;
#pragma unroll 16
        for (int kk = 0; kk < 64; ++kk) { const float w = ada_w[(size_t)(ks * 64 + kk) * 6144 + j];
#pragma unroll
            for (int b = 0; b < 16; ++b) acc[b] += sl[b * 64 + kk] * w; }
#pragma unroll
        for (int b = 0; b < 16; ++b) modp[(size_t)(ks * 16 + b) * 6144 + j] = acc[b];
    }
}

__device__ __forceinline__ void p0_cpe(Frame& F) {
    float* cpe = (float*)(F.ws + WS_CPE);
    LAS float* red = (LAS float*)F.lds;
    for (int u = F.bid - 192; u >= 0 && u < 64; u += F.G) {
        const int kv = u >> 5, e0 = (u & 31) * 4, eo = F.tid & 3, kk = F.tid >> 2;
        const float* pe = F.in[kv ? 10 : 7]; const float* w1 = F.in[kv ? 11 : 8];
        float s = 0.f;
#pragma unroll
        for (int m = 0; m < 16; ++m) { const int k = kk + 128 * m; s += pe[k] * w1[(size_t)k * 128 + e0 + eo]; }
        __syncthreads();
        red[F.tid] = s;
        __syncthreads();
        if (F.tid < 4) { float t = 0.f; for (int i = 0; i < 128; ++i) t += red[i * 4 + F.tid]; cpe[kv * 128 + e0 + F.tid] = t; }
    }
}

__device__ __forceinline__ void p1_prologue(Frame& F) {
    const float* modp = (const float*)(F.ws + WS_MODP);
    float* mod = (float*)(F.ws + WS_MOD);
    const int gtid = F.bid * NTHREADS + F.tid, gsz = F.G * NTHREADS;
    for (int i = gtid; i < 16 * 6144; i += gsz) { float s = F.in[3][i % 6144];
        for (int ks = 0; ks < 16; ++ks) s += modp[(size_t)ks * 16 * 6144 + i];
        mod[i] = s; }
    { float* bin = (float*)(F.ws + WS_BIN);
      for (int i = gtid; i < NPROJ; i += gsz) { const int sc = map_in(i); bin[i] = sc >= 0 ? F.in[6][sc] : 0.f; } }
    { bf16* rwt = (bf16*)(F.ws + WS_RWT);
      for (int i = gtid; i < 32 * 1024; i += gsz) { const int e = i >> 10, d = i & 1023; const float wv = F.in[24][d * 32 + e]; const unsigned hi = f2bf(wv);
          rwt[i] = (bf16)hi; rwt[32 * 1024 + i] = (bf16)f2bf(wv - __builtin_bit_cast(float, hi << 16)); } }
    {
        const float* x = F.in[0]; const float* g1 = F.in[4]; bf16* xn = (bf16*)(F.ws + WS_XN);
        LAS float* sm = (LAS float*)F.lds;
        for (int rb = F.bid; rb < T / 128; rb += F.G) {
            const int b = rb >> 4;
            __syncthreads();
            for (int i = F.tid; i < 2048; i += NTHREADS) { float s = F.in[3][i];
                for (int ks = 0; ks < 16; ++ks) s += modp[(size_t)(ks * 16 + b) * 6144 + i];
                sm[i] = s; }
            __syncthreads();
            for (int r = 0; r < 16; ++r) {
                const int row = rb * 128 + F.wave * 16 + r;
                const f32x4* xr = (const f32x4*)(x + (size_t)row * D) + F.lane;
                f32x4 v[4]; float ss = 0.f;
#pragma unroll
                for (int j = 0; j < 4; ++j) { v[j] = xr[64 * j]; ss += v[j].x * v[j].x + v[j].y * v[j].y + v[j].z * v[j].z + v[j].w * v[j].w; }
                const float rs = rsqrtf(wave_sum(ss) * (1.0f / D) + 1e-5f);
                unsigned* o4 = (unsigned*)(F.ws + WS_OY + (size_t)row * D) + F.lane; u32x2* o8 = (u32x2*)(xn + (size_t)row * D) + F.lane;
#pragma unroll
                for (int j = 0; j < 4; ++j) { const int d0 = (64 * j + F.lane) * 4; const f32x4 gg = *(const f32x4*)(g1 + d0);
                    float y[4];
#pragma unroll
                    for (int i = 0; i < 4; ++i) y[i] = v[j][i] * rs * gg[i] * (1.0f + sm[1024 + d0 + i]) + sm[d0 + i];
                    o4[64 * j] = pk4_fp8(y[0], y[1], y[2], y[3]); u32x2 w; w.x = pk2(y[0], y[1]); w.y = pk2(y[2], y[3]); o8[64 * j] = w; }
            }
        }
    }
    __syncthreads();
    {
        LAS float* scr = (LAS float*)(F.lds + F.wave * 16384);
        const int gw = F.bid * NWAVES + F.wave, NGW = F.G * NWAVES;
        constexpr int I_IN = 16 * 144, I_PA = 8 * 32, I_WO = 16 * 32, I_UP1 = 16 * 64, I_DN1 = 16 * 32;
        constexpr int I_C1 = 32 * 4, I_C2 = 2 * 2, I_ML = 2 * 4;
        constexpr int NITEMS = I_IN + 2 * I_PA + I_WO + 2 * I_C1 + 2 * I_C2 + 12 * I_ML;
        for (int it = gw; it < NITEMS; it += NGW) {
            int r = it;
            if (r < I_IN) { const int nb = r % 144;
                if (nb < 16) transpose_item<1>(F.in[5], IN_W, 1024, (bf16*)(F.ws + WS_WIN), 144, r, scr, F.lane);
                else transpose_item8<1>(F.in[5], IN_W, 1024, (unsigned char*)(F.ws + WS_WIN + 4 * MiB) - (size_t)512 * 1024, 144, r, scr, F.lane);
                continue; } r -= I_IN;
            if (r < I_PA) { transpose_item<0>(F.in[20], 1024, 512, (bf16*)(F.ws + WS_WPA), 32, r, scr, F.lane, 1024); continue; } r -= I_PA;
            if (r < I_PA) { transpose_item<0>(F.in[21], 1024, 512, (bf16*)(F.ws + WS_WPA) + 512, 32, r, scr, F.lane, 1024); continue; } r -= I_PA;
            if (r < I_WO) { transpose_item<0>(F.in[22], 1024, 1024, (bf16*)(F.ws + WS_WOUT), 32, r, scr, F.lane); continue; } r -= I_WO;
            if (r < 2 * I_C1) { const int kv = r / I_C1; transpose_item<0>(F.in[kv ? 11 : 8], 128, 2048, (bf16*)(F.ws + WS_W1T) + (size_t)kv * 128 * 2048, 4, r - kv * I_C1, scr, F.lane); continue; } r -= 2 * I_C1;
            if (r < 2 * I_C2) { const int kv = r / I_C2; transpose_item<0>(F.in[kv ? 12 : 9], 64, 128, (bf16*)(F.ws + WS_W2T) + (size_t)kv * 64 * 128, 2, r - kv * I_C2, scr, F.lane); continue; } r -= 2 * I_C2;
            { const int mh = r / I_ML, mat = mh >> 2; transpose_item<0>(F.in[15 + mat] + (size_t)(mh & 3) * 16384, 128, 128, (bf16*)(F.ws + WS_WQT) + (size_t)mh * 16384, 4, r - mh * I_ML, scr, F.lane); }
        }
    }
}

struct AttnState { float q[64]; float o[64]; float m, l; };
__device__ __forceinline__ void attn_init(AttnState& st, const bf16* qp) {
#pragma unroll
    for (int i = 0; i < 8; ++i) { const u32x4 w = *(const u32x4*)(qp + 8 * i);
        st.q[8 * i + 0] = bflo(w.x) * 0.125f; st.q[8 * i + 1] = bfhi(w.x) * 0.125f; st.q[8 * i + 2] = bflo(w.y) * 0.125f; st.q[8 * i + 3] = bfhi(w.y) * 0.125f;
        st.q[8 * i + 4] = bflo(w.z) * 0.125f; st.q[8 * i + 5] = bfhi(w.z) * 0.125f; st.q[8 * i + 6] = bflo(w.w) * 0.125f; st.q[8 * i + 7] = bfhi(w.w) * 0.125f; }
#pragma unroll
    for (int d = 0; d < 64; ++d) st.o[d] = 0.f;
    st.m = -1e30f; st.l = 0.f;
}
__device__ __forceinline__ float dot_bf16row(const float (&q)[64], const bf16* kp) {
    float s0 = 0.f, s1 = 0.f;
#pragma unroll
    for (int i = 0; i < 8; ++i) { const u32x4 w = *(const u32x4*)(kp + 8 * i);
        s0 += q[8 * i + 0] * bflo(w.x); s1 += q[8 * i + 1] * bfhi(w.x); s0 += q[8 * i + 2] * bflo(w.y); s1 += q[8 * i + 3] * bfhi(w.y);
        s0 += q[8 * i + 4] * bflo(w.z); s1 += q[8 * i + 5] * bfhi(w.z); s0 += q[8 * i + 6] * bflo(w.w); s1 += q[8 * i + 7] * bfhi(w.w); }
    return s0 + s1;
}
__device__ __forceinline__ void attn_key_bf16(AttnState& st, float sc, bool valid, const bf16* vp) {
    const bool need = valid && (sc > st.m + 8.0f);
    if (__any(need)) { if (need) { const float a = __expf(st.m - sc); st.l *= a;
#pragma unroll
            for (int d = 0; d < 64; ++d) st.o[d] *= a;
            st.m = sc; } }
    const float p = valid ? __expf(sc - st.m) : 0.f;
    st.l += p;
#pragma unroll
    for (int i = 0; i < 8; ++i) { const u32x4 w = *(const u32x4*)(vp + 8 * i);
        st.o[8 * i + 0] += p * bflo(w.x); st.o[8 * i + 1] += p * bfhi(w.x); st.o[8 * i + 2] += p * bflo(w.y); st.o[8 * i + 3] += p * bfhi(w.y);
        st.o[8 * i + 4] += p * bflo(w.z); st.o[8 * i + 5] += p * bfhi(w.z); st.o[8 * i + 6] += p * bflo(w.w); st.o[8 * i + 7] += p * bfhi(w.w); }
}

__device__ __forceinline__ float gelu_tanh(float x) { const float u = 0.7978845608f * (x + 0.044715f * x * x * x); const float t = 1.0f - 2.0f / (__expf(2.0f * u) + 1.0f); return 0.5f * x * (1.0f + t); }

__device__ __forceinline__ void p3_compress(Frame& F) {
    const bf16* proj = (const bf16*)(F.ws + WS_PROJ); const bf16* w1t = (const bf16*)(F.ws + WS_W1T); const bf16* w2t = (const bf16*)(F.ws + WS_W2T);
    const float* cpe = (const float*)(F.ws + WS_CPE); bf16* kcb = (bf16*)(F.ws + WS_KCB);
    const int lane = F.lane, w = F.wave, c = lane & 15, g4 = lane >> 4, nt2 = w >> 2, sl = w & 3;
    LAS f32x4* part = (LAS f32x4*)F.lds;
    for (int bu = F.bid; bu < 256; bu += F.G) {
        const int wu = bu * 2 + nt2;
        const int kv = wu >> 8, b = (wu >> 4) & 15, g = (wu >> 3) & 1, n0 = (wu & 7) * 16;
        const int n = n0 + c, nn = n > 126 ? 126 : n;
        const bf16* xb = proj + (size_t)(b * S + 16 * nn) * PP + (kv ? C_VCMP : C_KCMP) + g * 64 + 8 * g4;
        const bf16* wb = w1t + (size_t)kv * 128 * 2048 + (size_t)c * 2048 + 8 * g4;
        f32x4 acc[8];
#pragma unroll
        for (int et = 0; et < 8; ++et) acc[et] = (f32x4){0.f, 0.f, 0.f, 0.f};
#pragma unroll 2
        for (int k2 = 0; k2 < 16; ++k2) { const int ks = 16 * sl + k2;
            const bf16x8 xf = *(const bf16x8*)(xb + (size_t)(ks >> 1) * PP + 32 * (ks & 1));
#pragma unroll
            for (int et = 0; et < 8; ++et) { const bf16x8 wf = *(const bf16x8*)(wb + (size_t)et * 16 * 2048 + 32 * ks); acc[et] = __builtin_amdgcn_mfma_f32_16x16x32_bf16(wf, xf, acc[et], 0, 0, 0); }
        }
        __syncthreads();
        if (sl != 0) {
#pragma unroll
            for (int et = 0; et < 8; ++et) part[((nt2 * 3 + (sl - 1)) * 8 + et) * 64 + lane] = acc[et]; }
        __syncthreads();
        if (sl == 0) {
#pragma unroll
            for (int et = 0; et < 8; ++et) { const f32x4 cp = *(const f32x4*)(cpe + kv * 128 + 16 * et + 4 * g4);
                const f32x4 s = acc[et] + part[((nt2 * 3 + 0) * 8 + et) * 64 + lane] + part[((nt2 * 3 + 1) * 8 + et) * 64 + lane] + part[((nt2 * 3 + 2) * 8 + et) * 64 + lane];
#pragma unroll
                for (int i = 0; i < 4; ++i) acc[et][i] = gelu_tanh(s[i] + cp[i]); }
            f32x4 o2[4];
#pragma unroll
            for (int dt = 0; dt < 4; ++dt) o2[dt] = (f32x4){0.f, 0.f, 0.f, 0.f};
#pragma unroll
            for (int ss = 0; ss < 4; ++ss) {
                u32x4 hw; hw.x = pk2(acc[2 * ss][0], acc[2 * ss][1]); hw.y = pk2(acc[2 * ss][2], acc[2 * ss][3]); hw.z = pk2(acc[2 * ss + 1][0], acc[2 * ss + 1][1]); hw.w = pk2(acc[2 * ss + 1][2], acc[2 * ss + 1][3]);
                const bf16x8 hf = __builtin_bit_cast(bf16x8, hw);
#pragma unroll
                for (int dt = 0; dt < 4; ++dt) { const bf16* wp = w2t + (size_t)kv * 64 * 128 + (size_t)(16 * dt + c) * 128 + 32 * ss + 4 * g4;
                    const u32x2 lo = *(const u32x2*)wp, hi = *(const u32x2*)(wp + 16);
                    const u32x4 ww = (u32x4){lo.x, lo.y, hi.x, hi.y};
                    o2[dt] = __builtin_amdgcn_mfma_f32_16x16x32_bf16(__builtin_bit_cast(bf16x8, ww), hf, o2[dt], 0, 0, 0); }
            }
            bf16* op = kcb + ((((size_t)kv * 16 + b) * 2 + g) * 128 + n) * 64 + 4 * g4;
#pragma unroll
            for (int dt = 0; dt < 4; ++dt) { u32x2 w2; w2.x = pk2(o2[dt][0], o2[dt][1]); w2.y = pk2(o2[dt][2], o2[dt][3]); if (n > 126) { w2.x = 0u; w2.y = 0u; } *(u32x2*)(op + 16 * dt) = w2; }
        }
    }
}

__device__ __forceinline__ void p4_cmpsel(Frame& F) {
    constexpr float LOG2E = 1.4426950408889634f;
    const bf16* proj = (const bf16*)(F.ws + WS_PROJ); const float* small = (const float*)(F.ws + WS_SMALL); float* oacc = (float*)(F.ws + WS_OACC);
    const bf16* kcb = (const bf16*)(F.ws + WS_KCB); const bf16* vcb = kcb + (size_t)16 * 2 * 128 * 64;
    unsigned* selm = (unsigned*)(F.ws + WS_SELM);
    LAS unsigned char* L = F.lds;
    LAS float* scA = (LAS float*)(F.lds + 32768); LAS float* scB = (LAS float*)(F.lds + 40960);
    const int lane = F.lane, w = F.wave, c = lane & 15, g4 = lane >> 4;
    const int pr = 8 * ((c >> 2) & 1) + 4 * (c >> 3) + (c & 3), k7 = pr & 7;
    int kof[2]; kof[0] = pr * 128 + (((0 + g4) ^ k7) << 4); kof[1] = pr * 128 + (((4 + g4) ^ k7) << 4);
    const int q4 = c >> 2, p4 = c & 3, xr = 2 * (g4 & 1) + (g4 >> 1);
    const int vb = 1024 * (g4 & 1) + 64 * (4 * (g4 >> 1) + q4) + 8 * (p4 & 1);
    int vx[2]; vx[0] = 16 * ((0 + (p4 >> 1)) ^ xr); vx[1] = 16 * ((2 + (p4 >> 1)) ^ xr);
    const int kbl = 8 * (g4 & 1) + 4 * (g4 >> 1);
    const int skey = F.tid >> 3, sch = F.tid & 7;
    const int kst = skey * 128 + ((sch ^ (skey & 7)) << 4);
    const int vst = 16384 + 1024 * (skey >> 3) + 512 * (sch >> 2) + 64 * (skey & 7) + 16 * ((sch & 3) ^ ((skey >> 2) & 3));
    for (int unit = F.bid; unit < 1024; unit += F.G) {
        const int qb = 31 - (unit >> 5), b = (unit & 31) >> 1, g = unit & 1, t0 = qb * 64;
        const int ntile = qb >= 16 ? 2 : 1;
        __syncthreads();
        for (int tl = 0; tl < ntile; ++tl) { const bf16* sp = kcb + ((size_t)(b * 2 + g) * 128 + 64 * tl + skey) * 64 + sch * 8;
            *(LAS u32x4*)(L + tl * 8192 + kst) = *(const u32x4*)sp; *(LAS u32x4*)(L + tl * 8192 + vst) = *(const u32x4*)(sp + (vcb - kcb)); }
        __syncthreads();
        const int hq = 4 * g + (c & 3);
        const float slope2 = exp2f(-(float)(hq + 1)) * LOG2E;
#pragma unroll
        for (int nt = 0; nt < 2; ++nt) {
            const int tlq = 8 * w + 4 * nt + (c >> 2), tq = t0 + tlq;
            const bf16* qp = proj + (size_t)(b * S + tq) * PP + C_Q + hq * 64 + 8 * g4;
            bf16x8 qf[2];
#pragma unroll
            for (int ks = 0; ks < 2; ++ks) { const u32x4 v = *(const u32x4*)(qp + 32 * ks); u32x4 o;
                o.x = pk2(bflo(v.x) * 0.125f, bfhi(v.x) * 0.125f); o.y = pk2(bflo(v.y) * 0.125f, bfhi(v.y) * 0.125f); o.z = pk2(bflo(v.z) * 0.125f, bfhi(v.z) * 0.125f); o.w = pk2(bflo(v.w) * 0.125f, bfhi(v.w) * 0.125f);
                qf[ks] = __builtin_bit_cast(bf16x8, o); }
            float sc[2][4][4]; float tmax = -1e30f;
            const int nvalid = tq >= 31 ? ((tq - 31) >> 4) + 1 : 0;
#pragma unroll
            for (int tl = 0; tl < 2; ++tl) {
                if (tl < ntile) {
                    f32x4 sa[4];
#pragma unroll
                    for (int mt = 0; mt < 4; ++mt) sa[mt] = (f32x4){0.f, 0.f, 0.f, 0.f};
#pragma unroll
                    for (int ks = 0; ks < 2; ++ks)
#pragma unroll
                        for (int mt = 0; mt < 4; ++mt) { const bf16x8 kf = *(const LAS bf16x8*)(L + tl * 8192 + mt * 2048 + kof[ks]); sa[mt] = __builtin_amdgcn_mfma_f32_16x16x32_bf16(kf, qf[ks], sa[mt], 0, 0, 0); }
#pragma unroll
                    for (int mt = 0; mt < 4; ++mt)
#pragma unroll
                        for (int i = 0; i < 4; ++i) { const int n = 64 * tl + 16 * mt + kbl + i;
                            const float v = n < nvalid ? sa[mt][i] * LOG2E - slope2 * ((float)(tq - 16 * n) - 15.5f) : -1e30f; sc[tl][mt][i] = v; tmax = fmaxf(tmax, v); }
                } else {
#pragma unroll
                    for (int mt = 0; mt < 4; ++mt)
#pragma unroll
                        for (int i = 0; i < 4; ++i) sc[tl][mt][i] = -1e30f;
                }
            }
            tmax = fmaxf(tmax, __shfl_xor(tmax, 16)); tmax = fmaxf(tmax, __shfl_xor(tmax, 32));
            float ls = 0.f;
#pragma unroll
            for (int tl = 0; tl < 2; ++tl)
#pragma unroll
                for (int mt = 0; mt < 4; ++mt)
#pragma unroll
                    for (int i = 0; i < 4; ++i) { const float p = sc[tl][mt][i] > -1e29f ? __builtin_amdgcn_exp2f(sc[tl][mt][i] - tmax) : 0.f; sc[tl][mt][i] = p; ls += p; }
            ls += __shfl_xor(ls, 16); ls += __shfl_xor(ls, 32);
            const float inv = ls > 0.f ? 1.0f / ls : 0.f;
            f32x4 o[4];
#pragma unroll
            for (int dt = 0; dt < 4; ++dt) o[dt] = (f32x4){0.f, 0.f, 0.f, 0.f};
#pragma unroll
            for (int tl = 0; tl < 2; ++tl) {
                if (tl < ntile) {
#pragma unroll
                    for (int mt = 0; mt < 4; ++mt) {
#pragma unroll
                        for (int i = 0; i < 4; ++i) sc[tl][mt][i] *= inv;
                        float a = sc[tl][mt][0] + sc[tl][mt][1] + sc[tl][mt][2] + 0.5f * sc[tl][mt][3], bb = 0.5f * sc[tl][mt][3];
                        a += __shfl_xor(a, 1); a += __shfl_xor(a, 2); bb += __shfl_xor(bb, 1); bb += __shfl_xor(bb, 2);
                        if ((c & 3) == 0) { const int j = 16 * tl + 4 * mt + 2 * (g4 & 1) + (g4 >> 1); scA[tlq * 32 + j] = a; scB[tlq * 32 + j] = bb; }
                    }
#pragma unroll
                    for (int s = 0; s < 2; ++s) { u32x4 pw; pw.x = pk2(sc[tl][2 * s][0], sc[tl][2 * s][1]); pw.y = pk2(sc[tl][2 * s][2], sc[tl][2 * s][3]); pw.z = pk2(sc[tl][2 * s + 1][0], sc[tl][2 * s + 1][1]); pw.w = pk2(sc[tl][2 * s + 1][2], sc[tl][2 * s + 1][3]);
                        const bf16x8 pf = __builtin_bit_cast(bf16x8, pw);
#pragma unroll
                        for (int dt = 0; dt < 4; ++dt) { const LAS unsigned char* vp = L + 16384 + tl * 8192 + vb + 4096 * s + 512 * (dt >> 1) + vx[dt & 1];
                            const s16x4 lo = __builtin_bit_cast(s16x4, __builtin_amdgcn_ds_read_tr16_b64_v4i16((LAS s16x4*)vp));
                            const s16x4 hi = __builtin_bit_cast(s16x4, __builtin_amdgcn_ds_read_tr16_b64_v4i16((LAS s16x4*)(vp + 2048)));
                            const bf16x8 vf = (bf16x8){lo[0], lo[1], lo[2], lo[3], hi[0], hi[1], hi[2], hi[3]};
                            o[dt] = __builtin_amdgcn_mfma_f32_16x16x32_bf16(vf, pf, o[dt], 0, 0, 0); } }
                }
            }
            const size_t tok = (size_t)(b * S + tq);
            const float sg = sigmoidf_(small[tok * 32 + hq]);
#pragma unroll
            for (int dt = 0; dt < 4; ++dt) *(f32x4*)(oacc + tok * 512 + hq * 64 + 16 * dt + 4 * g4) = o[dt] * sg;
        }
        __syncthreads();
        if (F.tid < 64) { const int tlq = F.tid, t = t0 + tlq, cur = qb; unsigned mask;
            if (cur < 8) mask = (1u << (cur + 1)) - 1u;
            else { mask = 1u | (1u << cur);
                float sv[31];
#pragma unroll
                for (int j = 1; j < 31; ++j) sv[j] = j < cur ? scA[tlq * 32 + j] + scB[tlq * 32 + j - 1] : -1.0f;
#pragma unroll
                for (int it = 0; it < 6; ++it) { float best = -1.0f; int bj = 0;
#pragma unroll
                    for (int j = 1; j < 31; ++j) { const bool ok = sv[j] > best; best = ok ? sv[j] : best; bj = ok ? j : bj; }
                    mask |= 1u << bj;
#pragma unroll
                    for (int j = 1; j < 31; ++j) sv[j] = (j == bj) ? -1.0f : sv[j]; }
                mask &= ~1u; mask |= 1u; }
            selm[(size_t)(b * 2 + g) * S + t] = mask; }
    }
}

struct AttnW { f32x4 o[2][4]; float m[2], l[2]; };
template <int PHASE>
__device__ __forceinline__ void attn_tile(const bool EDGE, AttnW& st, const LAS unsigned char* Kb, const LAS unsigned char* Vb, const LAS bf16x8* qfl, const int (&kof)[2], int vb, const int (&vx)[2],
                                          int kt, int kbl, int t0, const int (&tq)[2], const unsigned (&smask)[2], float slope2) {
    f32x4 bias[4];
    { const float tbs = slope2 * (float)(64 * kt + kbl - t0 - 63);
#pragma unroll
      for (int mt = 0; mt < 4; ++mt)
#pragma unroll
          for (int i = 0; i < 4; ++i) bias[mt][i] = __builtin_fmaf(slope2, (float)(16 * mt + i), tbs); }
#pragma unroll
    for (int nt = 0; nt < 2; ++nt) {
        const bool selb = PHASE == 0 ? true : ((smask[nt] >> kt) & 1u);
        if (PHASE == 1 && !__any(selb)) continue;
        f32x4 sa[4];
#pragma unroll
        for (int mt = 0; mt < 4; ++mt) sa[mt] = bias[mt];
#pragma unroll
        for (int ks = 0; ks < 2; ++ks)
#pragma unroll
            for (int mt = 0; mt < 4; ++mt) { const bf16x8 kf = *(const LAS bf16x8*)(Kb + mt * 2048 + kof[ks]); sa[mt] = __builtin_amdgcn_mfma_f32_16x16x32_bf16(kf, qfl[(nt * 2 + ks) * 64], sa[mt], 0, 0, 0); }
        if (EDGE) { const int dbase = tq[nt] - 64 * kt - kbl;
#pragma unroll
            for (int mt = 0; mt < 4; ++mt)
#pragma unroll
                for (int i = 0; i < 4; ++i) { const int dist = dbase - (16 * mt + i); const bool valid = PHASE == 0 ? (dist >= 0 && dist < 256) : (dist >= 0); sa[mt][i] = valid ? sa[mt][i] : -1e30f; } }
        float tmax = fmaxf(fmaxf(sa[0][0], sa[0][1]), sa[0][2]);
#pragma unroll
        for (int mt = 0; mt < 4; ++mt) { if (mt > 0) tmax = fmaxf(fmaxf(tmax, sa[mt][0]), sa[mt][1]), tmax = fmaxf(tmax, sa[mt][2]); tmax = fmaxf(tmax, sa[mt][3]); }
        if (PHASE == 1) tmax = selb ? tmax : -1e30f;
        tmax = fmaxf(tmax, __shfl_xor(tmax, 16)); tmax = fmaxf(tmax, __shfl_xor(tmax, 32));
        float mn = st.m[nt];
        if (__any(tmax > mn)) { mn = fmaxf(mn, tmax); const float alpha = __builtin_amdgcn_exp2f(st.m[nt] - mn); st.m[nt] = mn; st.l[nt] *= alpha;
#pragma unroll
            for (int dt = 0; dt < 4; ++dt) st.o[nt][dt] *= alpha; }
        if (PHASE == 1) mn = selb ? mn : 3.0e38f;
        float ls = 0.f;
#pragma unroll
        for (int mt = 0; mt < 4; ++mt)
#pragma unroll
            for (int i = 0; i < 4; ++i) { const float p = __builtin_amdgcn_exp2f(sa[mt][i] - mn); sa[mt][i] = p; ls += p; }
        st.l[nt] += ls;
        bf16x8 pf[2];
#pragma unroll
        for (int s = 0; s < 2; ++s) { u32x4 w; w.x = pk2(sa[2 * s][0], sa[2 * s][1]); w.y = pk2(sa[2 * s][2], sa[2 * s][3]); w.z = pk2(sa[2 * s + 1][0], sa[2 * s + 1][1]); w.w = pk2(sa[2 * s + 1][2], sa[2 * s + 1][3]);
            pf[s] = __builtin_bit_cast(bf16x8, w); }
#pragma unroll
        for (int dt = 0; dt < 4; ++dt)
#pragma unroll
            for (int s = 0; s < 2; ++s) { const LAS unsigned char* vp = Vb + vb + 4096 * s + 512 * (dt >> 1) + vx[dt & 1];
                const s16x4 lo = __builtin_bit_cast(s16x4, __builtin_amdgcn_ds_read_tr16_b64_v4i16((LAS s16x4*)vp));
                const s16x4 hi = __builtin_bit_cast(s16x4, __builtin_amdgcn_ds_read_tr16_b64_v4i16((LAS s16x4*)(vp + 2048)));
                const bf16x8 vf = (bf16x8){lo[0], lo[1], lo[2], lo[3], hi[0], hi[1], hi[2], hi[3]};
                st.o[nt][dt] = __builtin_amdgcn_mfma_f32_16x16x32_bf16(vf, pf[s], st.o[nt][dt], 0, 0, 0); }
    }
}

__device__ __forceinline__ void p5_attn(Frame& F, int qslot) {
    constexpr float LOG2E = 1.4426950408889634f, QS = 0.125f * LOG2E;
    const bf16* proj = (const bf16*)(F.ws + WS_PROJ); const float* small = (const float*)(F.ws + WS_SMALL);
    const bf16* kcb = (const bf16*)(F.ws + WS_KCB); const bf16* vcb = kcb + (size_t)16 * 2 * 128 * 64;
    bf16* onsa = (bf16*)(F.ws + WS_OY);
    unsigned* qctr = (unsigned*)(F.ws + WS_CTL) + 8 + qslot;
    LAS unsigned char* L = F.lds;
    volatile LAS unsigned* sched = (volatile LAS unsigned*)(F.lds + 32768);
    LAS unsigned* sml = (LAS unsigned*)(F.lds + 32768 + 256);
    LAS float* scA = (LAS float*)(F.lds + 40960); LAS float* scB = (LAS float*)(F.lds + 49152);
    const int w = F.wave;
    for (;;) {
        __syncthreads();
        if (F.tid == 0) sched[0] = atomicAdd(qctr, 1u);
        __syncthreads();
        const int qi = (int)__builtin_amdgcn_readfirstlane(sched[0]);
        if (qi >= 1408) break;
        const int qa = qi / 11, qr = qi - 11 * qa;
        if (qr == 2 || qr == 6 || qr == 10) {
            const int chunk = 3 * qa + (qr == 2 ? 0 : qr == 6 ? 1 : 2);
            LAS float* scr = (LAS float*)(F.lds + 40960 + w * 8448);
            for (int j = 0; j < 16; ++j) { const int it = chunk * 128 + w * 16 + j;
                if (it < 32 * 1024) { const int e = it >> 10; transpose_item8<2>(F.in[26] + (size_t)e * 1024 * 2048, 2048, 1024, (unsigned char*)(F.ws + WS_WUP) + (size_t)e * 2048 * 1024, 64, it & 1023, scr, F.lane); }
                else { const int r2 = it - 32 * 1024, e = r2 >> 9; transpose_item8<0>(F.in[28] + (size_t)e * 1024 * 1024, 1024, 1024, (unsigned char*)(F.ws + WS_WDN) + (size_t)e * 1024 * 1024, 32, r2 & 511, scr, F.lane); } }
            continue;
        }
        const int unit = 8 * qa + (qr - (qr > 2 ? 1 : 0) - (qr > 6 ? 1 : 0));
        const int lane = opaque_i(F.lane), c = lane & 15, g4 = lane >> 4;
        const int pr = 8 * ((c >> 2) & 1) + 4 * (c >> 3) + (c & 3), k7 = pr & 7;
        int kof[2]; kof[0] = pr * 128 + (((0 + g4) ^ k7) << 4); kof[1] = pr * 128 + (((4 + g4) ^ k7) << 4);
        const int q4 = c >> 2, p4 = c & 3, xr = 2 * (g4 & 1) + (g4 >> 1);
        const int vb = 1024 * (g4 & 1) + 64 * (4 * (g4 >> 1) + q4) + 8 * (p4 & 1);
        int vx[2]; vx[0] = 16 * ((0 + (p4 >> 1)) ^ xr); vx[1] = 16 * ((2 + (p4 >> 1)) ^ xr);
        const int kbl = 8 * (g4 & 1) + 4 * (g4 >> 1);
        const int tid_ = opaque_i(F.tid), skey = tid_ >> 3, sch = tid_ & 7;
        const int kst = skey * 128 + ((sch ^ (skey & 7)) << 4);
        const int vst = 16384 + 1024 * (skey >> 3) + 512 * (sch >> 2) + 64 * (skey & 7) + 16 * ((sch & 3) ^ ((skey >> 2) & 3));
        const int qb = 31 - (unit >> 5), b = (unit & 31) >> 1, g = unit & 1, t0 = qb * 64;
        const int ntile = qb >= 16 ? 2 : 1;
        for (int tl = 0; tl < ntile; ++tl) { const bf16* sp = kcb + ((size_t)(b * 2 + g) * 128 + 64 * tl + skey) * 64 + sch * 8;
            *(LAS u32x4*)(L + tl * 8192 + kst) = *(const u32x4*)sp; *(LAS u32x4*)(L + tl * 8192 + vst) = *(const u32x4*)(sp + (vcb - kcb)); }
        int tq[2]; unsigned smask[2]; LAS bf16x8* qfl = (LAS bf16x8*)(F.lds + 106496 + w * 4096) + lane;
        const int hq = 4 * g + (c & 3);
        const float slope2 = exp2f(-(float)(hq + 1)) * LOG2E;
#pragma unroll
        for (int nt = 0; nt < 2; ++nt) { const int tl = 8 * w + 4 * nt + (c >> 2); tq[nt] = t0 + tl;
            const bf16* qp = proj + (size_t)(b * S + tq[nt]) * PP + C_Q + hq * 64 + 8 * g4;
#pragma unroll
            for (int ks = 0; ks < 2; ++ks) { const u32x4 v = *(const u32x4*)(qp + 32 * ks); u32x4 o;
                o.x = pk2(bflo(v.x) * QS, bfhi(v.x) * QS); o.y = pk2(bflo(v.y) * QS, bfhi(v.y) * QS); o.z = pk2(bflo(v.z) * QS, bfhi(v.z) * QS); o.w = pk2(bflo(v.w) * QS, bfhi(v.w) * QS);
                qfl[(nt * 2 + ks) * 64] = __builtin_bit_cast(bf16x8, o); } }
        const bf16* rowb = proj + (size_t)(b * S + skey) * PP + g * 64 + sch * 8;
        u32x4 rk, rv;
        { const bf16* sp = rowb + (size_t)(64 * qb) * PP + C_KWIN; rk = *(const u32x4*)sp; rv = *(const u32x4*)(sp + 128); }
        __syncthreads();
        f32x4 ocm[2][4];
#pragma unroll
        for (int nt = 0; nt < 2; ++nt) {
            const int tlq = 8 * w + 4 * nt + (c >> 2);
            float sc[2][4][4]; float tmax = -1e30f;
            const int nvalid = tq[nt] >= 31 ? ((tq[nt] - 31) >> 4) + 1 : 0;
#pragma unroll
            for (int tl = 0; tl < 2; ++tl) {
                if (tl < ntile) {
                    f32x4 sa[4];
#pragma unroll
                    for (int mt = 0; mt < 4; ++mt) sa[mt] = (f32x4){0.f, 0.f, 0.f, 0.f};
#pragma unroll
                    for (int ks = 0; ks < 2; ++ks)
#pragma unroll
                        for (int mt = 0; mt < 4; ++mt) { const bf16x8 kf = *(const LAS bf16x8*)(L + tl * 8192 + mt * 2048 + kof[ks]); sa[mt] = __builtin_amdgcn_mfma_f32_16x16x32_bf16(kf, qfl[(nt * 2 + ks) * 64], sa[mt], 0, 0, 0); }
#pragma unroll
                    for (int mt = 0; mt < 4; ++mt)
#pragma unroll
                        for (int i = 0; i < 4; ++i) { const int n = 64 * tl + 16 * mt + kbl + i;
                            const float v = n < nvalid ? sa[mt][i] - slope2 * ((float)(tq[nt] - 16 * n) - 15.5f) : -1e30f; sc[tl][mt][i] = v; tmax = fmaxf(tmax, v); }
                } else {
#pragma unroll
                    for (int mt = 0; mt < 4; ++mt)
#pragma unroll
                        for (int i = 0; i < 4; ++i) sc[tl][mt][i] = -1e30f;
                }
            }
            tmax = fmaxf(tmax, __shfl_xor(tmax, 16)); tmax = fmaxf(tmax, __shfl_xor(tmax, 32));
            float ls = 0.f;
#pragma unroll
            for (int tl = 0; tl < 2; ++tl)
#pragma unroll
                for (int mt = 0; mt < 4; ++mt)
#pragma unroll
                    for (int i = 0; i < 4; ++i) { const float p = sc[tl][mt][i] > -1e29f ? __builtin_amdgcn_exp2f(sc[tl][mt][i] - tmax) : 0.f; sc[tl][mt][i] = p; ls += p; }
            ls += __shfl_xor(ls, 16); ls += __shfl_xor(ls, 32);
            const float inv = ls > 0.f ? 1.0f / ls : 0.f;
#pragma unroll
            for (int dt = 0; dt < 4; ++dt) ocm[nt][dt] = (f32x4){0.f, 0.f, 0.f, 0.f};
#pragma unroll
            for (int tl = 0; tl < 2; ++tl) {
                if (tl < ntile) {
#pragma unroll
                    for (int mt = 0; mt < 4; ++mt) {
#pragma unroll
                        for (int i = 0; i < 4; ++i) sc[tl][mt][i] *= inv;
                        float a = sc[tl][mt][0] + sc[tl][mt][1] + sc[tl][mt][2] + 0.5f * sc[tl][mt][3], bb = 0.5f * sc[tl][mt][3];
                        a += __shfl_xor(a, 1); a += __shfl_xor(a, 2); bb += __shfl_xor(bb, 1); bb += __shfl_xor(bb, 2);
                        if ((c & 3) == 0) { const int j = 16 * tl + 4 * mt + 2 * (g4 & 1) + (g4 >> 1); scA[tlq * 32 + j] = a; scB[tlq * 32 + j] = bb; }
                    }
#pragma unroll
                    for (int s = 0; s < 2; ++s) { u32x4 pw; pw.x = pk2(sc[tl][2 * s][0], sc[tl][2 * s][1]); pw.y = pk2(sc[tl][2 * s][2], sc[tl][2 * s][3]); pw.z = pk2(sc[tl][2 * s + 1][0], sc[tl][2 * s + 1][1]); pw.w = pk2(sc[tl][2 * s + 1][2], sc[tl][2 * s + 1][3]);
                        const bf16x8 pf = __builtin_bit_cast(bf16x8, pw);
#pragma unroll
                        for (int dt = 0; dt < 4; ++dt) { const LAS unsigned char* vp = L + 16384 + tl * 8192 + vb + 4096 * s + 512 * (dt >> 1) + vx[dt & 1];
                            const s16x4 lo = __builtin_bit_cast(s16x4, __builtin_amdgcn_ds_read_tr16_b64_v4i16((LAS s16x4*)vp));
                            const s16x4 hi = __builtin_bit_cast(s16x4, __builtin_amdgcn_ds_read_tr16_b64_v4i16((LAS s16x4*)(vp + 2048)));
                            const bf16x8 vf = (bf16x8){lo[0], lo[1], lo[2], lo[3], hi[0], hi[1], hi[2], hi[3]};
                            ocm[nt][dt] = __builtin_amdgcn_mfma_f32_16x16x32_bf16(vf, pf, ocm[nt][dt], 0, 0, 0); } }
                }
            }
            const float sg = sigmoidf_(small[(size_t)(b * S + tq[nt]) * 32 + hq]);
#pragma unroll
            for (int dt = 0; dt < 4; ++dt) ocm[nt][dt] *= sg;
        }
        __syncthreads();
        if (F.tid < 64) { const int tlq = F.tid, cur = qb; unsigned mask;
            if (cur < 8) mask = (1u << (cur + 1)) - 1u;
            else { mask = 1u | (1u << cur);
                float sv[31];
#pragma unroll
                for (int j = 1; j < 31; ++j) sv[j] = j < cur ? scA[tlq * 32 + j] + scB[tlq * 32 + j - 1] : -1.0f;
#pragma unroll
                for (int it = 0; it < 6; ++it) { float best = -1.0f; int bj = 0;
#pragma unroll
                    for (int j = 1; j < 31; ++j) { const bool ok = sv[j] > best; best = ok ? sv[j] : best; bj = ok ? j : bj; }
                    mask |= 1u << bj;
#pragma unroll
                    for (int j = 1; j < 31; ++j) sv[j] = (j == bj) ? -1.0f : sv[j]; }
                mask &= ~1u; mask |= 1u; }
            sml[tlq] = mask; }
        __syncthreads();
        const unsigned mreg = sml[lane];
        unsigned um = mreg;
#pragma unroll
        for (int o = 1; o < 64; o <<= 1) um |= (unsigned)__shfl_xor((int)um, o);
        um = (unsigned)__builtin_amdgcn_readfirstlane((int)um);
        AttnW st; LAS f32x4* owl = (LAS f32x4*)(F.lds + 40960 + w * 8192) + lane;
#pragma unroll
        for (int nt = 0; nt < 2; ++nt) { smask[nt] = sml[8 * w + 4 * nt + (c >> 2)]; st.m[nt] = -1e30f; st.l[nt] = 0.f;
#pragma unroll
            for (int dt = 0; dt < 4; ++dt) { owl[(nt * 4 + dt) * 64] = ocm[nt][dt]; st.o[nt][dt] = (f32x4){0.f, 0.f, 0.f, 0.f}; } }
        int phase = 0, kt = qb, wleft = qb + 1 < 5 ? qb + 1 : 5; unsigned rem = um;
        int buf = 0;
        while (phase != 2) {
            *(LAS u32x4*)(L + buf * 8192 + kst) = rk; *(LAS u32x4*)(L + buf * 8192 + vst) = rv;
            __syncthreads();
            int nphase = phase, nkt = kt;
            if (phase == 0) { --wleft; if (wleft > 0) nkt = kt - 1; else { nphase = 1; nkt = 31 - __builtin_clz(rem); rem &= ~(1u << nkt); } }
            else { if (rem) { nkt = 31 - __builtin_clz(rem); rem &= ~(1u << nkt); } else nphase = 2; }
            if (nphase != 2) { const bf16* sp = rowb + (size_t)(64 * nkt) * PP + (nphase == 0 ? C_KWIN : C_KSLC); rk = *(const u32x4*)sp; rv = *(const u32x4*)(sp + 128); }
            if (phase == 0) attn_tile<0>(kt == qb || kt == qb - 4, st, L + buf * 8192, L + 16384 + buf * 8192, qfl, kof, vb, vx, kt, kbl, t0, tq, smask, slope2);
            else            attn_tile<1>(kt == qb, st, L + buf * 8192, L + 16384 + buf * 8192, qfl, kof, vb, vx, kt, kbl, t0, tq, smask, slope2);
            if (nphase != phase) {
#pragma unroll
                for (int nt = 0; nt < 2; ++nt) {
                    float lt = st.l[nt]; lt += __shfl_xor(lt, 16); lt += __shfl_xor(lt, 32);
                    const size_t tok = (size_t)(b * S + tq[nt]);
                    if (phase == 0) { const float sg = sigmoidf_(small[tok * 32 + 16 + hq]) / lt;
#pragma unroll
                        for (int dt = 0; dt < 4; ++dt) { owl[(nt * 4 + dt) * 64] += st.o[nt][dt] * sg; st.o[nt][dt] = (f32x4){0.f, 0.f, 0.f, 0.f}; }
                        st.m[nt] = -1e30f; st.l[nt] = 0.f; }
                    else { const float sg = sigmoidf_(small[tok * 32 + 8 + hq]) / lt;
#pragma unroll
                        for (int dt = 0; dt < 4; ++dt) { const size_t oi = tok * 1024 + hq * 64 + 16 * dt + 4 * g4;
                            const f32x4 r = owl[(nt * 4 + dt) * 64] + st.o[nt][dt] * sg;
                            u32x2 o2; o2.x = pk2(r[0], r[1]); o2.y = pk2(r[2], r[3]); *(u32x2*)(onsa + oi) = o2; } }
                }
            }
            phase = nphase; kt = nkt; buf ^= 1;
        }
    }
}

__device__ __forceinline__ int sw256(int r, int col) { return r * 256 + ((((col >> 3) ^ (r & 15))) << 4) + (col & 7) * 2; }
__device__ __forceinline__ void ml_gates(Frame& F, const float* small, size_t tok0, int h, LAS float* Fa, LAS float* ia) {
    if (F.wave == 0) {
        const int l = F.lane; const float fb = F.in[18][h];
        const float f0 = small[(tok0 + 2 * l) * 32 + 28 + h] + fb, f1 = small[(tok0 + 2 * l + 1) * 32 + 28 + h] + fb;
        const float a = fminf(f0, 0.f) - log1pf(__expf(-fabsf(f0))), bq = fminf(f1, 0.f) - log1pf(__expf(-fabsf(f1)));
        float s = a + bq;
#pragma unroll
        for (int o = 1; o < 64; o <<= 1) { const float v = __shfl_up(s, o); if (l >= o) s += v; }
        const float pre = s - (a + bq);
        Fa[2 * l] = pre + a; Fa[2 * l + 1] = pre + a + bq;
        ia[2 * l] = small[(tok0 + 2 * l) * 32 + 24 + h]; ia[2 * l + 1] = small[(tok0 + 2 * l + 1) * 32 + 24 + h];
    }
}

__device__ __forceinline__ void p3_mlstate(Frame& F) {
    const bf16* proj = (const bf16*)(F.ws + WS_PROJ); const float* small = (const float*)(F.ws + WS_SMALL);
    bf16* qml = (bf16*)(F.ws + WS_QML); bf16* kml = (bf16*)(F.ws + WS_KML); bf16* vtg = (bf16*)(F.ws + WS_VML);
    const bf16* wqt = (const bf16*)(F.ws + WS_WQT); const bf16* wkt = wqt + 4 * 16384; const bf16* wvt = wqt + 8 * 16384;
    float* cloct = (float*)(F.ws + WS_CLOC); float* nloc = (float*)(F.ws + WS_NLOC); float* mloc = (float*)(F.ws + WS_MLOC); float* flast = (float*)(F.ws + WS_FLAST);
    const float* cw = F.in[13]; const float* cb = F.in[14];
    LAS unsigned char* L = F.lds;
    LAS float* Fa = (LAS float*)(F.lds + 131072); LAS float* ia = Fa + 128; LAS float* wa = ia + 128; LAS float* red = wa + 128;
    const int lane = F.lane, w = F.wave, c = lane & 15, g4 = lane >> 4;
    for (int u = F.bid; u < 1024; u += F.G) {
        const int b = u >> 6, h = (u >> 4) & 3, ch = u & 15, t0 = ch * 128;
        const size_t tok0 = (size_t)b * S + t0;
        __syncthreads();
        for (int it = F.tid; it < 2048; it += NTHREADS) { const int t = it >> 4, c8 = (it & 15) * 8, cc = h * 128 + c8;
            float a[8]; u32x4 xm3 = (u32x4){0u, 0u, 0u, 0u};
#pragma unroll
            for (int i = 0; i < 8; ++i) a[i] = cb[cc + i];
#pragma unroll
            for (int j = 0; j < 4; ++j) { const int tt = t0 + t - 3 + j;
                if (tt >= 0) { const u32x4 xv = *(const u32x4*)(proj + ((size_t)b * S + tt) * PP + C_XM + cc);
                    const f32x4 w0 = *(const f32x4*)(cw + j * 512 + cc), w1 = *(const f32x4*)(cw + j * 512 + cc + 4);
                    a[0] += w0.x * bflo(xv.x); a[1] += w0.y * bfhi(xv.x); a[2] += w0.z * bflo(xv.y); a[3] += w0.w * bfhi(xv.y);
                    a[4] += w1.x * bflo(xv.z); a[5] += w1.y * bfhi(xv.z); a[6] += w1.z * bflo(xv.w); a[7] += w1.w * bfhi(xv.w);
                    if (j == 3) xm3 = xv; } }
#pragma unroll
            for (int i = 0; i < 8; ++i) a[i] = a[i] * __builtin_amdgcn_rcpf(1.0f + __expf(-a[i]));
            u32x4 o; o.x = pk2(a[0], a[1]); o.y = pk2(a[2], a[3]); o.z = pk2(a[4], a[5]); o.w = pk2(a[6], a[7]);
            *(LAS u32x4*)(L + sw256(t, c8)) = xm3; *(LAS u32x4*)(L + 32768 + sw256(t, c8)) = o; }
        ml_gates(F, small, tok0, h, Fa, ia);
        if (F.wave == 0) { LDS_WAIT(); const float FL = Fa[127]; float m = fmaxf(FL - Fa[2 * lane] + ia[2 * lane], FL - Fa[2 * lane + 1] + ia[2 * lane + 1]);
#pragma unroll
            for (int o = 1; o < 64; o <<= 1) m = fmaxf(m, __shfl_xor(m, o));
            wa[2 * lane] = __expf(FL - Fa[2 * lane] + ia[2 * lane] - m); wa[2 * lane + 1] = __expf(FL - Fa[2 * lane + 1] + ia[2 * lane + 1] - m);
            if (lane == 0) { mloc[u] = m; flast[u] = FL; } }
        __syncthreads();
        {
            const size_t wo = (size_t)(h * 128 + 16 * w + c) * 128 + 8 * g4;
            const size_t ro0 = ((size_t)(b * 4 + h) * S + t0) * 128 + 16 * w + 4 * g4; const int e = 16 * w + 4 * g4;
            f32x4 acc[8];
#pragma unroll
            for (int tt = 0; tt < 8; ++tt) acc[tt] = (f32x4){0.f, 0.f, 0.f, 0.f};
#pragma unroll
            for (int ks = 0; ks < 4; ++ks) { const bf16x8 wf = *(const bf16x8*)(wqt + wo + 32 * ks);
#pragma unroll
                for (int tt = 0; tt < 8; ++tt) acc[tt] = __builtin_amdgcn_mfma_f32_16x16x32_bf16(wf, *(const LAS bf16x8*)(L + 32768 + sw256(16 * tt + c, 32 * ks + 8 * g4)), acc[tt], 0, 0, 0); }
#pragma unroll
            for (int tt = 0; tt < 8; ++tt) { u32x2 qv; qv.x = pk2(acc[tt][0], acc[tt][1]); qv.y = pk2(acc[tt][2], acc[tt][3]); *(u32x2*)(qml + ro0 + (size_t)(16 * tt + c) * 128) = qv; }
#pragma unroll
            for (int tt = 0; tt < 8; ++tt) acc[tt] = (f32x4){0.f, 0.f, 0.f, 0.f};
#pragma unroll
            for (int ks = 0; ks < 4; ++ks) { const bf16x8 wf = *(const bf16x8*)(wkt + wo + 32 * ks);
#pragma unroll
                for (int tt = 0; tt < 8; ++tt) acc[tt] = __builtin_amdgcn_mfma_f32_16x16x32_bf16(wf, *(const LAS bf16x8*)(L + 32768 + sw256(16 * tt + c, 32 * ks + 8 * g4)), acc[tt], 0, 0, 0); }
#pragma unroll
            for (int tt = 0; tt < 8; ++tt) { const int t = 16 * tt + c; const float wt = wa[t];
                const float k0 = acc[tt][0] * 0.08838834764831845f, k1 = acc[tt][1] * 0.08838834764831845f, k2 = acc[tt][2] * 0.08838834764831845f, k3 = acc[tt][3] * 0.08838834764831845f;
                u32x2 kv; kv.x = pk2(k0, k1); kv.y = pk2(k2, k3); *(u32x2*)(kml + ro0 + (size_t)t * 128) = kv;
                *(LAS bf16*)(L + 65536 + sw256(e + 0, t)) = (bf16)f2bf(k0 * wt); *(LAS bf16*)(L + 65536 + sw256(e + 1, t)) = (bf16)f2bf(k1 * wt);
                *(LAS bf16*)(L + 65536 + sw256(e + 2, t)) = (bf16)f2bf(k2 * wt); *(LAS bf16*)(L + 65536 + sw256(e + 3, t)) = (bf16)f2bf(k3 * wt); }
#pragma unroll
            for (int tt = 0; tt < 8; ++tt) acc[tt] = (f32x4){0.f, 0.f, 0.f, 0.f};
#pragma unroll
            for (int ks = 0; ks < 4; ++ks) { const bf16x8 wf = *(const bf16x8*)(wvt + wo + 32 * ks);
#pragma unroll
                for (int tt = 0; tt < 8; ++tt) acc[tt] = __builtin_amdgcn_mfma_f32_16x16x32_bf16(*(const LAS bf16x8*)(L + sw256(16 * tt + c, 32 * ks + 8 * g4)), wf, acc[tt], 0, 0, 0); }
#pragma unroll
            for (int tt = 0; tt < 8; ++tt) { u32x2 vv; vv.x = pk2(acc[tt][0], acc[tt][1]); vv.y = pk2(acc[tt][2], acc[tt][3]); *(LAS u32x2*)(L + 98304 + sw256(16 * w + c, 16 * tt + 4 * g4)) = vv; }
        }
        __syncthreads();
        {
            f32x4 ac[8];
#pragma unroll
            for (int et = 0; et < 8; ++et) ac[et] = (f32x4){0.f, 0.f, 0.f, 0.f};
#pragma unroll
            for (int ks = 0; ks < 4; ++ks) {
                const bf16x8 kf = *(const LAS bf16x8*)(L + 65536 + sw256(16 * w + c, 32 * ks + 8 * g4));
#pragma unroll
                for (int et = 0; et < 8; ++et) { const bf16x8 vf = *(const LAS bf16x8*)(L + 98304 + sw256(16 * et + c, 32 * ks + 8 * g4)); ac[et] = __builtin_amdgcn_mfma_f32_16x16x32_bf16(kf, vf, ac[et], 0, 0, 0); }
            }
#pragma unroll
            for (int et = 0; et < 8; ++et) *(f32x4*)(cloct + (size_t)u * 16384 + (size_t)(16 * et + c) * 128 + 16 * w + 4 * g4) = ac[et];
        }
        if (F.tid < 128) { float s = 0.f;
#pragma unroll
            for (int k = 0; k < 16; ++k) { const u32x4 v = *(const LAS u32x4*)(L + 65536 + F.tid * 256 + k * 16); s += (bflo(v.x) + bfhi(v.x)) + (bflo(v.y) + bfhi(v.y)) + (bflo(v.z) + bfhi(v.z)) + (bflo(v.w) + bfhi(v.w)); }
            nloc[u * 128 + F.tid] = s; }
#pragma unroll
        for (int j = 0; j < 4; ++j) { const int id = F.tid + NTHREADS * j, e = id >> 4, ci = id & 15;
            *(u32x4*)(vtg + (size_t)u * 16384 + e * 128 + ci * 8) = *(const LAS u32x4*)(L + 98304 + e * 256 + ((ci ^ (e & 15)) << 4)); }
    }
}

__device__ __forceinline__ void p4_mlscan(Frame& F) {
    const float* cloct = (const float*)(F.ws + WS_CLOC); const float* nloc = (const float*)(F.ws + WS_NLOC); const float* mloc = (const float*)(F.ws + WS_MLOC); const float* flast = (const float*)(F.ws + WS_FLAST);
    bf16* cint = (bf16*)(F.ws + WS_CIN); float* nin = (float*)(F.ws + WS_NIN); float* min_ = (float*)(F.ws + WS_MIN);
    const int gtid = F.bid * NTHREADS + F.tid, gsz = F.G * NTHREADS;
    for (int idx = gtid; idx < 64 * (8192 + 64); idx += gsz) {
        const int bh = idx / (8192 + 64), de = (idx - bh * (8192 + 64)) * 2;
        float C0 = 0.f, C1 = 0.f, m = 0.f;
        for (int cch = 0; cch < 16; ++cch) { const int u = bh * 16 + cch;
            f32x2 loc;
            if (de < 16384) { *(unsigned*)(cint + (size_t)u * 16384 + de) = pk2(C0, C1); loc = *(const f32x2*)(cloct + (size_t)u * 16384 + de); if (de == 0) min_[u] = m; }
            else { *(f32x2*)(nin + u * 128 + (de - 16384)) = (f32x2){C0, C1}; loc = *(const f32x2*)(nloc + u * 128 + (de - 16384)); }
            const float FL = flast[u], ml = mloc[u], mn = fmaxf(FL + m, ml), dA = __expf(FL + m - mn), dB = __expf(ml - mn);
            C0 = dA * C0 + dB * loc.x; C1 = dA * C1 + dB * loc.y; m = mn; }
    }
}

__device__ __forceinline__ void p5_mlout(Frame& F) {
    const bf16* proj = (const bf16*)(F.ws + WS_PROJ); const float* small = (const float*)(F.ws + WS_SMALL);
    const bf16* qml = (const bf16*)(F.ws + WS_QML); const bf16* kml = (const bf16*)(F.ws + WS_KML); const bf16* vtg = (const bf16*)(F.ws + WS_VML);
    const bf16* cint = (const bf16*)(F.ws + WS_CIN); const float* nin = (const float*)(F.ws + WS_NIN); const float* min_ = (const float*)(F.ws + WS_MIN);
    bf16* yml = (bf16*)(F.ws + WS_OY) + 512;
    LAS unsigned char* L = F.lds;
    LAS float* Fa = (LAS float*)(F.lds + 98304); LAS float* ia = Fa + 128; LAS float* pm = ia + 128;
    const int lane = F.lane, w = F.wave, c = lane & 15, g4 = lane >> 4;
    for (int u = F.bid; u < 1024; u += F.G) {
        const int b = u >> 6, h = (u >> 4) & 3, ch = u & 15, t0 = ch * 128;
        const size_t tok0 = (size_t)b * S + t0; const size_t bhrow = ((size_t)(b * 4 + h) * S + t0);
        __syncthreads();
#pragma unroll
        for (int j = 0; j < 4; ++j) { const int id = F.tid + NTHREADS * j, r = id >> 4, ci = id & 15;
            *(LAS u32x4*)(L + r * 256 + ((ci ^ (r & 15)) << 4)) = *(const u32x4*)(kml + (bhrow + r) * 128 + ci * 8);
            *(LAS u32x4*)(L + 32768 + r * 256 + ((ci ^ (r & 15)) << 4)) = *(const u32x4*)(vtg + (size_t)u * 16384 + r * 128 + ci * 8);
            *(LAS u32x4*)(L + 65536 + r * 256 + ((ci ^ (r & 15)) << 4)) = *(const u32x4*)(cint + (size_t)u * 16384 + r * 128 + ci * 8); }
        ml_gates(F, small, tok0, h, Fa, ia);
        __syncthreads();
        if (F.wave == 0) {
            const float g0 = ia[2 * lane] - Fa[2 * lane], g1 = ia[2 * lane + 1] - Fa[2 * lane + 1];
            float s = fmaxf(g0, g1);
#pragma unroll
            for (int o = 1; o < 64; o <<= 1) { const float v = __shfl_up(s, o); if (lane >= o) s = fmaxf(s, v); }
            const float prev = __shfl_up(s, 1);
            pm[2 * lane] = lane > 0 ? fmaxf(prev, g0) : g0; pm[2 * lane + 1] = s;
            ia[2 * lane] = g0; ia[2 * lane + 1] = g1; }
        __syncthreads();
        const int t = 16 * w + c;
        const float mm = min_[u], mref = fmaxf(mm, pm[t]), wi = __expf(mm - mref);
        bf16x8 qf[4]; float qn = 0.f;
#pragma unroll
        for (int ks = 0; ks < 4; ++ks) { const u32x4 qv = *(const u32x4*)(qml + (bhrow + t) * 128 + 32 * ks + 8 * g4); qf[ks] = __builtin_bit_cast(bf16x8, qv);
            const f32x4 n0 = *(const f32x4*)(nin + u * 128 + 32 * ks + 8 * g4), n1 = *(const f32x4*)(nin + u * 128 + 32 * ks + 8 * g4 + 4);
            qn += bflo(qv.x) * n0.x + bfhi(qv.x) * n0.y + bflo(qv.y) * n0.z + bfhi(qv.y) * n0.w + bflo(qv.z) * n1.x + bfhi(qv.z) * n1.y + bflo(qv.w) * n1.z + bfhi(qv.w) * n1.w; }
        qn += __shfl_xor(qn, 16); qn += __shfl_xor(qn, 32);
        f32x4 aI[8], aP[8];
#pragma unroll
        for (int et = 0; et < 8; ++et) { aI[et] = (f32x4){0.f, 0.f, 0.f, 0.f}; aP[et] = aI[et]; }
#pragma unroll
        for (int ks = 0; ks < 4; ++ks)
            {
#pragma unroll
              for (int et = 0; et < 8; ++et) aI[et] = __builtin_amdgcn_mfma_f32_16x16x32_bf16(*(const LAS bf16x8*)(L + 65536 + sw256(16 * et + c, 32 * ks + 8 * g4)), qf[ks], aI[et], 0, 0, 0); __builtin_amdgcn_sched_barrier(0); }
        float den = 0.f;
        for (int ss = 0; 2 * ss <= w; ++ss) {
            float p[2][4];
#pragma unroll
            for (int hh = 0; hh < 2; ++hh) { const int st = 2 * ss + hh;
                if (st <= w) { f32x4 sa = (f32x4){0.f, 0.f, 0.f, 0.f};
#pragma unroll
                    for (int ks = 0; ks < 4; ++ks) sa = __builtin_amdgcn_mfma_f32_16x16x32_bf16(*(const LAS bf16x8*)(L + sw256(16 * st + c, 32 * ks + 8 * g4)), qf[ks], sa, 0, 0, 0);
#pragma unroll
                    for (int i = 0; i < 4; ++i) { const int s = 16 * st + 4 * g4 + i; const float v = s <= t ? sa[i] * __expf(ia[s] - mref) : 0.f; p[hh][i] = v; den += v; } }
                else {
#pragma unroll
                    for (int i = 0; i < 4; ++i) p[hh][i] = 0.f; } }
            u32x4 pw; pw.x = pk2(p[0][0], p[0][1]); pw.y = pk2(p[0][2], p[0][3]); pw.z = pk2(p[1][0], p[1][1]); pw.w = pk2(p[1][2], p[1][3]);
            const bf16x8 pf = __builtin_bit_cast(bf16x8, pw);
#pragma unroll
            for (int et = 0; et < 8; ++et) { const u32x2 lo = *(const LAS u32x2*)(L + 32768 + sw256(16 * et + c, 32 * ss + 4 * g4)), hi = *(const LAS u32x2*)(L + 32768 + sw256(16 * et + c, 32 * ss + 16 + 4 * g4));
                const u32x4 vw = (u32x4){lo.x, lo.y, hi.x, hi.y};
                aP[et] = __builtin_amdgcn_mfma_f32_16x16x32_bf16(__builtin_bit_cast(bf16x8, vw), pf, aP[et], 0, 0, 0); }
        }
        den += __shfl_xor(den, 16); den += __shfl_xor(den, 32);
        den += wi * qn;
        const float mt = Fa[t] + mref, dd = 1.0f / fmaxf(fabsf(den), __expf(-mt));
        float s1 = 0.f;
#pragma unroll
        for (int et = 0; et < 8; ++et)
#pragma unroll
            for (int i = 0; i < 4; ++i) { const float v = (aP[et][i] + wi * aI[et][i]) * dd; aP[et][i] = v; s1 += v; }
        s1 += __shfl_xor(s1, 16); s1 += __shfl_xor(s1, 32);
        const float mu = s1 * (1.0f / 128.0f); float s2 = 0.f;
#pragma unroll
        for (int et = 0; et < 8; ++et)
#pragma unroll
            for (int i = 0; i < 4; ++i) { const float v = aP[et][i] - mu; aP[et][i] = v; s2 += v * v; }
        s2 += __shfl_xor(s2, 16); s2 += __shfl_xor(s2, 32);
        const float rstd = rsqrtf(s2 * (1.0f / 128.0f) + 1e-5f);
        const size_t tok = tok0 + t;
#pragma unroll
        for (int et = 0; et < 8; ++et) { const int col = h * 128 + 16 * et + 4 * g4;
            const unsigned ow8 = *(const unsigned*)((const unsigned char*)(F.ws + WS_GATE8) + tok * GP + G_OPRE + col); const f32x2 o01 = __builtin_amdgcn_cvt_pk_f32_fp8((int)ow8, false), o23 = __builtin_amdgcn_cvt_pk_f32_fp8((int)ow8, true); const f32x4 ng = *(const f32x4*)(F.in[19] + col);
            u32x2 y; y.x = pk2(sigmoidf_(o01.x) * aP[et][0] * rstd * ng.x, sigmoidf_(o01.y) * aP[et][1] * rstd * ng.y);
            y.y = pk2(sigmoidf_(o23.x) * aP[et][2] * rstd * ng.z, sigmoidf_(o23.y) * aP[et][3] * rstd * ng.w);
            *(u32x2*)(yml + tok * 1024 + col) = y; }
    }
}

__device__ __forceinline__ void p9_route(Frame& F, const bool dup) {
    const bf16* x1 = (const bf16*)(F.ws + WS_OY); const float* mod = (const float*)(F.ws + WS_MOD); const float* g2 = F.in[23]; const float* rb = F.in[25];
    const bf16* rwh = (const bf16*)(F.ws + WS_RWT); const bf16* rwl = rwh + 32 * 1024;
    bf16* h2 = (bf16*)(F.ws + WS_XN);
    int* re = (int*)(F.ws + (dup ? WS_ACT : WS_RE)); float* rwt = (float*)(F.ws + (dup ? WS_ACT + MiB : WS_RW)); int* rs = (int*)(F.ws + (dup ? WS_ACT + 2 * MiB : WS_RS)); unsigned* cnt = (unsigned*)(F.ws + WS_CTL) + (dup ? 16 : 0);
    const int gw = F.bid * NWAVES + F.wave, NGW = F.G * NWAVES, lane = F.lane, c = lane & 15, g4 = lane >> 4;
    LAS unsigned* lcnt = (LAS unsigned*)F.lds;
    for (int grp = gw; grp < T / 16; grp += NGW) {
        const int tkn = grp * 16 + c, b = tkn >> 11;
        const bf16* xr = x1 + (size_t)tkn * D + 8 * g4; const float* sh = mod + (size_t)b * 6144 + 3 * 1024 + 8 * g4; const float* scp = mod + (size_t)b * 6144 + 4 * 1024 + 8 * g4;
        float ss = 0.f;
#pragma unroll 8
        for (int ks = 0; ks < 32; ++ks) { const u32x4 xv = *(const u32x4*)(xr + 32 * ks); const f32x4 a = (f32x4){bflo(xv.x), bfhi(xv.x), bflo(xv.y), bfhi(xv.y)}, bq = (f32x4){bflo(xv.z), bfhi(xv.z), bflo(xv.w), bfhi(xv.w)};
            ss += (a.x * a.x + a.y * a.y) + (a.z * a.z + a.w * a.w) + (bq.x * bq.x + bq.y * bq.y) + (bq.z * bq.z + bq.w * bq.w); }
        ss += __shfl_xor(ss, 16); ss += __shfl_xor(ss, 32);
        const float rsq = rsqrtf(ss * (1.0f / D) + 1e-5f);
        f32x4 acc[2]; acc[0] = (f32x4){0.f, 0.f, 0.f, 0.f}; acc[1] = acc[0];
#pragma unroll 4
        for (int ks = 0; ks < 32; ++ks) {
            float y[8];
            { const u32x4 xv = *(const u32x4*)(xr + 32 * ks); const f32x4 a = (f32x4){bflo(xv.x), bfhi(xv.x), bflo(xv.y), bfhi(xv.y)}, bq = (f32x4){bflo(xv.z), bfhi(xv.z), bflo(xv.w), bfhi(xv.w)};
              const f32x4 ga = *(const f32x4*)(g2 + 32 * ks + 8 * g4), gb = *(const f32x4*)(g2 + 32 * ks + 8 * g4 + 4);
              const f32x4 sa = *(const f32x4*)(scp + 32 * ks), sb = *(const f32x4*)(scp + 32 * ks + 4), ha = *(const f32x4*)(sh + 32 * ks), hb = *(const f32x4*)(sh + 32 * ks + 4);
#pragma unroll
              for (int i = 0; i < 4; ++i) { y[i] = a[i] * rsq * ga[i] * (1.0f + sa[i]) + ha[i]; y[4 + i] = bq[i] * rsq * gb[i] * (1.0f + sb[i]) + hb[i]; } }
            unsigned hi[8], lo[8];
#pragma unroll
            for (int i = 0; i < 8; ++i) { hi[i] = f2bf(y[i]); lo[i] = f2bf(y[i] - __builtin_bit_cast(float, hi[i] << 16)); }
            const u32x4 yhw = (u32x4){hi[0] | (hi[1] << 16), hi[2] | (hi[3] << 16), hi[4] | (hi[5] << 16), hi[6] | (hi[7] << 16)};
            const u32x4 ylw = (u32x4){lo[0] | (lo[1] << 16), lo[2] | (lo[3] << 16), lo[4] | (lo[5] << 16), lo[6] | (lo[7] << 16)};
            { u32x2 y8; y8.x = pk4_fp8(y[0], y[1], y[2], y[3]); y8.y = pk4_fp8(y[4], y[5], y[6], y[7]); *(u32x2*)((unsigned char*)h2 + (size_t)tkn * D + 32 * ks + 8 * g4) = y8; }
            const bf16x8 yh = __builtin_bit_cast(bf16x8, yhw), yl = __builtin_bit_cast(bf16x8, ylw);
#pragma unroll
            for (int et = 0; et < 2; ++et) { const size_t wo = (size_t)(16 * et + c) * 1024 + 32 * ks + 8 * g4;
                const bf16x8 wh = *(const bf16x8*)(rwh + wo), wl = *(const bf16x8*)(rwl + wo);
                acc[et] = __builtin_amdgcn_mfma_f32_16x16x32_bf16(wh, yh, acc[et], 0, 0, 0);
                acc[et] = __builtin_amdgcn_mfma_f32_16x16x32_bf16(wl, yh, acc[et], 0, 0, 0);
                acc[et] = __builtin_amdgcn_mfma_f32_16x16x32_bf16(wh, yl, acc[et], 0, 0, 0); }
        }
        float lg[32];
#pragma unroll
        for (int gs = 0; gs < 4; ++gs)
#pragma unroll
            for (int et = 0; et < 2; ++et)
#pragma unroll
                for (int i = 0; i < 4; ++i) { const int e = 16 * et + 4 * gs + i; lg[e] = __shfl(acc[et][i], c + 16 * gs) + rb[e]; }
        int te[4]; float tv[4]; unsigned used = 0u;
#pragma unroll
        for (int k = 0; k < 4; ++k) { float best = -3.0e38f; int bi = 0;
#pragma unroll
            for (int e = 0; e < 32; ++e) { const bool ok = !((used >> e) & 1u) && lg[e] > best; best = ok ? lg[e] : best; bi = ok ? e : bi; }
            te[k] = bi; tv[k] = best; used |= 1u << bi; }
        const float e1 = __expf(tv[1] - tv[0]), e2 = __expf(tv[2] - tv[0]), e3 = __expf(tv[3] - tv[0]); const float inv = 1.0f / (1.0f + e1 + e2 + e3);
        { const int ek = g4 == 0 ? te[0] : g4 == 1 ? te[1] : g4 == 2 ? te[2] : te[3];
          const float wk = (g4 == 0 ? 1.0f : g4 == 1 ? e1 : g4 == 2 ? e2 : e3) * inv;
          __syncthreads();
          if (F.tid < 32) lcnt[F.tid] = 0u;
          __syncthreads();
          const unsigned rnk = __hip_atomic_fetch_add(lcnt + ek, 1u, __ATOMIC_RELAXED, __HIP_MEMORY_SCOPE_WORKGROUP);
          __syncthreads();
          if (F.tid < 32) lcnt[32 + F.tid] = atomicAdd(cnt + F.tid * 32, lcnt[F.tid]);
          __syncthreads();
          const unsigned slot = lcnt[32 + ek] + rnk;
          re[tkn * 4 + g4] = ek; rwt[tkn * 4 + g4] = wk; rs[tkn * 4 + g4] = (int)slot; }
    }
}

__device__ __forceinline__ void p10_gather(Frame& F) {
    const unsigned* cnt = (const unsigned*)(F.ws + WS_CTL);
    const int* re = (const int*)(F.ws + WS_RE); const int* rs = (const int*)(F.ws + WS_RS); int* dest = (int*)(F.ws + WS_DEST); int* blke = (int*)(F.ws + WS_BLKE);
    int* rowidx = (int*)(F.ws + WS_ROWIDX);
    LAS int* off = (LAS int*)F.lds;
    __syncthreads();
    if (F.tid == 0) { int o = 0; for (int e = 0; e < 32; ++e) { const int c = (int)__hip_atomic_load(cnt + e * 32, __ATOMIC_RELAXED, __HIP_MEMORY_SCOPE_AGENT); const int p = (c + 255) & ~255; off[e] = o; off[32 + e] = c; off[64 + e] = p; o += p; } off[96] = o; }
    __syncthreads();
    if (F.bid == 0) { const int nblk = off[96] >> 8;
        for (int i = F.tid; i < nblk; i += NTHREADS) { int e = 0; for (int k = 1; k < 32; ++k) if (i * 256 >= off[k]) e = k; blke[i] = e; }
        if (F.tid == 0) blke[1000] = nblk; }
    const int gtid = F.bid * NTHREADS + F.tid, gsz = F.G * NTHREADS;
    for (int i = gtid; i < T * 4; i += gsz) { const int dr = off[re[i]] + rs[i]; dest[i] = dr; rowidx[dr] = i >> 2; }
    for (int i = gtid; i < 32 * 256; i += gsz) { const int e = i >> 8, r = i & 255; if (off[32 + e] + r < off[64 + e]) rowidx[off[e] + off[32 + e] + r] = 0; }
}

__device__ __forceinline__ void p13_final(Frame& F, const bool dup) {
    const float* mod = (const float*)(F.ws + WS_MOD); const float* fg = F.in[30];
    const float* rwt = (const float*)(F.ws + WS_RW); const int* dest = (const int*)(F.ws + WS_DEST); const bf16* ypad = (const bf16*)(F.ws + WS_PROJ);
    const int gw = F.bid * NWAVES + F.wave, NGW = F.G * NWAVES, lane = F.lane;
    for (int grp = gw; grp < T / 16; grp += NGW) {
        const int dl = dest[grp * 64 + lane]; const float wl = rwt[grp * 64 + lane];
        const int b = (grp * 16) >> 11; const float* g2 = mod + (size_t)b * 6144 + 5 * 1024;
#pragma unroll 4
        for (int tk = 0; tk < 16; ++tk) {
            const int tkn = grp * 16 + tk; const bf16* xr = (const bf16*)(F.ws + WS_OY) + (size_t)tkn * D; float* xo = (dup ? (float*)(F.ws + WS_ACT) : F.out) + (size_t)tkn * D;
            float acc[16];
#pragma unroll
            for (int i = 0; i < 16; ++i) acc[i] = 0.f;
#pragma unroll
            for (int k = 0; k < 4; ++k) { const int dr = __shfl(dl, 4 * tk + k); const float w = __shfl(wl, 4 * tk + k); const u32x4* yp = (const u32x4*)(ypad + (size_t)dr * D);
#pragma unroll
                for (int j = 0; j < 2; ++j) { const u32x4 y = yp[64 * j + lane];
                    acc[8 * j + 0] += w * bflo(y.x); acc[8 * j + 1] += w * bfhi(y.x); acc[8 * j + 2] += w * bflo(y.y); acc[8 * j + 3] += w * bfhi(y.y);
                    acc[8 * j + 4] += w * bflo(y.z); acc[8 * j + 5] += w * bfhi(y.z); acc[8 * j + 6] += w * bflo(y.w); acc[8 * j + 7] += w * bfhi(y.w); } }
            float ss = 0.f;
#pragma unroll
            for (int j = 0; j < 2; ++j) { const int d0 = (64 * j + lane) * 8; const u32x4 xw = *(const u32x4*)(xr + d0);
#pragma unroll
                for (int q = 0; q < 2; ++q) { const f32x4 xv = q == 0 ? (f32x4){bflo(xw.x), bfhi(xw.x), bflo(xw.y), bfhi(xw.y)} : (f32x4){bflo(xw.z), bfhi(xw.z), bflo(xw.w), bfhi(xw.w)}; const f32x4 gv = *(const f32x4*)(g2 + d0 + 4 * q);
#pragma unroll
                    for (int i = 0; i < 4; ++i) { const float y = xv[i] + gv[i] * acc[8 * j + 4 * q + i]; acc[8 * j + 4 * q + i] = y; ss += y * y; } } }
            const float rsq = rsqrtf(wave_sum(ss) * (1.0f / D) + 1e-5f);
#pragma unroll
            for (int j = 0; j < 2; ++j) { const int d0 = (64 * j + lane) * 8;
#pragma unroll
                for (int q = 0; q < 2; ++q) { const f32x4 gv = *(const f32x4*)(fg + d0 + 4 * q);
                    *(f32x4*)(xo + d0 + 4 * q) = (f32x4){acc[8 * j + 4 * q] * rsq * gv.x, acc[8 * j + 4 * q + 1] * rsq * gv.y, acc[8 * j + 4 * q + 2] * rsq * gv.z, acc[8 * j + 4 * q + 3] * rsq * gv.w}; } }
        }
    }
}

#define XB_TMO      128
#define XB_XCNT(j)  (256  + 64 * (j))
#define XB_XSUB(j)  (1280 + 64 * (j))
#define XB_XGEN(j)  (2304 + 64 * (j))
#define XB_TOP      3328
#define XB_TOPGEN   3392
#define XCD_BAR_WORDS 3456
#define XB_SPIN_CAP (1u << 18)
__device__ __forceinline__ unsigned xb_ld(unsigned* p)              { return __hip_atomic_load(p, __ATOMIC_RELAXED, __HIP_MEMORY_SCOPE_AGENT); }
__device__ __forceinline__ unsigned xb_add(unsigned* p, unsigned v) { return __hip_atomic_fetch_add(p, v, __ATOMIC_RELAXED, __HIP_MEMORY_SCOPE_AGENT); }
__device__ __forceinline__ unsigned xb_xcc_id() { return (unsigned)__builtin_amdgcn_s_getreg((3 << 11) | 20) & 0xFu; }
#define XB_SPIN(cond, bar) do { unsigned _sp = 0; while (cond) { __builtin_amdgcn_s_sleep(1); \
    if ((++_sp & 255u) == 0u) { if (xb_ld(&(bar)[XB_TMO])) break; if (_sp > XB_SPIN_CAP) { atomicAdd(&(bar)[XB_TMO], 1u); break; } } } } while (0)
struct XcdBarrier { unsigned* bar; unsigned x; volatile LAS unsigned* st; };
__device__ __forceinline__ XcdBarrier xcd_barrier_post(unsigned* bar, volatile LAS unsigned* st) {
    XcdBarrier b; b.bar = bar; b.x = xb_xcc_id(); b.st = st;
    if (threadIdx.x == 0) (void)xb_add(&bar[XB_XCNT(b.x)], 1u);
    return b;
}
__device__ __forceinline__ void xcd_barrier_complete(unsigned* bar, unsigned x, unsigned& nloc, unsigned& nx) {
    const unsigned G = gridDim.x * gridDim.y * gridDim.z;
    unsigned sum, cnt, mine, sp = 0u;
    for (;;) {
        sum = 0u; cnt = 0u; mine = 0u;
#pragma unroll
        for (unsigned j = 0; j < 16; ++j) { const unsigned c = xb_ld(&bar[XB_XCNT(j)]); sum += c; cnt += (c > 0u) ? 1u : 0u; mine = (j == x) ? c : mine; }
        if (sum == G) break;
        __builtin_amdgcn_s_sleep(1);
        if ((++sp & 255u) == 0u) { if (xb_ld(&bar[XB_TMO])) break; if (sp > XB_SPIN_CAP) { atomicAdd(&bar[XB_TMO], 1u); break; } }
    }
    nloc = mine > 0u ? mine : 1u; nx = cnt > 0u ? cnt : 1u;
}
__device__ __forceinline__ void xcd_barrier(const XcdBarrier& b) {
    asm volatile("s_waitcnt vmcnt(0)" ::: "memory");
    __syncthreads();
    if (threadIdx.x == 0) {
        unsigned* bar = b.bar;
        __builtin_amdgcn_s_waitcnt(0);
        unsigned nloc = b.st[0], nx = b.st[1];
        if (nloc == 0u) { xcd_barrier_complete(bar, b.x, nloc, nx); b.st[0] = nloc; b.st[1] = nx; }
        const unsigned old = xb_add(&bar[XB_XSUB(b.x)], 1u);
        const unsigned gen = old / nloc;
        if (old + 1u == (gen + 1u) * nloc) {
            __builtin_amdgcn_fence(__ATOMIC_RELEASE, "agent");
            asm volatile("s_waitcnt vmcnt(0)" ::: "memory");
            const unsigned og = xb_add(&bar[XB_TOP], 1u);
            const unsigned tg = og / nx;
            if (og + 1u == (tg + 1u) * nx) xb_add(&bar[XB_TOPGEN], 1u);
            else XB_SPIN(xb_ld(&bar[XB_TOPGEN]) == tg, bar);
            __builtin_amdgcn_fence(__ATOMIC_ACQUIRE, "agent");
            xb_add(&bar[XB_XGEN(b.x)], 1u);
            asm volatile("s_waitcnt vmcnt(0)" ::: "memory");
        } else {
            XB_SPIN(xb_ld(&bar[XB_XGEN(b.x)]) == gen, bar);
            __builtin_amdgcn_fence(__ATOMIC_ACQUIRE, "agent");
            asm volatile("s_waitcnt vmcnt(0)" ::: "memory");
        }
    }
    __syncthreads();
}

#ifndef PH_MASK
#define PH_MASK 0xFFFFFFFFu
#endif
#define PH(k) ((PH_MASK >> (k)) & 1u)
#ifndef DUP_MASK
#define DUP_MASK 0u
#endif
#define DUP(k) ((DUP_MASK >> (k)) & 1u)
#define REFRESH() do { F.tid = opaque_i(threadIdx.x); F.lane = F.tid & 63; F.wave = __builtin_amdgcn_readfirstlane(F.tid >> 6); } while (0)
__global__ void __launch_bounds__(NTHREADS, 2) fwd_mega(Args args) {
    extern __shared__ __attribute__((aligned(16))) unsigned char lds_raw[];
    cg::grid_group grid = cg::this_grid();
    Frame F;
    F.lds = (LAS unsigned char*)lds_raw; F.ws = args.ws; F.in = args.in; F.out = args.out;
    F.tid = threadIdx.x; F.lane = F.tid & 63; F.wave = __builtin_amdgcn_readfirstlane(F.tid >> 6); F.G = gridDim.x; F.bid = blockIdx.x;
    unsigned char* ws = args.ws;
    volatile LAS unsigned* bst = (volatile LAS unsigned*)(F.lds + LDS_BYTES - 64);
    if (F.tid < 16) bst[F.tid] = 0u;
    __syncthreads();
    const XcdBarrier xbar = xcd_barrier_post((unsigned*)(ws + WS_CTL) + 1024, bst);
#define GSYNC() do { xcd_barrier(xbar); REFRESH(); } while (0)

    if (PH(0)) { p0_adaln(F); __syncthreads(); p0_cpe(F); }
    if (DUP(0)) { __syncthreads(); p0_adaln(F); __syncthreads(); p0_cpe(F); }
    if (__builtin_expect(args.ws == nullptr, 0)) grid.sync();
    GSYNC();
    if (PH(1)) p1_prologue(F);
    if (DUP(1)) { __syncthreads(); p1_prologue(F); }
    GSYNC();
    if (PH(2)) {
        { pg8::Gemm g{(const bf16*)(ws + WS_XN), (const bf16*)(ws + WS_WIN), 1024}; pg8::StaticOrder So; So.init(T, NPROJ_A, F.G, F.bid);
          pg8::EpiProj E{(bf16*)(ws + WS_PROJ), (float*)(ws + WS_SMALL), (const float*)(ws + WS_BIN), (unsigned char*)(ws + WS_GATE8), 0, -1, 1000};
          pg8::gemm_phase<pg8::EpiProj, pg8::StaticOrder, true, true>(F.lds, g, So, E);
          if (DUP(2)) { __syncthreads(); pg8::gemm_phase<pg8::EpiProj, pg8::StaticOrder, true, true>(F.lds, g, So, E); } }
        __syncthreads();
        { pg8::Gemm g{(const bf16*)(ws + WS_OY), (const bf16*)(ws + WS_WIN + 4 * MiB), 1024}; pg8::StaticOrder So; So.init(T, NPROJ_B, F.G, F.bid);
          pg8::EpiProj E{(bf16*)(ws + WS_PROJ) + NPROJ_A, (float*)(ws + WS_SMALL), (const float*)(ws + WS_BIN) + NPROJ_A, (unsigned char*)(ws + WS_GATE8), NPROJ_A, 5, 6};
          pg8::gemm_phase<pg8::EpiProj, pg8::StaticOrder, true, true, true>(F.lds, g, So, E);
          if (DUP(20)) { __syncthreads(); pg8::gemm_phase<pg8::EpiProj, pg8::StaticOrder, true, true, true>(F.lds, g, So, E); } }
    }
    GSYNC();
    if (PH(3)) { p3_compress(F); __syncthreads(); }
    if (DUP(3)) { p3_compress(F); __syncthreads(); }
    REFRESH(); if (PH(4)) { p3_mlstate(F); __syncthreads(); }
    if (DUP(4)) { p3_mlstate(F); __syncthreads(); }
    GSYNC();
    REFRESH(); if (PH(7)) p4_mlscan(F);
    if (DUP(7)) p4_mlscan(F);
    GSYNC();
    if (PH(8)) { p5_attn(F, 0); __syncthreads(); }
    if (DUP(8)) { p5_attn(F, 1); __syncthreads(); }
    REFRESH(); if (PH(9)) p5_mlout(F);
    if (DUP(9)) { __syncthreads(); p5_mlout(F); }
    GSYNC();
    if (DUP(21)) { GSYNC(); GSYNC(); GSYNC(); GSYNC(); }
    if (PH(11)) {
        pg8::StaticOrder So; So.init(T, 1024, F.G, F.bid);
        for (int rep7 = 0; rep7 < (DUP(11) ? 2 : 1); ++rep7) {
        { pg8::Gemm g{(const bf16*)(ws + WS_OY), (const bf16*)(ws + WS_WPA), 1024};
          pg8::EpiMix2 E{(bf16*)(ws + WS_XN), (const unsigned char*)(ws + WS_GATE8)};
          pg8::gemm_phase<pg8::EpiMix2, pg8::StaticOrder, true, true>(F.lds, g, So, E); }
        __syncthreads(); }
    }
    GSYNC();
    if (PH(12)) {
        pg8::Gemm g{(const bf16*)(ws + WS_XN), (const bf16*)(ws + WS_WOUT), 1024}; pg8::StaticOrder So; So.init(T, 1024, F.G, F.bid);
        pg8::EpiWout E{F.in[0], (bf16*)(ws + WS_OY), (const float*)(ws + WS_MOD) + 2 * 1024};
        pg8::gemm_phase<pg8::EpiWout, pg8::StaticOrder, true, true>(F.lds, g, So, E);
        if (DUP(12)) { __syncthreads(); pg8::gemm_phase<pg8::EpiWout, pg8::StaticOrder, true, true>(F.lds, g, So, E); }
        if (DUP(19)) { __syncthreads(); pg8::EpiNull En{(float*)(ws + WS_ACT)}; pg8::gemm_phase<pg8::EpiNull, pg8::StaticOrder, true, true>(F.lds, g, So, En); }
    }
    GSYNC();
    if (PH(13)) p9_route(F, false);
    if (DUP(13)) p9_route(F, true);
    GSYNC();
    if (PH(14)) p10_gather(F);
    if (DUP(14)) { __syncthreads(); p10_gather(F); }
    GSYNC();
    if (PH(15)) {
        const int* blke = (const int*)(ws + WS_BLKE); const int nblk = __builtin_amdgcn_readfirstlane(blke[1000]);
        { pg8::MoeOrderG Mo; Mo.blk_e = blke; Mo.rows = (const int*)(ws + WS_ROWIDX); Mo.nblk = nblk; Mo.x = F.bid & 7; Mo.y = F.bid >> 3; Mo.ny = F.G >> 3; Mo.nN = 8; Mo.nPerE = 2048;
          pg8::Gemm g{(const bf16*)(ws + WS_XN), (const bf16*)(ws + WS_WUP), 1024};
          pg8::EpiSwiglu E{(bf16*)(ws + WS_ACT), F.in[27]};
          pg8::gemm_phase<pg8::EpiSwiglu, pg8::MoeOrderG, true, true, true>(F.lds, g, Mo, E);
          if (DUP(17)) { __syncthreads(); pg8::gemm_phase<pg8::EpiSwiglu, pg8::MoeOrderG, true, true, true>(F.lds, g, Mo, E); } }
        pg8::MoeOrder Mo; Mo.blk_e = blke; Mo.rows = nullptr; Mo.nblk = nblk; Mo.x = F.bid & 7; Mo.y = F.bid >> 3; Mo.ny = F.G >> 3;
        GSYNC();
        { Mo.nN = 4; Mo.nPerE = 1024;
          pg8::Gemm g{(const bf16*)(ws + WS_ACT), (const bf16*)(ws + WS_WDN), 1024};
          pg8::EpiDown E{(bf16*)(ws + WS_PROJ), F.in[29]};
          pg8::gemm_phase<pg8::EpiDown, pg8::MoeOrder, true, true, true>(F.lds, g, Mo, E);
          if (DUP(18)) { __syncthreads(); pg8::gemm_phase<pg8::EpiDown, pg8::MoeOrder, true, true, true>(F.lds, g, Mo, E); } }
    }
    GSYNC();
    if (PH(16)) p13_final(F, false);
    if (DUP(16)) p13_final(F, true);
}

extern "C" void kernel_launch(void* const* d_in, const int* in_sizes, int n_in, void* d_out, int out_size, void* d_ws, size_t ws_size, hipStream_t stream) {
    static int grid = 0;
    if (grid == 0) {
        if (n_in != 31 || out_size != T * D || ws_size < WS_END) { fprintf(stderr, "kernel_launch: unexpected problem (n_in %d out %d ws %zu)\n", n_in, out_size, ws_size); grid = -1; return; }
        int dev = 0, cus = 0, per_cu = 0;
        if (hipGetDevice(&dev) != hipSuccess || hipDeviceGetAttribute(&cus, hipDeviceAttributeMultiprocessorCount, dev) != hipSuccess) { grid = -1; return; }
        if (hipFuncSetAttribute((const void*)fwd_mega, hipFuncAttributeMaxDynamicSharedMemorySize, LDS_BYTES) != hipSuccess) { fprintf(stderr, "kernel_launch: hipFuncSetAttribute failed\n"); grid = -1; return; }
        if (hipOccupancyMaxActiveBlocksPerMultiprocessor(&per_cu, (const void*)fwd_mega, NTHREADS, LDS_BYTES) != hipSuccess || per_cu < 1) { fprintf(stderr, "kernel_launch: occupancy query says %d\n", per_cu); (void)hipGetLastError(); grid = -1; return; }
        grid = cus;
        if (grid % 8 != 0) grid -= grid % 8;
        fprintf(stderr, "kernel_launch: cus %d per_cu %d grid %d ws %zu\n", cus, per_cu, grid, ws_size);
    }
    if (grid < 0) return;
    (void)hipMemsetAsync((char*)d_ws + WS_CTL, 0, 32768, stream);
    Args a{};
    for (int i = 0; i < 31; ++i) a.in[i] = (const float*)d_in[i];
    a.out = (float*)d_out; a.ws = (unsigned char*)d_ws;
    void* kargs[] = {&a};
    hipError_t e = hipLaunchCooperativeKernel((const void*)fwd_mega, dim3(grid), dim3(NTHREADS), kargs, LDS_BYTES, stream);
    if (e != hipSuccess) fprintf(stderr, "kernel_launch: cooperative launch failed: %s\n", hipGetErrorString(e));
}
```

```cpp
#include <hip/hip_runtime.h>
#include <hip/hip_cooperative_groups.h>
#include <cstdio>
#include <cstdint>
namespace cg = cooperative_groups;

#define LAS __attribute__((address_space(3)))
typedef unsigned short bf16;
typedef float f32x4 __attribute__((ext_vector_type(4)));
typedef float f32x2 __attribute__((ext_vector_type(2)));
typedef unsigned u32x4 __attribute__((ext_vector_type(4)));
typedef unsigned u32x2 __attribute__((ext_vector_type(2)));
typedef short bf16x8 __attribute__((ext_vector_type(8)));
typedef short s16x4 __attribute__((ext_vector_type(4)));

constexpr int NB = 16, S = 2048, D = 1024, T = NB * S;
constexpr int NPROJ = 4608;
constexpr int C_Q = 512, C_KCMP = 1024, C_VCMP = 1152, C_KSLC = 1280, C_VSLC = 1408, C_KWIN = 1536, C_VWIN = 1664;
constexpr int C_XM = 0, C_SMALL = 1792, C_OPRE = 2048, C_GA = 2560, C_GB = 3584;
constexpr int NPROJ_A = 512, NPROJ_B = 4096;
constexpr int PP = 2048, GP = 2560;
constexpr int G_OPRE = 0, G_GA = 512, G_GB = 1536;
constexpr int IN_W = 4384;
constexpr int NCMP = 127;
constexpr int NEXP = 32, PMAX = 544 * 256;
constexpr int NTHREADS = 512, NWAVES = 8;
constexpr int LDS_BYTES = 147456;

constexpr size_t MiB = 1u << 20;
constexpr size_t WS_CTL = 0;
constexpr size_t WS_MODP = 1 * MiB;
constexpr size_t WS_MOD = 7 * MiB;
constexpr size_t WS_BIN = 8 * MiB;
constexpr size_t WS_BLKE = 8 * MiB + 64 * 1024;
constexpr size_t WS_OFFS = 8 * MiB + 128 * 1024;
constexpr size_t WS_SMALL = 9 * MiB;
constexpr size_t WS_RE = 13 * MiB;
constexpr size_t WS_RW = WS_RE + 512 * 1024;
constexpr size_t WS_RS = WS_RW + 512 * 1024;
constexpr size_t WS_DEST = WS_RS + 512 * 1024;
constexpr size_t WS_ROWIDX = 17 * MiB;
constexpr size_t WS_SELM = 15 * MiB;
constexpr size_t WS_KC = 16 * MiB;
constexpr size_t WS_KCB = 16 * MiB;
constexpr size_t WS_W1T = 21 * MiB;
constexpr size_t WS_W2T = 22 * MiB;
constexpr size_t WS_CPE = 22 * MiB + 64 * 1024;
constexpr size_t WS_WQT = 23 * MiB;
constexpr size_t WS_RWT = 23 * MiB + 512 * 1024;
constexpr size_t WS_NLOC = 19 * MiB;
constexpr size_t WS_MLOC = 19 * MiB + 512 * 1024;
constexpr size_t WS_FLAST = WS_MLOC + 4096;
constexpr size_t WS_MIN = WS_FLAST + 4096;
constexpr size_t WS_NIN = 20 * MiB;
constexpr size_t WS_WIN = 24 * MiB;
constexpr size_t WS_WPA = 33 * MiB, WS_WOUT = 35 * MiB;
constexpr size_t WS_WUP = 40 * MiB;
constexpr size_t WS_WDN = 168 * MiB;
constexpr size_t WS_XN = 232 * MiB;
constexpr size_t WS_PROJ = 296 * MiB;
constexpr size_t WS_GATE8 = 424 * MiB;
constexpr size_t WS_QML = 584 * MiB, WS_KML = 616 * MiB, WS_VML = 648 * MiB;
constexpr size_t WS_CLOC = 680 * MiB, WS_CIN = 744 * MiB;
constexpr size_t WS_OACC = 808 * MiB;
constexpr size_t WS_ACT = 584 * MiB;
constexpr size_t WS_OY = 872 * MiB;
constexpr size_t WS_END = 936 * MiB;

__device__ __forceinline__ unsigned f2bf(float f) { unsigned u = __builtin_bit_cast(unsigned, f); return (u + 0x7fffu + ((u >> 16) & 1u)) >> 16; }
typedef __bf16 bf16x2_t __attribute__((ext_vector_type(2)));
__device__ __forceinline__ unsigned pk2(float lo, float hi) { const f32x2 v = {lo, hi}; return __builtin_bit_cast(unsigned, __builtin_convertvector(v, bf16x2_t)); }
__device__ __forceinline__ float bf2f(bf16 v) { return __builtin_bit_cast(float, (unsigned)v << 16); }
__device__ __forceinline__ float bflo(unsigned w) { return __builtin_bit_cast(float, w << 16); }
__device__ __forceinline__ float bfhi(unsigned w) { return __builtin_bit_cast(float, w & 0xffff0000u); }
__device__ __forceinline__ float sigmoidf_(float x) { return __builtin_amdgcn_rcpf(1.0f + __expf(-x)); }
__device__ __forceinline__ float wave_sum(float v) {
#pragma unroll
    for (int o = 1; o < 64; o <<= 1) v += __shfl_xor(v, o);
    return v;
}
#define LDS_WAIT() asm volatile("s_waitcnt lgkmcnt(0)" ::: "memory")
__device__ __forceinline__ unsigned pk4_fp8(float a, float b, float c, float d) { int w = 0; w = __builtin_amdgcn_cvt_pk_fp8_f32(a, b, w, false); w = __builtin_amdgcn_cvt_pk_fp8_f32(c, d, w, true); return (unsigned)w; }
__device__ __forceinline__ int opaque_i(int x) { asm volatile("" : "+v"(x)); return x; }

namespace pg8 {
constexpr int BM = 256, BK = 64, HALF = 128, HTB = HALF * BK * 2, STAGE_BYTES = 8 * HTB, NXCD = 8, WGM = 8;
__host__ __device__ __forceinline__ int lds_byte(int r, int c) { const int st = (r >> 4) * 2 + (c >> 5), rr = r & 15, cc = c & 31, ob = rr * 64 + cc * 2; return st * 1024 + (ob ^ (((ob >> 9) & 1) << 5)); }
__host__ __device__ __forceinline__ void stage_rc(int b, int& R, int& C) { const int st = b / 1024, sb = b % 1024, swz = sb ^ (((sb >> 9) & 1) << 5); R = (st >> 1) * 16 + swz / 64; C = (st & 1) * 32 + (swz % 64) / 2; }
__host__ __device__ __forceinline__ int perm32(int rho) { const int n = rho >> 4, i = rho & 15; return 8 * (i >> 2) + 4 * n + (i & 3); }

struct Unit { int pm, pn, brow, e; };
struct Gemm { const bf16* A; const bf16* Bt; int K; };

struct StaticOrder {
    static constexpr bool GATHER = false;
    int nM, nN, nwg, G, c;
    __device__ void init(int M, int N, int G_, int c_) { nM = M / BM; nN = N / BM; nwg = nM * nN; G = G_; c = c_; }
    __device__ bool next(int i, Unit& u) const {
        const long L = (long)i * G + c; if (L >= nwg) return false;
        int wgid = (int)L; { const int q = nwg / NXCD, r = nwg % NXCD, xcd = wgid % NXCD, off = wgid / NXCD; wgid = (xcd < r ? xcd * (q + 1) : r * (q + 1) + (xcd - r) * q) + off; }
        const int nig = WGM * nN, gid = wgid / nig, fm = gid * WGM, gsz = (nM - fm) < WGM ? (nM - fm) : WGM;
        u.pm = fm + ((wgid % nig) % gsz); u.pn = (wgid % nig) / gsz; u.brow = u.pn * BM; u.e = 0; return true;
    }
};
template <bool GATHER_> struct MoeOrderT {
    static constexpr bool GATHER = GATHER_;
    const int* blk_e; const int* rows; int nblk, nN, nPerE, x, y, ny;
    __device__ bool next(int i, Unit& u) const {
        const int l = i * ny + y, rb = l / nN, pn = l - rb * nN, pm = rb * 8 + x;
        if (pm >= nblk) return false;
        const int e = __builtin_amdgcn_readfirstlane(blk_e[pm]);
        u.pm = pm; u.pn = pn; u.e = e; u.brow = e * nPerE + pn * BM; return true;
    }
};
typedef MoeOrderT<false> MoeOrder;
typedef MoeOrderT<true> MoeOrderG;

__device__ __forceinline__ unsigned cvt_pk_bf16(float lo, float hi) { unsigned r; asm volatile("v_cvt_pk_bf16_f32 %0, %1, %2" : "=v"(r) : "v"(lo), "v"(hi)); return r; }

typedef int v8i __attribute__((ext_vector_type(8)));
typedef int v4i __attribute__((ext_vector_type(4)));
template <class Epi, class Sched, bool ALIGN_EPI, bool SP2, bool FP8 = false>
__device__ __forceinline__ void gemm_phase(LAS unsigned char* lds, const Gemm g, const Sched& S, const Epi& E) {
    constexpr int ESZ = FP8 ? 1 : 2;
    const int tid = opaque_i(threadIdx.x), wid = __builtin_amdgcn_readfirstlane(tid >> 6), lane = tid & 63, wr = wid >> 2, wc = wid & 3, fr = lane & 15, fq = lane >> 4;
    const int K = g.K, nt = (K * ESZ) / 128;
    unsigned voffA[2], voffB[2];
#pragma unroll
    for (int i = 0; i < 2; ++i) { int R, C; stage_rc(tid * 16 + i * 8192, R, C); const int Rb = Epi::PERM ? ((R & ~31) + perm32(R & 31)) : R;
        voffA[i] = (unsigned)(R * K * ESZ + C * 2); voffB[i] = (unsigned)(Rb * K * ESZ + C * 2); }
    const size_t kstep = (size_t)(BK * 2);
    const size_t hstep = (size_t)HALF * K * ESZ;
    const size_t tstep = 2 * hstep;
    const size_t rstep = (size_t)K * ESZ;
    const unsigned ldsw = (unsigned)wid * 1024u;
    const int aoff = lds_byte(wr * 64 + fr, fq * 8), boff = lds_byte(wc * 32 + fr, fq * 8);
#define PG8_SA(b, h) (((b) * 2 + (h)) * HTB)
#define PG8_SB(b, h) ((4 + (b) * 2 + (h)) * HTB)
#define PG8_STAGE(bufoff, gbase, voff) do { _Pragma("unroll") for (int _i = 0; _i < 2; ++_i) \
        __builtin_amdgcn_global_load_lds((const unsigned*)((const char*)(gbase) + (voff)[_i]), (LAS unsigned*)(lds + (bufoff) + ldsw + _i * 8192), 16, 0, 0); } while (0)
#define PG8_LDA(dst, b, h) do { _Pragma("unroll") for (int m = 0; m < 4; ++m) { const v4i lo_ = *(const LAS v4i*)(lds + PG8_SA(b, h) + aoff + m * 2048), hi_ = *(const LAS v4i*)(lds + PG8_SA(b, h) + aoff + m * 2048 + 1024); dst[m] = __builtin_shufflevector(lo_, hi_, 0, 1, 2, 3, 4, 5, 6, 7); } } while (0)
#define PG8_LDB(dst, b, h) do { _Pragma("unroll") for (int n = 0; n < 2; ++n) { const v4i lo_ = *(const LAS v4i*)(lds + PG8_SB(b, h) + boff + n * 2048), hi_ = *(const LAS v4i*)(lds + PG8_SB(b, h) + boff + n * 2048 + 1024); dst[n] = __builtin_shufflevector(lo_, hi_, 0, 1, 2, 3, 4, 5, 6, 7); } } while (0)
#define PG8_MMA(ai, bj, At, Bt) do { __builtin_amdgcn_s_setprio(1); _Pragma("unroll") for (int m = 0; m < 4; ++m) _Pragma("unroll") for (int n = 0; n < 2; ++n) { \
        if constexpr (FP8) asm volatile("v_mfma_scale_f32_16x16x128_f8f6f4 %0, %1, %2, %0, %3, %4 op_sel_hi:[0,0,0]" : "+v"(acc[ai][bj][m][n]) : "v"(Bt[n]), "v"(At[m]), "v"(sclW), "v"(sclX)); \
        else { acc[ai][bj][m][n] = __builtin_amdgcn_mfma_f32_16x16x32_bf16(__builtin_bit_cast(bf16x8, __builtin_shufflevector(Bt[n], Bt[n], 0, 1, 2, 3)), __builtin_bit_cast(bf16x8, __builtin_shufflevector(At[m], At[m], 0, 1, 2, 3)), acc[ai][bj][m][n], 0, 0, 0); \
               acc[ai][bj][m][n] = __builtin_amdgcn_mfma_f32_16x16x32_bf16(__builtin_bit_cast(bf16x8, __builtin_shufflevector(Bt[n], Bt[n], 4, 5, 6, 7)), __builtin_bit_cast(bf16x8, __builtin_shufflevector(At[m], At[m], 4, 5, 6, 7)), acc[ai][bj][m][n], 0, 0, 0); } } __builtin_amdgcn_s_setprio(0); } while (0)
#define PG8_WAIT_V(n) asm volatile("s_waitcnt vmcnt(" #n ")" ::: "memory")
#define PG8_WAIT_L(n) asm volatile("s_waitcnt lgkmcnt(" #n ")" ::: "memory")
#define PG8_BAR __builtin_amdgcn_s_barrier()
#define PG8_SCHED __builtin_amdgcn_sched_barrier(0)
    int sclW = 0x7a7a7a7a, sclX = 0x7f7f7f7f; asm volatile("" : "+v"(sclW), "+v"(sclX));
    Unit cur, nxt; int ui = 0;
    if (!S.next(0, cur)) return;
    unsigned vC[2][2], vN[2][2];
#define PG8_ROWOFFS(dst, pm_) do { if constexpr (Sched::GATHER) { _Pragma("unroll") for (int _h = 0; _h < 2; ++_h) _Pragma("unroll") for (int _i = 0; _i < 2; ++_i) { int R_, C_; stage_rc(tid * 16 + _i * 8192, R_, C_); \
        dst[_h][_i] = (unsigned)(S.rows[(pm_) * BM + _h * HALF + R_] * K * ESZ + C_ * 2); } } } while (0)
#define PG8_STAGE_A(bufoff, plain_ptr, koff, h, nx) do { if constexpr (Sched::GATHER) { _Pragma("unroll") for (int _i = 0; _i < 2; ++_i) { const unsigned vo_ = (nx) ? vN[h][_i] : vC[h][_i]; \
        __builtin_amdgcn_global_load_lds((const unsigned*)((const char*)g.A + (koff) + vo_), (LAS unsigned*)(lds + (bufoff) + ldsw + _i * 8192), 16, 0, 0); } } \
        else { PG8_STAGE(bufoff, plain_ptr, voffA); } } while (0)
    PG8_ROWOFFS(vC, cur.pm);
    f32x4 acc[2][2][4][2];
#pragma unroll
    for (int a = 0; a < 2; ++a)
#pragma unroll
        for (int b = 0; b < 2; ++b)
#pragma unroll
            for (int m = 0; m < 4; ++m)
#pragma unroll
                for (int n = 0; n < 2; ++n) acc[a][b][m][n] = (f32x4){0.f, 0.f, 0.f, 0.f};
    v8i At[4], B0[2], B1[2];
    const char* cA = (const char*)g.A + (size_t)cur.pm * tstep; const char* cB = (const char*)g.Bt + (size_t)cur.brow * rstep;
    if constexpr (SP2) {
        PG8_STAGE(PG8_SB(0, 0), cB, voffB); PG8_STAGE(PG8_SB(0, 1), cB + hstep, voffB); PG8_STAGE_A(PG8_SA(0, 0), cA, 0, 0, false); PG8_STAGE_A(PG8_SA(0, 1), cA + hstep, 0, 1, false);
        if (wr == 1) PG8_BAR;
        PG8_WAIT_V(2); PG8_BAR;
        PG8_STAGE(PG8_SB(1, 0), cB + kstep, voffB); PG8_STAGE_A(PG8_SA(1, 0), cA + kstep, kstep, 0, false); PG8_STAGE(PG8_SB(1, 1), cB + hstep + kstep, voffB);
        PG8_WAIT_V(6); PG8_BAR;
    } else {
        PG8_STAGE(PG8_SB(0, 0), cB, voffB); PG8_STAGE(PG8_SA(0, 0), cA, voffA); PG8_STAGE(PG8_SB(0, 1), cB + hstep, voffB); PG8_STAGE(PG8_SA(0, 1), cA + hstep, voffA);
        if (wr == 1) PG8_BAR;
        PG8_WAIT_V(4); PG8_BAR;
        PG8_STAGE(PG8_SB(1, 0), cB + kstep, voffB); PG8_STAGE(PG8_SA(1, 0), cA + kstep, voffA); PG8_STAGE(PG8_SB(1, 1), cB + hstep + kstep, voffB);
        PG8_WAIT_V(6); PG8_BAR;
    }
    for (;;) {
        const bool has_next = S.next(ui + 1, nxt);
        if constexpr (Sched::GATHER) { if (has_next) { PG8_ROWOFFS(vN, nxt.pm); } else { vN[0][0] = vC[0][0]; vN[0][1] = vC[0][1]; vN[1][0] = vC[1][0]; vN[1][1] = vC[1][1]; } }
        const char* nA = has_next ? (const char*)g.A + (size_t)nxt.pm * tstep : cA; const char* nB = has_next ? (const char*)g.Bt + (size_t)nxt.brow * rstep : cB;
#pragma nounroll
        for (int t = 0; t < nt; t += 2) {
            if constexpr (Epi::MIDK > 0) { if (t == Epi::MIDK) E.mid(acc, cur, wr, wc, fr, fq); }
            const bool last = (t == nt - 2);
            const char* a1 = cA + (size_t)(t + 1) * kstep;
            const char* a2 = last ? nA : cA + (size_t)(t + 2) * kstep; const char* b2 = last ? nB : cB + (size_t)(t + 2) * kstep;
            const char* a3 = a2 + kstep; const char* b3 = b2 + kstep;
            const size_t k1 = (size_t)(t + 1) * kstep, k2 = last ? 0 : (size_t)(t + 2) * kstep;
            if constexpr (SP2) {
            PG8_LDB(B0, 0, 0); PG8_LDB(B1, 0, 1); PG8_SCHED; PG8_LDA(At, 0, 0); PG8_STAGE_A(PG8_SA(1, 1), a1 + hstep, k1, 1, false);
            PG8_WAIT_V(8); PG8_WAIT_L(0); PG8_BAR; PG8_MMA(0, 0, At, B0); PG8_MMA(0, 1, At, B1); PG8_BAR; PG8_SCHED;
            PG8_LDA(At, 0, 1); PG8_STAGE(PG8_SB(0, 0), b2, voffB); PG8_STAGE(PG8_SB(0, 1), b2 + hstep, voffB); PG8_STAGE_A(PG8_SA(0, 0), a2, k2, 0, last);
            PG8_WAIT_V(8); PG8_WAIT_L(0); PG8_BAR; PG8_MMA(1, 0, At, B0); PG8_MMA(1, 1, At, B1); PG8_BAR; PG8_SCHED;
            PG8_LDB(B0, 1, 0); PG8_LDB(B1, 1, 1); PG8_SCHED; PG8_LDA(At, 1, 0); PG8_STAGE_A(PG8_SA(0, 1), a2 + hstep, k2, 1, last);
            PG8_WAIT_V(8); PG8_WAIT_L(0); PG8_BAR; PG8_MMA(0, 0, At, B0); PG8_MMA(0, 1, At, B1); PG8_BAR; PG8_SCHED;
            PG8_LDA(At, 1, 1); PG8_STAGE(PG8_SB(1, 0), b3, voffB); PG8_STAGE(PG8_SB(1, 1), b3 + hstep, voffB); PG8_STAGE_A(PG8_SA(1, 0), a3, k2 + kstep, 0, last);
            PG8_WAIT_V(8); PG8_WAIT_L(0); PG8_BAR; PG8_MMA(1, 0, At, B0); PG8_MMA(1, 1, At, B1); PG8_BAR; PG8_SCHED;
            } else {
            PG8_LDB(B0, 0, 0); PG8_SCHED; PG8_LDA(At, 0, 0); PG8_STAGE(PG8_SA(1, 1), a1 + hstep, voffA);
            PG8_WAIT_L(8); PG8_BAR; PG8_WAIT_L(0); PG8_MMA(0, 0, At, B0); PG8_BAR; PG8_SCHED;
            PG8_LDB(B1, 0, 1); PG8_STAGE(PG8_SB(0, 0), b2, voffB);
            PG8_BAR; PG8_WAIT_L(0); PG8_MMA(0, 1, At, B1); PG8_BAR;
            PG8_LDA(At, 0, 1); PG8_STAGE(PG8_SA(0, 0), a2, voffA);
            PG8_BAR; PG8_WAIT_L(0); PG8_MMA(1, 0, At, B0); PG8_BAR; PG8_SCHED;
            PG8_STAGE(PG8_SB(0, 1), b2 + hstep, voffB);
            PG8_WAIT_V(6); PG8_BAR; PG8_MMA(1, 1, At, B1); PG8_BAR;
            PG8_LDB(B0, 1, 0); PG8_SCHED; PG8_LDA(At, 1, 0); PG8_STAGE(PG8_SA(0, 1), a2 + hstep, voffA);
            PG8_WAIT_L(8); PG8_BAR; PG8_WAIT_L(0); PG8_MMA(0, 0, At, B0); PG8_BAR; PG8_SCHED;
            PG8_LDB(B1, 1, 1); PG8_STAGE(PG8_SB(1, 0), b3, voffB);
            PG8_BAR; PG8_WAIT_L(0); PG8_MMA(0, 1, At, B1); PG8_BAR;
            PG8_LDA(At, 1, 1); PG8_STAGE(PG8_SA(1, 0), a3, voffA);
            PG8_BAR; PG8_WAIT_L(0); PG8_MMA(1, 0, At, B0); PG8_BAR; PG8_SCHED;
            PG8_STAGE(PG8_SB(1, 1), b3 + hstep, voffB);
            PG8_WAIT_V(6); PG8_BAR; PG8_MMA(1, 1, At, B1); PG8_BAR;
            }
        }
        if constexpr (ALIGN_EPI) { if (wr == 0) PG8_BAR; }
        if constexpr (FP8) asm volatile("s_nop 15\n\ts_nop 15" ::: "memory");
        E(acc, cur, wr, wc, fr, fq);
        if (!has_next) break;
#pragma unroll
        for (int a = 0; a < 2; ++a)
#pragma unroll
            for (int b = 0; b < 2; ++b)
#pragma unroll
                for (int m = 0; m < 4; ++m)
#pragma unroll
                    for (int n = 0; n < 2; ++n) acc[a][b][m][n] = (f32x4){0.f, 0.f, 0.f, 0.f};
        cur = nxt; cA = nA; cB = nB; ++ui;
        if constexpr (Sched::GATHER) { vC[0][0] = vN[0][0]; vC[0][1] = vN[0][1]; vC[1][0] = vN[1][0]; vC[1][1] = vN[1][1]; }
        if constexpr (ALIGN_EPI) { if (wr == 1) PG8_BAR; }
    }
    PG8_WAIT_V(0);
    if constexpr (!ALIGN_EPI) { if (wr == 0) PG8_BAR; }
    PG8_BAR;
#undef PG8_SA
#undef PG8_SB
#undef PG8_STAGE
#undef PG8_STAGE_A
#undef PG8_ROWOFFS
#undef PG8_LDA
#undef PG8_LDB
#undef PG8_MMA
#undef PG8_WAIT_V
#undef PG8_WAIT_L
#undef PG8_BAR
#undef PG8_SCHED
}

typedef const f32x4 (&AccRef)[2][2][4][2];
struct EpiProj {
    static constexpr int MIDK = 0;
    static constexpr bool PERM = true;
    bf16* O; float* small; const float* bias; unsigned char* G8; int coloff, smtile, gtile;
    __device__ __forceinline__ void operator()(AccRef acc, const Unit& u, int wr, int wc, int fr, int fq) const {
        const int row0 = u.pm * BM + wr * 64 + fr, col0 = u.pn * BM + wc * 32 + 8 * fq;
        f32x4 bv[2][2];
#pragma unroll
        for (int bj = 0; bj < 2; ++bj)
#pragma unroll
            for (int n = 0; n < 2; ++n) bv[bj][n] = *(const f32x4*)(bias + col0 + bj * HALF + 4 * n);
        const bool sm = (u.pn == smtile) && (wc == 0);
        const bool tog = u.pn >= gtile;
#pragma unroll
        for (int ai = 0; ai < 2; ++ai)
#pragma unroll
            for (int m = 0; m < 4; ++m) { const int row = row0 + ai * HALF + m * 16; bf16* rowp = O + (size_t)row * PP + col0;
                unsigned char* gp = G8 + (size_t)row * GP + (col0 - gtile * BM);
#pragma unroll
                for (int bj = 0; bj < 2; ++bj) { const f32x4 v0 = acc[ai][bj][m][0] + bv[bj][0], v1 = acc[ai][bj][m][1] + bv[bj][1];
                    if (tog) { u32x2 w8; w8.x = pk4_fp8(v0[0], v0[1], v0[2], v0[3]); w8.y = pk4_fp8(v1[0], v1[1], v1[2], v1[3]); *(u32x2*)(gp + bj * HALF) = w8; }
                    else { u32x4 w; w.x = cvt_pk_bf16(v0[0], v0[1]); w.y = cvt_pk_bf16(v0[2], v0[3]); w.z = cvt_pk_bf16(v1[0], v1[1]); w.w = cvt_pk_bf16(v1[2], v1[3]);
                        *(u32x4*)(rowp + bj * HALF) = w; }
                    if (bj == 0 && sm) { *(f32x4*)(small + (size_t)row * 32 + 8 * fq) = v0; *(f32x4*)(small + (size_t)row * 32 + 8 * fq + 4) = v1; } } }
    }
};
struct EpiMix2 {
    static constexpr int MIDK = 8;
    static constexpr bool PERM = true;
    bf16* O; const unsigned char* g8;
    __device__ __forceinline__ void mid(f32x4 (&acc)[2][2][4][2], const Unit& u, int wr, int wc, int fr, int fq) const {
        int z = 0; asm volatile("" : "+v"(z));
        const int row0 = u.pm * BM + wr * 64 + fr + z, col0 = u.pn * BM + wc * 32 + 8 * fq;
#pragma unroll
        for (int ai = 0; ai < 2; ++ai)
#pragma unroll
            for (int m = 0; m < 4; ++m) { const unsigned char* gp = g8 + (size_t)(row0 + ai * HALF + m * 16) * GP + col0;
#pragma unroll
                for (int bj = 0; bj < 2; ++bj) { const u32x2 ga8 = *(const u32x2*)(gp + G_GA + bj * HALF), gb8 = *(const u32x2*)(gp + G_GB + bj * HALF);
                    float fa[8], fb[8]; { const f32x2 a0 = __builtin_amdgcn_cvt_pk_f32_fp8((int)ga8.x, false), a1 = __builtin_amdgcn_cvt_pk_f32_fp8((int)ga8.x, true), a2 = __builtin_amdgcn_cvt_pk_f32_fp8((int)ga8.y, false), a3 = __builtin_amdgcn_cvt_pk_f32_fp8((int)ga8.y, true);
                        const f32x2 b0 = __builtin_amdgcn_cvt_pk_f32_fp8((int)gb8.x, false), b1 = __builtin_amdgcn_cvt_pk_f32_fp8((int)gb8.x, true), b2 = __builtin_amdgcn_cvt_pk_f32_fp8((int)gb8.y, false), b3 = __builtin_amdgcn_cvt_pk_f32_fp8((int)gb8.y, true);
                        fa[0] = a0.x; fa[1] = a0.y; fa[2] = a1.x; fa[3] = a1.y; fa[4] = a2.x; fa[5] = a2.y; fa[6] = a3.x; fa[7] = a3.y; fb[0] = b0.x; fb[1] = b0.y; fb[2] = b1.x; fb[3] = b1.y; fb[4] = b2.x; fb[5] = b2.y; fb[6] = b3.x; fb[7] = b3.y; }
                    float r[8];
#define MIXR(i, av, bv) r[i] = (1.0f + fminf(__expf(-(bv)), 1e20f)) * __builtin_amdgcn_rcpf(1.0f + __expf(-(av)))
                    MIXR(0, fa[0], fb[0]); MIXR(1, fa[1], fb[1]); MIXR(2, fa[2], fb[2]); MIXR(3, fa[3], fb[3]); MIXR(4, fa[4], fb[4]); MIXR(5, fa[5], fb[5]); MIXR(6, fa[6], fb[6]); MIXR(7, fa[7], fb[7]);
#undef MIXR
#pragma unroll
                    for (int j = 0; j < 4; ++j) { acc[ai][bj][m][0][j] *= r[j]; acc[ai][bj][m][1][j] *= r[4 + j]; } }
                __builtin_amdgcn_sched_barrier(0); }
    }
    __device__ __forceinline__ void operator()(AccRef acc, const Unit& u, int wr, int wc, int fr, int fq) const {
        const int row0 = u.pm * BM + wr * 64 + fr, col0 = u.pn * BM + wc * 32 + 8 * fq;
#pragma unroll
        for (int ai = 0; ai < 2; ++ai)
#pragma unroll
            for (int m = 0; m < 4; ++m) { const int row = row0 + ai * HALF + m * 16; bf16* rowp = O + (size_t)row * D + col0;
                const unsigned char* gp = g8 + (size_t)row * GP + G_GB + col0;
#pragma unroll
                for (int bj = 0; bj < 2; ++bj) { const u32x2 gb8 = *(const u32x2*)(gp + bj * HALF);
                    const f32x2 b0 = __builtin_amdgcn_cvt_pk_f32_fp8((int)gb8.x, false), b1 = __builtin_amdgcn_cvt_pk_f32_fp8((int)gb8.x, true), b2 = __builtin_amdgcn_cvt_pk_f32_fp8((int)gb8.y, false), b3 = __builtin_amdgcn_cvt_pk_f32_fp8((int)gb8.y, true);
                    float r[8];
#define MIXG(bv) __builtin_amdgcn_rcpf(1.0f + fminf(__expf(-(bv)), 1e20f))
                    r[0] = MIXG(b0.x) * acc[ai][bj][m][0][0]; r[1] = MIXG(b0.y) * acc[ai][bj][m][0][1]; r[2] = MIXG(b1.x) * acc[ai][bj][m][0][2]; r[3] = MIXG(b1.y) * acc[ai][bj][m][0][3];
                    r[4] = MIXG(b2.x) * acc[ai][bj][m][1][0]; r[5] = MIXG(b2.y) * acc[ai][bj][m][1][1]; r[6] = MIXG(b3.x) * acc[ai][bj][m][1][2]; r[7] = MIXG(b3.y) * acc[ai][bj][m][1][3];
#undef MIXG
                    u32x4 w; w.x = cvt_pk_bf16(r[0], r[1]); w.y = cvt_pk_bf16(r[2], r[3]); w.z = cvt_pk_bf16(r[4], r[5]); w.w = cvt_pk_bf16(r[6], r[7]);
                    *(u32x4*)(rowp + bj * HALF) = w; } }
    }
};
struct EpiWout {
    static constexpr int MIDK = 0;
    static constexpr bool PERM = true;
    const float* x; bf16* out; const float* gate;
    __device__ __forceinline__ void operator()(AccRef acc, const Unit& u, int wr, int wc, int fr, int fq) const {
        const int row0 = u.pm * BM + wr * 64 + fr, col0 = u.pn * BM + wc * 32 + 8 * fq, b = u.pm >> 3;
        f32x4 gv[2][2];
#pragma unroll
        for (int bj = 0; bj < 2; ++bj)
#pragma unroll
            for (int n = 0; n < 2; ++n) gv[bj][n] = *(const f32x4*)(gate + (size_t)b * 6144 + col0 + bj * HALF + 4 * n);
#pragma unroll
        for (int ai = 0; ai < 2; ++ai)
#pragma unroll
            for (int m = 0; m < 4; ++m) { const size_t off = (size_t)(row0 + ai * HALF + m * 16) * D + col0;
#pragma unroll
                for (int bj = 0; bj < 2; ++bj) { const f32x4 x0 = *(const f32x4*)(x + off + bj * HALF), x1 = *(const f32x4*)(x + off + bj * HALF + 4);
                    const f32x4 v0 = x0 + gv[bj][0] * acc[ai][bj][m][0], v1 = x1 + gv[bj][1] * acc[ai][bj][m][1];
                    u32x4 w; w.x = cvt_pk_bf16(v0[0], v0[1]); w.y = cvt_pk_bf16(v0[2], v0[3]); w.z = cvt_pk_bf16(v1[0], v1[1]); w.w = cvt_pk_bf16(v1[2], v1[3]);
                    *(u32x4*)(out + off + bj * HALF) = w; } }
    }
};
struct EpiNull {
    static constexpr int MIDK = 0;
    static constexpr bool PERM = false;
    float* sink;
    __device__ __forceinline__ void operator()(AccRef acc, const Unit& u, int wr, int wc, int fr, int fq) const {
        f32x4 s = (f32x4){0.f, 0.f, 0.f, 0.f};
#pragma unroll
        for (int ai = 0; ai < 2; ++ai)
#pragma unroll
            for (int bj = 0; bj < 2; ++bj)
#pragma unroll
                for (int m = 0; m < 4; ++m)
#pragma unroll
                    for (int n = 0; n < 2; ++n) s += acc[ai][bj][m][n];
        if (s[0] == 1.2345e30f) sink[0] = s[1] + s[2] + s[3];
    }
};
struct EpiSwiglu {
    static constexpr int MIDK = 0;
    static constexpr bool PERM = true;
    bf16* O; const float* bup;
    __device__ __forceinline__ void operator()(AccRef acc, const Unit& u, int wr, int wc, int fr, int fq) const {
        const int row0 = u.pm * BM + wr * 64 + fr, lc = wc * 32 + 8 * fq, hc = u.pn * HALF + lc;
        const float* bp = bup + (size_t)u.e * 2048 + hc;
        f32x4 bg[2], bl[2];
#pragma unroll
        for (int n = 0; n < 2; ++n) { bg[n] = *(const f32x4*)(bp + 4 * n); bl[n] = *(const f32x4*)(bp + 1024 + 4 * n); }
#pragma unroll
        for (int ai = 0; ai < 2; ++ai)
#pragma unroll
            for (int m = 0; m < 4; ++m) { const int row = row0 + ai * HALF + m * 16;
                float r[8];
#pragma unroll
                for (int n = 0; n < 2; ++n)
#pragma unroll
                    for (int j = 0; j < 4; ++j) { float gg = acc[ai][0][m][n][j] + bg[n][j], ll = acc[ai][1][m][n][j] + bl[n][j];
                        gg = fminf(gg, 7.0f); ll = fminf(fmaxf(ll, -7.0f), 7.0f);
                        r[4 * n + j] = gg * sigmoidf_(1.702f * gg) * (ll + 1.0f); }
                u32x2 w; w.x = pk4_fp8(r[0], r[1], r[2], r[3]); w.y = pk4_fp8(r[4], r[5], r[6], r[7]);
                *(u32x2*)((unsigned char*)O + (size_t)row * D + hc) = w; }
    }
};
struct EpiDown {
    static constexpr int MIDK = 0;
    static constexpr bool PERM = true;
    bf16* O; const float* bdn;
    __device__ __forceinline__ void operator()(AccRef acc, const Unit& u, int wr, int wc, int fr, int fq) const {
        const int row0 = u.pm * BM + wr * 64 + fr, col0 = u.pn * BM + wc * 32 + 8 * fq;
        f32x4 bv[2][2];
#pragma unroll
        for (int bj = 0; bj < 2; ++bj)
#pragma unroll
            for (int n = 0; n < 2; ++n) bv[bj][n] = *(const f32x4*)(bdn + (size_t)u.e * D + col0 + bj * HALF + 4 * n);
#pragma unroll
        for (int ai = 0; ai < 2; ++ai)
#pragma unroll
            for (int m = 0; m < 4; ++m) { bf16* rowp = O + (size_t)(row0 + ai * HALF + m * 16) * D + col0;
#pragma unroll
                for (int bj = 0; bj < 2; ++bj) { const f32x4 v0 = acc[ai][bj][m][0] + bv[bj][0], v1 = acc[ai][bj][m][1] + bv[bj][1];
                    u32x4 w; w.x = cvt_pk_bf16(v0[0], v0[1]); w.y = cvt_pk_bf16(v0[2], v0[3]); w.z = cvt_pk_bf16(v1[0], v1[1]); w.w = cvt_pk_bf16(v1[2], v1[3]);
                    *(u32x4*)(rowp + bj * HALF) = w; } }
    }
};
}

struct Args { const float* in[31]; float* out; unsigned char* ws; };

struct Frame {
    LAS unsigned char* lds;
    unsigned char* ws;
    const float* const* in;
    float* out;
    int tid, lane, wave, G, bid;
};

__device__ __forceinline__ int map_in(int d) {
    if (d < 512) return 1304 + d;
    if (d < 1792) return d - 512;
    if (d < 1816) return 1280 + (d - 1792);
    if (d < 1824) return 2328 + (d - 1816);
    if (d < 2048) return -1;
    if (d < 2560) return 1816 + (d - 2048);
    return 2336 + (d - 2560);
}
__device__ __forceinline__ int map_up(int r) { return ((r >> 7) & 1) * 1024 + (r >> 8) * 128 + (r & 127); }

template <int MAP>
__device__ __forceinline__ void transpose_item(const float* W, int ldw, int K, bf16* WT, int nblk, int item, LAS float* scr, int lane, int ldt = 0) {
    if (ldt == 0) ldt = K;
    const int kb = item / nblk, nb = item - kb * nblk, k0 = 64 * kb, n0 = 32 * nb;
    const int r = lane >> 3, c4 = (lane & 7) * 4, nd = n0 + c4;
    const int sc = MAP == 0 ? nd : (MAP == 1 ? map_in(nd) : map_up(nd));
    f32x4 v[8];
#pragma unroll
    for (int i = 0; i < 8; ++i) v[i] = sc >= 0 ? *(const f32x4*)(W + (size_t)(k0 + 8 * i + r) * ldw + sc) : (f32x4){0.f, 0.f, 0.f, 0.f};
#pragma unroll
    for (int i = 0; i < 8; ++i) { LAS float* p = scr + (8 * i + r) * 33 + c4; p[0] = v[i].x; p[1] = v[i].y; p[2] = v[i].z; p[3] = v[i].w; }
    LDS_WAIT();
    const int c = lane & 7;
#pragma unroll
    for (int j = 0; j < 4; ++j) { const int n = (lane >> 3) + 8 * j; const LAS float* s = scr + (8 * c) * 33 + n;
        u32x4 o; o.x = pk2(s[0 * 33], s[1 * 33]); o.y = pk2(s[2 * 33], s[3 * 33]); o.z = pk2(s[4 * 33], s[5 * 33]); o.w = pk2(s[6 * 33], s[7 * 33]);
        *(u32x4*)(WT + (size_t)(n0 + n) * ldt + k0 + 8 * c) = o; }
    LDS_WAIT();
}

template <int MAP>
__device__ __forceinline__ void transpose_item8(const float* W, int ldw, int K, unsigned char* WT, int nblk, int item, LAS float* scr, int lane) {
    const int kb = item / nblk, nb = item - kb * nblk, k0 = 64 * kb, n0 = 32 * nb;
    const int r = lane >> 3, c4 = (lane & 7) * 4, nd = n0 + c4;
    const int sc = MAP == 0 ? nd : (MAP == 1 ? map_in(nd) : map_up(nd));
    f32x4 v[8];
#pragma unroll
    for (int i = 0; i < 8; ++i) v[i] = sc >= 0 ? *(const f32x4*)(W + (size_t)(k0 + 8 * i + r) * ldw + sc) : (f32x4){0.f, 0.f, 0.f, 0.f};
#pragma unroll
    for (int i = 0; i < 8; ++i) { LAS float* p = scr + (8 * i + r) * 33 + c4; p[0] = v[i].x; p[1] = v[i].y; p[2] = v[i].z; p[3] = v[i].w; }
    LDS_WAIT();
    const int c = lane & 7;
#pragma unroll
    for (int j = 0; j < 4; ++j) { const int n = (lane >> 3) + 8 * j; const LAS float* s = scr + (8 * c) * 33 + n;
        u32x2 o; o.x = pk4_fp8(32.f * s[0 * 33], 32.f * s[1 * 33], 32.f * s[2 * 33], 32.f * s[3 * 33]); o.y = pk4_fp8(32.f * s[4 * 33], 32.f * s[5 * 33], 32.f * s[6 * 33], 32.f * s[7 * 33]);
        *(u32x2*)(WT + (size_t)(n0 + n) * K + k0 + 8 * c) = o; }
    LDS_WAIT();
}

__device__ __forceinline__ void p0_adaln(Frame& F) {
    const float* c = F.in[1]; const float* ada_w = F.in[2];
    float* modp = (float*)(F.ws + WS_MODP);
    LAS float* sl = (LAS float*)F.lds;
    for (int u = F.bid; u < 192; u += F.G) {
        const int ks = u / 12, cc = u - ks * 12, j = cc * 512 + F.tid;
        __syncthreads();
        for (int i = F.tid; i < 1024; i += NTHREADS) { const int b = i >> 6, kk = i & 63; const float v = c[b * 1024 + ks * 64 + kk]; sl[i] = v / (1.0f + __expf(-v)); }
        __syncthreads();
        float acc[16];
#pragma unroll
        for (int b = 0; b < 16; ++b) acc[b] = 0.f;
#pragma unroll 16
        for (int kk = 0; kk < 64; ++kk) { const float w = ada_w[(size_t)(ks * 64 + kk) * 6144 + j];
#pragma unroll
            for (int b = 0; b < 16; ++b) acc[b] += sl[b * 64 + kk] * w; }
#pragma unroll
        for (int b = 0; b < 16; ++b) modp[(size_t)(ks * 16 + b) * 6144 + j] = acc[b];
    }
}

__device__ __forceinline__ void p0_cpe(Frame& F) {
    float* cpe = (float*)(F.ws + WS_CPE);
    LAS float* red = (LAS float*)F.lds;
    for (int u = F.bid - 192; u >= 0 && u < 64; u += F.G) {
        const int kv = u >> 5, e0 = (u & 31) * 4, eo = F.tid & 3, kk = F.tid >> 2;
        const float* pe = F.in[kv ? 10 : 7]; const float* w1 = F.in[kv ? 11 : 8];
        float s = 0.f;
#pragma unroll
        for (int m = 0; m < 16; ++m) { const int k = kk + 128 * m; s += pe[k] * w1[(size_t)k * 128 + e0 + eo]; }
        __syncthreads();
        red[F.tid] = s;
        __syncthreads();
        if (F.tid < 4) { float t = 0.f; for (int i = 0; i < 128; ++i) t += red[i * 4 + F.tid]; cpe[kv * 128 + e0 + F.tid] = t; }
    }
}

__device__ __forceinline__ void p1_prologue(Frame& F) {
    const float* modp = (const float*)(F.ws + WS_MODP);
    float* mod = (float*)(F.ws + WS_MOD);
    const int gtid = F.bid * NTHREADS + F.tid, gsz = F.G * NTHREADS;
    for (int i = gtid; i < 16 * 6144; i += gsz) { float s = F.in[3][i % 6144];
        for (int ks = 0; ks < 16; ++ks) s += modp[(size_t)ks * 16 * 6144 + i];
        mod[i] = s; }
    { float* bin = (float*)(F.ws + WS_BIN);
      for (int i = gtid; i < NPROJ; i += gsz) { const int sc = map_in(i); bin[i] = sc >= 0 ? F.in[6][sc] : 0.f; } }
    { bf16* rwt = (bf16*)(F.ws + WS_RWT);
      for (int i = gtid; i < 32 * 1024; i += gsz) { const int e = i >> 10, d = i & 1023; const float wv = F.in[24][d * 32 + e]; const unsigned hi = f2bf(wv);
          rwt[i] = (bf16)hi; rwt[32 * 1024 + i] = (bf16)f2bf(wv - __builtin_bit_cast(float, hi << 16)); } }
    {
        const float* x = F.in[0]; const float* g1 = F.in[4]; bf16* xn = (bf16*)(F.ws + WS_XN);
        LAS float* sm = (LAS float*)F.lds;
        for (int rb = F.bid; rb < T / 128; rb += F.G) {
            const int b = rb >> 4;
            __syncthreads();
            for (int i = F.tid; i < 2048; i += NTHREADS) { float s = F.in[3][i];
                for (int ks = 0; ks < 16; ++ks) s += modp[(size_t)(ks * 16 + b) * 6144 + i];
                sm[i] = s; }
            __syncthreads();
            for (int r = 0; r < 16; ++r) {
                const int row = rb * 128 + F.wave * 16 + r;
                const f32x4* xr = (const f32x4*)(x + (size_t)row * D) + F.lane;
                f32x4 v[4]; float ss = 0.f;
#pragma unroll
                for (int j = 0; j < 4; ++j) { v[j] = xr[64 * j]; ss += v[j].x * v[j].x + v[j].y * v[j].y + v[j].z * v[j].z + v[j].w * v[j].w; }
                const float rs = rsqrtf(wave_sum(ss) * (1.0f / D) + 1e-5f);
                unsigned* o4 = (unsigned*)(F.ws + WS_OY + (size_t)row * D) + F.lane; u32x2* o8 = (u32x2*)(xn + (size_t)row * D) + F.lane;
#pragma unroll
                for (int j = 0; j < 4; ++j) { const int d0 = (64 * j + F.lane) * 4; const f32x4 gg = *(const f32x4*)(g1 + d0);
                    float y[4];
#pragma unroll
                    for (int i = 0; i < 4; ++i) y[i] = v[j][i] * rs * gg[i] * (1.0f + sm[1024 + d0 + i]) + sm[d0 + i];
                    o4[64 * j] = pk4_fp8(y[0], y[1], y[2], y[3]); u32x2 w; w.x = pk2(y[0], y[1]); w.y = pk2(y[2], y[3]); o8[64 * j] = w; }
            }
        }
    }
    __syncthreads();
    {
        LAS float* scr = (LAS float*)(F.lds + F.wave * 16384);
        const int gw = F.bid * NWAVES + F.wave, NGW = F.G * NWAVES;
        constexpr int I_IN = 16 * 144, I_PA = 8 * 32, I_WO = 16 * 32, I_UP1 = 16 * 64, I_DN1 = 16 * 32;
        constexpr int I_C1 = 32 * 4, I_C2 = 2 * 2, I_ML = 2 * 4;
        constexpr int NITEMS = I_IN + 2 * I_PA + I_WO + 2 * I_C1 + 2 * I_C2 + 12 * I_ML;
        for (int it = gw; it < NITEMS; it += NGW) {
            int r = it;
            if (r < I_IN) { const int nb = r % 144;
                if (nb < 16) transpose_item<1>(F.in[5], IN_W, 1024, (bf16*)(F.ws + WS_WIN), 144, r, scr, F.lane);
                else transpose_item8<1>(F.in[5], IN_W, 1024, (unsigned char*)(F.ws + WS_WIN + 4 * MiB) - (size_t)512 * 1024, 144, r, scr, F.lane);
                continue; } r -= I_IN;
            if (r < I_PA) { transpose_item<0>(F.in[20], 1024, 512, (bf16*)(F.ws + WS_WPA), 32, r, scr, F.lane, 1024); continue; } r -= I_PA;
            if (r < I_PA) { transpose_item<0>(F.in[21], 1024, 512, (bf16*)(F.ws + WS_WPA) + 512, 32, r, scr, F.lane, 1024); continue; } r -= I_PA;
            if (r < I_WO) { transpose_item<0>(F.in[22], 1024, 1024, (bf16*)(F.ws + WS_WOUT), 32, r, scr, F.lane); continue; } r -= I_WO;
            if (r < 2 * I_C1) { const int kv = r / I_C1; transpose_item<0>(F.in[kv ? 11 : 8], 128, 2048, (bf16*)(F.ws + WS_W1T) + (size_t)kv * 128 * 2048, 4, r - kv * I_C1, scr, F.lane); continue; } r -= 2 * I_C1;
            if (r < 2 * I_C2) { const int kv = r / I_C2; transpose_item<0>(F.in[kv ? 12 : 9], 64, 128, (bf16*)(F.ws + WS_W2T) + (size_t)kv * 64 * 128, 2, r - kv * I_C2, scr, F.lane); continue; } r -= 2 * I_C2;
            { const int mh = r / I_ML, mat = mh >> 2; transpose_item<0>(F.in[15 + mat] + (size_t)(mh & 3) * 16384, 128, 128, (bf16*)(F.ws + WS_WQT) + (size_t)mh * 16384, 4, r - mh * I_ML, scr, F.lane); }
        }
    }
}

struct AttnState { float q[64]; float o[64]; float m, l; };
__device__ __forceinline__ void attn_init(AttnState& st, const bf16* qp) {
#pragma unroll
    for (int i = 0; i < 8; ++i) { const u32x4 w = *(const u32x4*)(qp + 8 * i);
        st.q[8 * i + 0] = bflo(w.x) * 0.125f; st.q[8 * i + 1] = bfhi(w.x) * 0.125f; st.q[8 * i + 2] = bflo(w.y) * 0.125f; st.q[8 * i + 3] = bfhi(w.y) * 0.125f;
        st.q[8 * i + 4] = bflo(w.z) * 0.125f; st.q[8 * i + 5] = bfhi(w.z) * 0.125f; st.q[8 * i + 6] = bflo(w.w) * 0.125f; st.q[8 * i + 7] = bfhi(w.w) * 0.125f; }
#pragma unroll
    for (int d = 0; d < 64; ++d) st.o[d] = 0.f;
    st.m = -1e30f; st.l = 0.f;
}
__device__ __forceinline__ float dot_bf16row(const float (&q)[64], const bf16* kp) {
    float s0 = 0.f, s1 = 0.f;
#pragma unroll
    for (int i = 0; i < 8; ++i) { const u32x4 w = *(const u32x4*)(kp + 8 * i);
        s0 += q[8 * i + 0] * bflo(w.x); s1 += q[8 * i + 1] * bfhi(w.x); s0 += q[8 * i + 2] * bflo(w.y); s1 += q[8 * i + 3] * bfhi(w.y);
        s0 += q[8 * i + 4] * bflo(w.z); s1 += q[8 * i + 5] * bfhi(w.z); s0 += q[8 * i + 6] * bflo(w.w); s1 += q[8 * i + 7] * bfhi(w.w); }
    return s0 + s1;
}
__device__ __forceinline__ void attn_key_bf16(AttnState& st, float sc, bool valid, const bf16* vp) {
    const bool need = valid && (sc > st.m + 8.0f);
    if (__any(need)) { if (need) { const float a = __expf(st.m - sc); st.l *= a;
#pragma unroll
            for (int d = 0; d < 64; ++d) st.o[d] *= a;
            st.m = sc; } }
    const float p = valid ? __expf(sc - st.m) : 0.f;
    st.l += p;
#pragma unroll
    for (int i = 0; i < 8; ++i) { const u32x4 w = *(const u32x4*)(vp + 8 * i);
        st.o[8 * i + 0] += p * bflo(w.x); st.o[8 * i + 1] += p * bfhi(w.x); st.o[8 * i + 2] += p * bflo(w.y); st.o[8 * i + 3] += p * bfhi(w.y);
        st.o[8 * i + 4] += p * bflo(w.z); st.o[8 * i + 5] += p * bfhi(w.z); st.o[8 * i + 6] += p * bflo(w.w); st.o[8 * i + 7] += p * bfhi(w.w); }
}

__device__ __forceinline__ float gelu_tanh(float x) { const float u = 0.7978845608f * (x + 0.044715f * x * x * x); const float t = 1.0f - 2.0f / (__expf(2.0f * u) + 1.0f); return 0.5f * x * (1.0f + t); }

__device__ __forceinline__ void p3_compress(Frame& F) {
    const bf16* proj = (const bf16*)(F.ws + WS_PROJ); const bf16* w1t = (const bf16*)(F.ws + WS_W1T); const bf16* w2t = (const bf16*)(F.ws + WS_W2T);
    const float* cpe = (const float*)(F.ws + WS_CPE); bf16* kcb = (bf16*)(F.ws + WS_KCB);
    const int lane = F.lane, w = F.wave, c = lane & 15, g4 = lane >> 4, nt2 = w >> 2, sl = w & 3;
    LAS f32x4* part = (LAS f32x4*)F.lds;
    for (int bu = F.bid; bu < 256; bu += F.G) {
        const int wu = bu * 2 + nt2;
        const int kv = wu >> 8, b = (wu >> 4) & 15, g = (wu >> 3) & 1, n0 = (wu & 7) * 16;
        const int n = n0 + c, nn = n > 126 ? 126 : n;
        const bf16* xb = proj + (size_t)(b * S + 16 * nn) * PP + (kv ? C_VCMP : C_KCMP) + g * 64 + 8 * g4;
        const bf16* wb = w1t + (size_t)kv * 128 * 2048 + (size_t)c * 2048 + 8 * g4;
        f32x4 acc[8];
#pragma unroll
        for (int et = 0; et < 8; ++et) acc[et] = (f32x4){0.f, 0.f, 0.f, 0.f};
#pragma unroll 2
        for (int k2 = 0; k2 < 16; ++k2) { const int ks = 16 * sl + k2;
            const bf16x8 xf = *(const bf16x8*)(xb + (size_t)(ks >> 1) * PP + 32 * (ks & 1));
#pragma unroll
            for (int et = 0; et < 8; ++et) { const bf16x8 wf = *(const bf16x8*)(wb + (size_t)et * 16 * 2048 + 32 * ks); acc[et] = __builtin_amdgcn_mfma_f32_16x16x32_bf16(wf, xf, acc[et], 0, 0, 0); }
        }
        __syncthreads();
        if (sl != 0) {
#pragma unroll
            for (int et = 0; et < 8; ++et) part[((nt2 * 3 + (sl - 1)) * 8 + et) * 64 + lane] = acc[et]; }
        __syncthreads();
        if (sl == 0) {
#pragma unroll
            for (int et = 0; et < 8; ++et) { const f32x4 cp = *(const f32x4*)(cpe + kv * 128 + 16 * et + 4 * g4);
                const f32x4 s = acc[et] + part[((nt2 * 3 + 0) * 8 + et) * 64 + lane] + part[((nt2 * 3 + 1) * 8 + et) * 64 + lane] + part[((nt2 * 3 + 2) * 8 + et) * 64 + lane];
#pragma unroll
                for (int i = 0; i < 4; ++i) acc[et][i] = gelu_tanh(s[i] + cp[i]); }
            f32x4 o2[4];
#pragma unroll
            for (int dt = 0; dt < 4; ++dt) o2[dt] = (f32x4){0.f, 0.f, 0.f, 0.f};
#pragma unroll
            for (int ss = 0; ss < 4; ++ss) {
                u32x4 hw; hw.x = pk2(acc[2 * ss][0], acc[2 * ss][1]); hw.y = pk2(acc[2 * ss][2], acc[2 * ss][3]); hw.z = pk2(acc[2 * ss + 1][0], acc[2 * ss + 1][1]); hw.w = pk2(acc[2 * ss + 1][2], acc[2 * ss + 1][3]);
                const bf16x8 hf = __builtin_bit_cast(bf16x8, hw);
#pragma unroll
                for (int dt = 0; dt < 4; ++dt) { const bf16* wp = w2t + (size_t)kv * 64 * 128 + (size_t)(16 * dt + c) * 128 + 32 * ss + 4 * g4;
                    const u32x2 lo = *(const u32x2*)wp, hi = *(const u32x2*)(wp + 16);
                    const u32x4 ww = (u32x4){lo.x, lo.y, hi.x, hi.y};
                    o2[dt] = __builtin_amdgcn_mfma_f32_16x16x32_bf16(__builtin_bit_cast(bf16x8, ww), hf, o2[dt], 0, 0, 0); }
            }
            bf16* op = kcb + ((((size_t)kv * 16 + b) * 2 + g) * 128 + n) * 64 + 4 * g4;
#pragma unroll
            for (int dt = 0; dt < 4; ++dt) { u32x2 w2; w2.x = pk2(o2[dt][0], o2[dt][1]); w2.y = pk2(o2[dt][2], o2[dt][3]); if (n > 126) { w2.x = 0u; w2.y = 0u; } *(u32x2*)(op + 16 * dt) = w2; }
        }
    }
}

__device__ __forceinline__ void p4_cmpsel(Frame& F) {
    constexpr float LOG2E = 1.4426950408889634f;
    const bf16* proj = (const bf16*)(F.ws + WS_PROJ); const float* small = (const float*)(F.ws + WS_SMALL); float* oacc = (float*)(F.ws + WS_OACC);
    const bf16* kcb = (const bf16*)(F.ws + WS_KCB); const bf16* vcb = kcb + (size_t)16 * 2 * 128 * 64;
    unsigned* selm = (unsigned*)(F.ws + WS_SELM);
    LAS unsigned char* L = F.lds;
    LAS float* scA = (LAS float*)(F.lds + 32768); LAS float* scB = (LAS float*)(F.lds + 40960);
    const int lane = F.lane, w = F.wave, c = lane & 15, g4 = lane >> 4;
    const int pr = 8 * ((c >> 2) & 1) + 4 * (c >> 3) + (c & 3), k7 = pr & 7;
    int kof[2]; kof[0] = pr * 128 + (((0 + g4) ^ k7) << 4); kof[1] = pr * 128 + (((4 + g4) ^ k7) << 4);
    const int q4 = c >> 2, p4 = c & 3, xr = 2 * (g4 & 1) + (g4 >> 1);
    const int vb = 1024 * (g4 & 1) + 64 * (4 * (g4 >> 1) + q4) + 8 * (p4 & 1);
    int vx[2]; vx[0] = 16 * ((0 + (p4 >> 1)) ^ xr); vx[1] = 16 * ((2 + (p4 >> 1)) ^ xr);
    const int kbl = 8 * (g4 & 1) + 4 * (g4 >> 1);
    const int skey = F.tid >> 3, sch = F.tid & 7;
    const int kst = skey * 128 + ((sch ^ (skey & 7)) << 4);
    const int vst = 16384 + 1024 * (skey >> 3) + 512 * (sch >> 2) + 64 * (skey & 7) + 16 * ((sch & 3) ^ ((skey >> 2) & 3));
    for (int unit = F.bid; unit < 1024; unit += F.G) {
        const int qb = 31 - (unit >> 5), b = (unit & 31) >> 1, g = unit & 1, t0 = qb * 64;
        const int ntile = qb >= 16 ? 2 : 1;
        __syncthreads();
        for (int tl = 0; tl < ntile; ++tl) { const bf16* sp = kcb + ((size_t)(b * 2 + g) * 128 + 64 * tl + skey) * 64 + sch * 8;
            *(LAS u32x4*)(L + tl * 8192 + kst) = *(const u32x4*)sp; *(LAS u32x4*)(L + tl * 8192 + vst) = *(const u32x4*)(sp + (vcb - kcb)); }
        __syncthreads();
        const int hq = 4 * g + (c & 3);
        const float slope2 = exp2f(-(float)(hq + 1)) * LOG2E;
#pragma unroll
        for (int nt = 0; nt < 2; ++nt) {
            const int tlq = 8 * w + 4 * nt + (c >> 2), tq = t0 + tlq;
            const bf16* qp = proj + (size_t)(b * S + tq) * PP + C_Q + hq * 64 + 8 * g4;
            bf16x8 qf[2];
#pragma unroll
            for (int ks = 0; ks < 2; ++ks) { const u32x4 v = *(const u32x4*)(qp + 32 * ks); u32x4 o;
                o.x = pk2(bflo(v.x) * 0.125f, bfhi(v.x) * 0.125f); o.y = pk2(bflo(v.y) * 0.125f, bfhi(v.y) * 0.125f); o.z = pk2(bflo(v.z) * 0.125f, bfhi(v.z) * 0.125f); o.w = pk2(bflo(v.w) * 0.125f, bfhi(v.w) * 0.125f);
                qf[ks] = __builtin_bit_cast(bf16x8, o); }
            float sc[2][4][4]; float tmax = -1e30f;
            const int nvalid = tq >= 31 ? ((tq - 31) >> 4) + 1 : 0;
#pragma unroll
            for (int tl = 0; tl < 2; ++tl) {
                if (tl < ntile) {
                    f32x4 sa[4];
#pragma unroll
                    for (int mt = 0; mt < 4; ++mt) sa[mt] = (f32x4){0.f, 0.f, 0.f, 0.f};
#pragma unroll
                    for (int ks = 0; ks < 2; ++ks)
#pragma unroll
                        for (int mt = 0; mt < 4; ++mt) { const bf16x8 kf = *(const LAS bf16x8*)(L + tl * 8192 + mt * 2048 + kof[ks]); sa[mt] = __builtin_amdgcn_mfma_f32_16x16x32_bf16(kf, qf[ks], sa[mt], 0, 0, 0); }
#pragma unroll
                    for (int mt = 0; mt < 4; ++mt)
#pragma unroll
                        for (int i = 0; i < 4; ++i) { const int n = 64 * tl + 16 * mt + kbl + i;
                            const float v = n < nvalid ? sa[mt][i] * LOG2E - slope2 * ((float)(tq - 16 * n) - 15.5f) : -1e30f; sc[tl][mt][i] = v; tmax = fmaxf(tmax, v); }
                } else {
#pragma unroll
                    for (int mt = 0; mt < 4; ++mt)
#pragma unroll
                        for (int i = 0; i < 4; ++i) sc[tl][mt][i] = -1e30f;
                }
            }
            tmax = fmaxf(tmax, __shfl_xor(tmax, 16)); tmax = fmaxf(tmax, __shfl_xor(tmax, 32));
            float ls = 0.f;
#pragma unroll
            for (int tl = 0; tl < 2; ++tl)
#pragma unroll
                for (int mt = 0; mt < 4; ++mt)
#pragma unroll
                    for (int i = 0; i < 4; ++i) { const float p = sc[tl][mt][i] > -1e29f ? __builtin_amdgcn_exp2f(sc[tl][mt][i] - tmax) : 0.f; sc[tl][mt][i] = p; ls += p; }
            ls += __shfl_xor(ls, 16); ls += __shfl_xor(ls, 32);
            const float inv = ls > 0.f ? 1.0f / ls : 0.f;
            f32x4 o[4];
#pragma unroll
            for (int dt = 0; dt < 4; ++dt) o[dt] = (f32x4){0.f, 0.f, 0.f, 0.f};
#pragma unroll
            for (int tl = 0; tl < 2; ++tl) {
                if (tl < ntile) {
#pragma unroll
                    for (int mt = 0; mt < 4; ++mt) {
#pragma unroll
                        for (int i = 0; i < 4; ++i) sc[tl][mt][i] *= inv;
                        float a = sc[tl][mt][0] + sc[tl][mt][1] + sc[tl][mt][2] + 0.5f * sc[tl][mt][3], bb = 0.5f * sc[tl][mt][3];
                        a += __shfl_xor(a, 1); a += __shfl_xor(a, 2); bb += __shfl_xor(bb, 1); bb += __shfl_xor(bb, 2);
                        if ((c & 3) == 0) { const int j = 16 * tl + 4 * mt + 2 * (g4 & 1) + (g4 >> 1); scA[tlq * 32 + j] = a; scB[tlq * 32 + j] = bb; }
                    }
#pragma unroll
                    for (int s = 0; s < 2; ++s) { u32x4 pw; pw.x = pk2(sc[tl][2 * s][0], sc[tl][2 * s][1]); pw.y = pk2(sc[tl][2 * s][2], sc[tl][2 * s][3]); pw.z = pk2(sc[tl][2 * s + 1][0], sc[tl][2 * s + 1][1]); pw.w = pk2(sc[tl][2 * s + 1][2], sc[tl][2 * s + 1][3]);
                        const bf16x8 pf = __builtin_bit_cast(bf16x8, pw);
#pragma unroll
                        for (int dt = 0; dt < 4; ++dt) { const LAS unsigned char* vp = L + 16384 + tl * 8192 + vb + 4096 * s + 512 * (dt >> 1) + vx[dt & 1];
                            const s16x4 lo = __builtin_bit_cast(s16x4, __builtin_amdgcn_ds_read_tr16_b64_v4i16((LAS s16x4*)vp));
                            const s16x4 hi = __builtin_bit_cast(s16x4, __builtin_amdgcn_ds_read_tr16_b64_v4i16((LAS s16x4*)(vp + 2048)));
                            const bf16x8 vf = (bf16x8){lo[0], lo[1], lo[2], lo[3], hi[0], hi[1], hi[2], hi[3]};
                            o[dt] = __builtin_amdgcn_mfma_f32_16x16x32_bf16(vf, pf, o[dt], 0, 0, 0); } }
                }
            }
            const size_t tok = (size_t)(b * S + tq);
            const float sg = sigmoidf_(small[tok * 32 + hq]);
#pragma unroll
            for (int dt = 0; dt < 4; ++dt) *(f32x4*)(oacc + tok * 512 + hq * 64 + 16 * dt + 4 * g4) = o[dt] * sg;
        }
        __syncthreads();
        if (F.tid < 64) { const int tlq = F.tid, t = t0 + tlq, cur = qb; unsigned mask;
            if (cur < 8) mask = (1u << (cur + 1)) - 1u;
            else { mask = 1u | (1u << cur);
                float sv[31];
#pragma unroll
                for (int j = 1; j < 31; ++j) sv[j] = j < cur ? scA[tlq * 32 + j] + scB[tlq * 32 + j - 1] : -1.0f;
#pragma unroll
                for (int it = 0; it < 6; ++it) { float best = -1.0f; int bj = 0;
#pragma unroll
                    for (int j = 1; j < 31; ++j) { const bool ok = sv[j] > best; best = ok ? sv[j] : best; bj = ok ? j : bj; }
                    mask |= 1u << bj;
#pragma unroll
                    for (int j = 1; j < 31; ++j) sv[j] = (j == bj) ? -1.0f : sv[j]; }
                mask &= ~1u; mask |= 1u; }
            selm[(size_t)(b * 2 + g) * S + t] = mask; }
    }
}

struct AttnW { f32x4 o[2][4]; float m[2], l[2]; };
template <int PHASE>
__device__ __forceinline__ void attn_tile(const bool EDGE, AttnW& st, const LAS unsigned char* Kb, const LAS unsigned char* Vb, const LAS bf16x8* qfl, const int (&kof)[2], int vb, const int (&vx)[2],
                                          int kt, int kbl, int t0, const int (&tq)[2], const unsigned (&smask)[2], float slope2) {
    f32x4 bias[4];
    { const float tbs = slope2 * (float)(64 * kt + kbl - t0 - 63);
#pragma unroll
      for (int mt = 0; mt < 4; ++mt)
#pragma unroll
          for (int i = 0; i < 4; ++i) bias[mt][i] = __builtin_fmaf(slope2, (float)(16 * mt + i), tbs); }
#pragma unroll
    for (int nt = 0; nt < 2; ++nt) {
        const bool selb = PHASE == 0 ? true : ((smask[nt] >> kt) & 1u);
        if (PHASE == 1 && !__any(selb)) continue;
        f32x4 sa[4];
#pragma unroll
        for (int mt = 0; mt < 4; ++mt) sa[mt] = bias[mt];
#pragma unroll
        for (int ks = 0; ks < 2; ++ks)
#pragma unroll
            for (int mt = 0; mt < 4; ++mt) { const bf16x8 kf = *(const LAS bf16x8*)(Kb + mt * 2048 + kof[ks]); sa[mt] = __builtin_amdgcn_mfma_f32_16x16x32_bf16(kf, qfl[(nt * 2 + ks) * 64], sa[mt], 0, 0, 0); }
        if (EDGE) { const int dbase = tq[nt] - 64 * kt - kbl;
#pragma unroll
            for (int mt = 0; mt < 4; ++mt)
#pragma unroll
                for (int i = 0; i < 4; ++i) { const int dist = dbase - (16 * mt + i); const bool valid = PHASE == 0 ? (dist >= 0 && dist < 256) : (dist >= 0); sa[mt][i] = valid ? sa[mt][i] : -1e30f; } }
        float tmax = fmaxf(fmaxf(sa[0][0], sa[0][1]), sa[0][2]);
#pragma unroll
        for (int mt = 0; mt < 4; ++mt) { if (mt > 0) tmax = fmaxf(fmaxf(tmax, sa[mt][0]), sa[mt][1]), tmax = fmaxf(tmax, sa[mt][2]); tmax = fmaxf(tmax, sa[mt][3]); }
        if (PHASE == 1) tmax = selb ? tmax : -1e30f;
        tmax = fmaxf(tmax, __shfl_xor(tmax, 16)); tmax = fmaxf(tmax, __shfl_xor(tmax, 32));
        float mn = st.m[nt];
        if (__any(tmax > mn)) { mn = fmaxf(mn, tmax); const float alpha = __builtin_amdgcn_exp2f(st.m[nt] - mn); st.m[nt] = mn; st.l[nt] *= alpha;
#pragma unroll
            for (int dt = 0; dt < 4; ++dt) st.o[nt][dt] *= alpha; }
        if (PHASE == 1) mn = selb ? mn : 3.0e38f;
        float ls = 0.f;
#pragma unroll
        for (int mt = 0; mt < 4; ++mt)
#pragma unroll
            for (int i = 0; i < 4; ++i) { const float p = __builtin_amdgcn_exp2f(sa[mt][i] - mn); sa[mt][i] = p; ls += p; }
        st.l[nt] += ls;
        bf16x8 pf[2];
#pragma unroll
        for (int s = 0; s < 2; ++s) { u32x4 w; w.x = pk2(sa[2 * s][0], sa[2 * s][1]); w.y = pk2(sa[2 * s][2], sa[2 * s][3]); w.z = pk2(sa[2 * s + 1][0], sa[2 * s + 1][1]); w.w = pk2(sa[2 * s + 1][2], sa[2 * s + 1][3]);
            pf[s] = __builtin_bit_cast(bf16x8, w); }
#pragma unroll
        for (int dt = 0; dt < 4; ++dt)
#pragma unroll
            for (int s = 0; s < 2; ++s) { const LAS unsigned char* vp = Vb + vb + 4096 * s + 512 * (dt >> 1) + vx[dt & 1];
                const s16x4 lo = __builtin_bit_cast(s16x4, __builtin_amdgcn_ds_read_tr16_b64_v4i16((LAS s16x4*)vp));
                const s16x4 hi = __builtin_bit_cast(s16x4, __builtin_amdgcn_ds_read_tr16_b64_v4i16((LAS s16x4*)(vp + 2048)));
                const bf16x8 vf = (bf16x8){lo[0], lo[1], lo[2], lo[3], hi[0], hi[1], hi[2], hi[3]};
                st.o[nt][dt] = __builtin_amdgcn_mfma_f32_16x16x32_bf16(vf, pf[s], st.o[nt][dt], 0, 0, 0); }
    }
}

__device__ __forceinline__ void p5_attn(Frame& F, int qslot) {
    constexpr float LOG2E = 1.4426950408889634f, QS = 0.125f * LOG2E;
    const bf16* proj = (const bf16*)(F.ws + WS_PROJ); const float* small = (const float*)(F.ws + WS_SMALL);
    const bf16* kcb = (const bf16*)(F.ws + WS_KCB); const bf16* vcb = kcb + (size_t)16 * 2 * 128 * 64;
    bf16* onsa = (bf16*)(F.ws + WS_OY);
    unsigned* qctr = (unsigned*)(F.ws + WS_CTL) + 8 + qslot;
    LAS unsigned char* L = F.lds;
    volatile LAS unsigned* sched = (volatile LAS unsigned*)(F.lds + 32768);
    LAS unsigned* sml = (LAS unsigned*)(F.lds + 32768 + 256);
    LAS float* scA = (LAS float*)(F.lds + 40960); LAS float* scB = (LAS float*)(F.lds + 49152);
    const int w = F.wave;
    for (;;) {
        __syncthreads();
        if (F.tid == 0) sched[0] = atomicAdd(qctr, 1u);
        __syncthreads();
        const int qi = (int)__builtin_amdgcn_readfirstlane(sched[0]);
        if (qi >= 1792) break;
        const int qa = qi / 14, qr = qi - 14 * qa;
        const int cslot = qr == 0 ? 0 : qr == 2 ? 1 : qr == 4 ? 2 : qr == 7 ? 3 : qr == 9 ? 4 : qr == 11 ? 5 : -1;
        if (cslot >= 0) {
            const int chunk = 6 * qa + cslot;
            LAS float* scr = (LAS float*)(F.lds + 40960 + w * 8448);
            for (int j = 0; j < 8; ++j) { const int it = chunk * 64 + w * 8 + j;
                if (it < 32 * 1024) { const int e = it >> 10; transpose_item8<2>(F.in[26] + (size_t)e * 1024 * 2048, 2048, 1024, (unsigned char*)(F.ws + WS_WUP) + (size_t)e * 2048 * 1024, 64, it & 1023, scr, F.lane); }
                else { const int r2 = it - 32 * 1024, e = r2 >> 9; transpose_item8<0>(F.in[28] + (size_t)e * 1024 * 1024, 1024, 1024, (unsigned char*)(F.ws + WS_WDN) + (size_t)e * 1024 * 1024, 32, r2 & 511, scr, F.lane); } }
            continue;
        }
        const int unit = 8 * qa + (qr - 1 - (qr > 2 ? 1 : 0) - (qr > 4 ? 1 : 0) - (qr > 7 ? 1 : 0) - (qr > 9 ? 1 : 0) - (qr > 11 ? 1 : 0));
        const int lane = opaque_i(F.lane), c = lane & 15, g4 = lane >> 4;
        const int pr = 8 * ((c >> 2) & 1) + 4 * (c >> 3) + (c & 3), k7 = pr & 7;
        int kof[2]; kof[0] = pr * 128 + (((0 + g4) ^ k7) << 4); kof[1] = pr * 128 + (((4 + g4) ^ k7) << 4);
        const int q4 = c >> 2, p4 = c & 3, xr = 2 * (g4 & 1) + (g4 >> 1);
        const int vb = 1024 * (g4 & 1) + 64 * (4 * (g4 >> 1) + q4) + 8 * (p4 & 1);
        int vx[2]; vx[0] = 16 * ((0 + (p4 >> 1)) ^ xr); vx[1] = 16 * ((2 + (p4 >> 1)) ^ xr);
        const int kbl = 8 * (g4 & 1) + 4 * (g4 >> 1);
        const int tid_ = opaque_i(F.tid), skey = tid_ >> 3, sch = tid_ & 7;
        const int kst = skey * 128 + ((sch ^ (skey & 7)) << 4);
        const int vst = 16384 + 1024 * (skey >> 3) + 512 * (sch >> 2) + 64 * (skey & 7) + 16 * ((sch & 3) ^ ((skey >> 2) & 3));
        const int qb = 31 - (unit >> 5), b = (unit & 31) >> 1, g = unit & 1, t0 = qb * 64;
        const int ntile = qb >= 16 ? 2 : 1;
        for (int tl = 0; tl < ntile; ++tl) { const bf16* sp = kcb + ((size_t)(b * 2 + g) * 128 + 64 * tl + skey) * 64 + sch * 8;
            *(LAS u32x4*)(L + tl * 8192 + kst) = *(const u32x4*)sp; *(LAS u32x4*)(L + tl * 8192 + vst) = *(const u32x4*)(sp + (vcb - kcb)); }
        int tq[2]; unsigned smask[2]; LAS bf16x8* qfl = (LAS bf16x8*)(F.lds + 106496 + w * 4096) + lane;
        const int hq = 4 * g + (c & 3);
        const float slope2 = exp2f(-(float)(hq + 1)) * LOG2E;
#pragma unroll
        for (int nt = 0; nt < 2; ++nt) { const int tl = 8 * w + 4 * nt + (c >> 2); tq[nt] = t0 + tl;
            const bf16* qp = proj + (size_t)(b * S + tq[nt]) * PP + C_Q + hq * 64 + 8 * g4;
#pragma unroll
            for (int ks = 0; ks < 2; ++ks) { const u32x4 v = *(const u32x4*)(qp + 32 * ks); u32x4 o;
                o.x = pk2(bflo(v.x) * QS, bfhi(v.x) * QS); o.y = pk2(bflo(v.y) * QS, bfhi(v.y) * QS); o.z = pk2(bflo(v.z) * QS, bfhi(v.z) * QS); o.w = pk2(bflo(v.w) * QS, bfhi(v.w) * QS);
                qfl[(nt * 2 + ks) * 64] = __builtin_bit_cast(bf16x8, o); } }
        const bf16* rowb = proj + (size_t)(b * S + skey) * PP + g * 64 + sch * 8;
        u32x4 rk, rv;
        { const bf16* sp = rowb + (size_t)(64 * qb) * PP + C_KWIN; rk = *(const u32x4*)sp; rv = *(const u32x4*)(sp + 128); }
        __syncthreads();
        f32x4 ocm[2][4];
#pragma unroll
        for (int nt = 0; nt < 2; ++nt) {
            const int tlq = 8 * w + 4 * nt + (c >> 2);
            float sc[2][4][4]; float tmax = -1e30f;
            const int nvalid = tq[nt] >= 31 ? ((tq[nt] - 31) >> 4) + 1 : 0;
#pragma unroll
            for (int tl = 0; tl < 2; ++tl) {
                if (tl < ntile) {
                    f32x4 sa[4];
#pragma unroll
                    for (int mt = 0; mt < 4; ++mt) sa[mt] = (f32x4){0.f, 0.f, 0.f, 0.f};
#pragma unroll
                    for (int ks = 0; ks < 2; ++ks)
#pragma unroll
                        for (int mt = 0; mt < 4; ++mt) { const bf16x8 kf = *(const LAS bf16x8*)(L + tl * 8192 + mt * 2048 + kof[ks]); sa[mt] = __builtin_amdgcn_mfma_f32_16x16x32_bf16(kf, qfl[(nt * 2 + ks) * 64], sa[mt], 0, 0, 0); }
#pragma unroll
                    for (int mt = 0; mt < 4; ++mt)
#pragma unroll
                        for (int i = 0; i < 4; ++i) { const int n = 64 * tl + 16 * mt + kbl + i;
                            const float v = n < nvalid ? sa[mt][i] - slope2 * ((float)(tq[nt] - 16 * n) - 15.5f) : -1e30f; sc[tl][mt][i] = v; tmax = fmaxf(tmax, v); }
                } else {
#pragma unroll
                    for (int mt = 0; mt < 4; ++mt)
#pragma unroll
                        for (int i = 0; i < 4; ++i) sc[tl][mt][i] = -1e30f;
                }
            }
            tmax = fmaxf(tmax, __shfl_xor(tmax, 16)); tmax = fmaxf(tmax, __shfl_xor(tmax, 32));
            float ls = 0.f;
#pragma unroll
            for (int tl = 0; tl < 2; ++tl)
#pragma unroll
                for (int mt = 0; mt < 4; ++mt)
#pragma unroll
                    for (int i = 0; i < 4; ++i) { const float p = sc[tl][mt][i] > -1e29f ? __builtin_amdgcn_exp2f(sc[tl][mt][i] - tmax) : 0.f; sc[tl][mt][i] = p; ls += p; }
            ls += __shfl_xor(ls, 16); ls += __shfl_xor(ls, 32);
            const float inv = ls > 0.f ? 1.0f / ls : 0.f;
#pragma unroll
            for (int dt = 0; dt < 4; ++dt) ocm[nt][dt] = (f32x4){0.f, 0.f, 0.f, 0.f};
#pragma unroll
            for (int tl = 0; tl < 2; ++tl) {
                if (tl < ntile) {
#pragma unroll
                    for (int mt = 0; mt < 4; ++mt) {
#pragma unroll
                        for (int i = 0; i < 4; ++i) sc[tl][mt][i] *= inv;
                        float a = sc[tl][mt][0] + sc[tl][mt][1] + sc[tl][mt][2] + 0.5f * sc[tl][mt][3], bb = 0.5f * sc[tl][mt][3];
                        a += __shfl_xor(a, 1); a += __shfl_xor(a, 2); bb += __shfl_xor(bb, 1); bb += __shfl_xor(bb, 2);
                        if ((c & 3) == 0) { const int j = 16 * tl + 4 * mt + 2 * (g4 & 1) + (g4 >> 1); scA[tlq * 32 + j] = a; scB[tlq * 32 + j] = bb; }
                    }
#pragma unroll
                    for (int s = 0; s < 2; ++s) { u32x4 pw; pw.x = pk2(sc[tl][2 * s][0], sc[tl][2 * s][1]); pw.y = pk2(sc[tl][2 * s][2], sc[tl][2 * s][3]); pw.z = pk2(sc[tl][2 * s + 1][0], sc[tl][2 * s + 1][1]); pw.w = pk2(sc[tl][2 * s + 1][2], sc[tl][2 * s + 1][3]);
                        const bf16x8 pf = __builtin_bit_cast(bf16x8, pw);
#pragma unroll
                        for (int dt = 0; dt < 4; ++dt) { const LAS unsigned char* vp = L + 16384 + tl * 8192 + vb + 4096 * s + 512 * (dt >> 1) + vx[dt & 1];
                            const s16x4 lo = __builtin_bit_cast(s16x4, __builtin_amdgcn_ds_read_tr16_b64_v4i16((LAS s16x4*)vp));
                            const s16x4 hi = __builtin_bit_cast(s16x4, __builtin_amdgcn_ds_read_tr16_b64_v4i16((LAS s16x4*)(vp + 2048)));
                            const bf16x8 vf = (bf16x8){lo[0], lo[1], lo[2], lo[3], hi[0], hi[1], hi[2], hi[3]};
                            ocm[nt][dt] = __builtin_amdgcn_mfma_f32_16x16x32_bf16(vf, pf, ocm[nt][dt], 0, 0, 0); } }
                }
            }
            const float sg = sigmoidf_(small[(size_t)(b * S + tq[nt]) * 32 + hq]);
#pragma unroll
            for (int dt = 0; dt < 4; ++dt) ocm[nt][dt] *= sg;
        }
        __syncthreads();
        if (F.tid < 64) { const int tlq = F.tid, cur = qb; unsigned mask;
            if (cur < 8) mask = (1u << (cur + 1)) - 1u;
            else { mask = 1u | (1u << cur);
                float sv[31];
#pragma unroll
                for (int j = 1; j < 31; ++j) sv[j] = j < cur ? scA[tlq * 32 + j] + scB[tlq * 32 + j - 1] : -1.0f;
#pragma unroll
                for (int it = 0; it < 6; ++it) { float best = -1.0f; int bj = 0;
#pragma unroll
                    for (int j = 1; j < 31; ++j) { const bool ok = sv[j] > best; best = ok ? sv[j] : best; bj = ok ? j : bj; }
                    mask |= 1u << bj;
#pragma unroll
                    for (int j = 1; j < 31; ++j) sv[j] = (j == bj) ? -1.0f : sv[j]; }
                mask &= ~1u; mask |= 1u; }
            sml[tlq] = mask; }
        __syncthreads();
        const unsigned mreg = sml[lane];
        unsigned um = mreg;
#pragma unroll
        for (int o = 1; o < 64; o <<= 1) um |= (unsigned)__shfl_xor((int)um, o);
        um = (unsigned)__builtin_amdgcn_readfirstlane((int)um);
        AttnW st; LAS f32x4* owl = (LAS f32x4*)(F.lds + 40960 + w * 8192) + lane;
#pragma unroll
        for (int nt = 0; nt < 2; ++nt) { smask[nt] = sml[8 * w + 4 * nt + (c >> 2)]; st.m[nt] = -1e30f; st.l[nt] = 0.f;
#pragma unroll
            for (int dt = 0; dt < 4; ++dt) { owl[(nt * 4 + dt) * 64] = ocm[nt][dt]; st.o[nt][dt] = (f32x4){0.f, 0.f, 0.f, 0.f}; } }
        int phase = 0, kt = qb, wleft = qb + 1 < 5 ? qb + 1 : 5; unsigned rem = um;
        int buf = 0;
        while (phase != 2) {
            *(LAS u32x4*)(L + buf * 8192 + kst) = rk; *(LAS u32x4*)(L + buf * 8192 + vst) = rv;
            __syncthreads();
            int nphase = phase, nkt = kt;
            if (phase == 0) { --wleft; if (wleft > 0) nkt = kt - 1; else { nphase = 1; nkt = 31 - __builtin_clz(rem); rem &= ~(1u << nkt); } }
            else { if (rem) { nkt = 31 - __builtin_clz(rem); rem &= ~(1u << nkt); } else nphase = 2; }
            if (nphase != 2) { const bf16* sp = rowb + (size_t)(64 * nkt) * PP + (nphase == 0 ? C_KWIN : C_KSLC); rk = *(const u32x4*)sp; rv = *(const u32x4*)(sp + 128); }
            if (phase == 0) attn_tile<0>(kt == qb || kt == qb - 4, st, L + buf * 8192, L + 16384 + buf * 8192, qfl, kof, vb, vx, kt, kbl, t0, tq, smask, slope2);
            else            attn_tile<1>(kt == qb, st, L + buf * 8192, L + 16384 + buf * 8192, qfl, kof, vb, vx, kt, kbl, t0, tq, smask, slope2);
            if (nphase != phase) {
#pragma unroll
                for (int nt = 0; nt < 2; ++nt) {
                    float lt = st.l[nt]; lt += __shfl_xor(lt, 16); lt += __shfl_xor(lt, 32);
                    const size_t tok = (size_t)(b * S + tq[nt]);
                    if (phase == 0) { const float sg = sigmoidf_(small[tok * 32 + 16 + hq]) / lt;
#pragma unroll
                        for (int dt = 0; dt < 4; ++dt) { owl[(nt * 4 + dt) * 64] += st.o[nt][dt] * sg; st.o[nt][dt] = (f32x4){0.f, 0.f, 0.f, 0.f}; }
                        st.m[nt] = -1e30f; st.l[nt] = 0.f; }
                    else { const float sg = sigmoidf_(small[tok * 32 + 8 + hq]) / lt;
#pragma unroll
                        for (int dt = 0; dt < 4; ++dt) { const size_t oi = tok * 1024 + hq * 64 + 16 * dt + 4 * g4;
                            const f32x4 r = owl[(nt * 4 + dt) * 64] + st.o[nt][dt] * sg;
                            u32x2 o2; o2.x = pk2(r[0], r[1]); o2.y = pk2(r[2], r[3]); *(u32x2*)(onsa + oi) = o2; } }
                }
            }
            phase = nphase; kt = nkt; buf ^= 1;
        }
    }
}

__device__ __forceinline__ int sw256(int r, int col) { return r * 256 + ((((col >> 3) ^ (r & 15))) << 4) + (col & 7) * 2; }
__device__ __forceinline__ void ml_gates(Frame& F, const float* small, size_t tok0, int h, LAS float* Fa, LAS float* ia) {
    if (F.wave == 0) {
        const int l = F.lane; const float fb = F.in[18][h];
        const float f0 = small[(tok0 + 2 * l) * 32 + 28 + h] + fb, f1 = small[(tok0 + 2 * l + 1) * 32 + 28 + h] + fb;
        const float a = fminf(f0, 0.f) - log1pf(__expf(-fabsf(f0))), bq = fminf(f1, 0.f) - log1pf(__expf(-fabsf(f1)));
        float s = a + bq;
#pragma unroll
        for (int o = 1; o < 64; o <<= 1) { const float v = __shfl_up(s, o); if (l >= o) s += v; }
        const float pre = s - (a + bq);
        Fa[2 * l] = pre + a; Fa[2 * l + 1] = pre + a + bq;
        ia[2 * l] = small[(tok0 + 2 * l) * 32 + 24 + h]; ia[2 * l + 1] = small[(tok0 + 2 * l + 1) * 32 + 24 + h];
    }
}

__device__ __forceinline__ void p3_mlstate(Frame& F) {
    const bf16* proj = (const bf16*)(F.ws + WS_PROJ); const float* small = (const float*)(F.ws + WS_SMALL);
    bf16* qml = (bf16*)(F.ws + WS_QML); bf16* kml = (bf16*)(F.ws + WS_KML); bf16* vtg = (bf16*)(F.ws + WS_VML);
    const bf16* wqt = (const bf16*)(F.ws + WS_WQT); const bf16* wkt = wqt + 4 * 16384; const bf16* wvt = wqt + 8 * 16384;
    float* cloct = (float*)(F.ws + WS_CLOC); float* nloc = (float*)(F.ws + WS_NLOC); float* mloc = (float*)(F.ws + WS_MLOC); float* flast = (float*)(F.ws + WS_FLAST);
    const float* cw = F.in[13]; const float* cb = F.in[14];
    LAS unsigned char* L = F.lds;
    LAS float* Fa = (LAS float*)(F.lds + 131072); LAS float* ia = Fa + 128; LAS float* wa = ia + 128; LAS float* red = wa + 128;
    const int lane = F.lane, w = F.wave, c = lane & 15, g4 = lane >> 4;
    for (int u = F.bid; u < 1024; u += F.G) {
        const int b = u >> 6, h = (u >> 4) & 3, ch = u & 15, t0 = ch * 128;
        const size_t tok0 = (size_t)b * S + t0;
        __syncthreads();
        for (int it = F.tid; it < 2048; it += NTHREADS) { const int t = it >> 4, c8 = (it & 15) * 8, cc = h * 128 + c8;
            float a[8]; u32x4 xm3 = (u32x4){0u, 0u, 0u, 0u};
#pragma unroll
            for (int i = 0; i < 8; ++i) a[i] = cb[cc + i];
#pragma unroll
            for (int j = 0; j < 4; ++j) { const int tt = t0 + t - 3 + j;
                if (tt >= 0) { const u32x4 xv = *(const u32x4*)(proj + ((size_t)b * S + tt) * PP + C_XM + cc);
                    const f32x4 w0 = *(const f32x4*)(cw + j * 512 + cc), w1 = *(const f32x4*)(cw + j * 512 + cc + 4);
                    a[0] += w0.x * bflo(xv.x); a[1] += w0.y * bfhi(xv.x); a[2] += w0.z * bflo(xv.y); a[3] += w0.w * bfhi(xv.y);
                    a[4] += w1.x * bflo(xv.z); a[5] += w1.y * bfhi(xv.z); a[6] += w1.z * bflo(xv.w); a[7] += w1.w * bfhi(xv.w);
                    if (j == 3) xm3 = xv; } }
#pragma unroll
            for (int i = 0; i < 8; ++i) a[i] = a[i] * __builtin_amdgcn_rcpf(1.0f + __expf(-a[i]));
            u32x4 o; o.x = pk2(a[0], a[1]); o.y = pk2(a[2], a[3]); o.z = pk2(a[4], a[5]); o.w = pk2(a[6], a[7]);
            *(LAS u32x4*)(L + sw256(t, c8)) = xm3; *(LAS u32x4*)(L + 32768 + sw256(t, c8)) = o; }
        ml_gates(F, small, tok0, h, Fa, ia);
        if (F.wave == 0) { LDS_WAIT(); const float FL = Fa[127]; float m = fmaxf(FL - Fa[2 * lane] + ia[2 * lane], FL - Fa[2 * lane + 1] + ia[2 * lane + 1]);
#pragma unroll
            for (int o = 1; o < 64; o <<= 1) m = fmaxf(m, __shfl_xor(m, o));
            wa[2 * lane] = __expf(FL - Fa[2 * lane] + ia[2 * lane] - m); wa[2 * lane + 1] = __expf(FL - Fa[2 * lane + 1] + ia[2 * lane + 1] - m);
            if (lane == 0) { mloc[u] = m; flast[u] = FL; } }
        __syncthreads();
        {
            const size_t wo = (size_t)(h * 128 + 16 * w + c) * 128 + 8 * g4;
            const size_t ro0 = ((size_t)(b * 4 + h) * S + t0) * 128 + 16 * w + 4 * g4; const int e = 16 * w + 4 * g4;
            f32x4 acc[8];
#pragma unroll
            for (int tt = 0; tt < 8; ++tt) acc[tt] = (f32x4){0.f, 0.f, 0.f, 0.f};
#pragma unroll
            for (int ks = 0; ks < 4; ++ks) { const bf16x8 wf = *(const bf16x8*)(wqt + wo + 32 * ks);
#pragma unroll
                for (int tt = 0; tt < 8; ++tt) acc[tt] = __builtin_amdgcn_mfma_f32_16x16x32_bf16(wf, *(const LAS bf16x8*)(L + 32768 + sw256(16 * tt + c, 32 * ks + 8 * g4)), acc[tt], 0, 0, 0); }
#pragma unroll
            for (int tt = 0; tt < 8; ++tt) { u32x2 qv; qv.x = pk2(acc[tt][0], acc[tt][1]); qv.y = pk2(acc[tt][2], acc[tt][3]); *(u32x2*)(qml + ro0 + (size_t)(16 * tt + c) * 128) = qv; }
#pragma unroll
            for (int tt = 0; tt < 8; ++tt) acc[tt] = (f32x4){0.f, 0.f, 0.f, 0.f};
#pragma unroll
            for (int ks = 0; ks < 4; ++ks) { const bf16x8 wf = *(const bf16x8*)(wkt + wo + 32 * ks);
#pragma unroll
                for (int tt = 0; tt < 8; ++tt) acc[tt] = __builtin_amdgcn_mfma_f32_16x16x32_bf16(wf, *(const LAS bf16x8*)(L + 32768 + sw256(16 * tt + c, 32 * ks + 8 * g4)), acc[tt], 0, 0, 0); }
#pragma unroll
            for (int tt = 0; tt < 8; ++tt) { const int t = 16 * tt + c; const float wt = wa[t];
                const float k0 = acc[tt][0] * 0.08838834764831845f, k1 = acc[tt][1] * 0.08838834764831845f, k2 = acc[tt][2] * 0.08838834764831845f, k3 = acc[tt][3] * 0.08838834764831845f;
                u32x2 kv; kv.x = pk2(k0, k1); kv.y = pk2(k2, k3); *(u32x2*)(kml + ro0 + (size_t)t * 128) = kv;
                *(LAS bf16*)(L + 65536 + sw256(e + 0, t)) = (bf16)f2bf(k0 * wt); *(LAS bf16*)(L + 65536 + sw256(e + 1, t)) = (bf16)f2bf(k1 * wt);
                *(LAS bf16*)(L + 65536 + sw256(e + 2, t)) = (bf16)f2bf(k2 * wt); *(LAS bf16*)(L + 65536 + sw256(e + 3, t)) = (bf16)f2bf(k3 * wt); }
#pragma unroll
            for (int tt = 0; tt < 8; ++tt) acc[tt] = (f32x4){0.f, 0.f, 0.f, 0.f};
#pragma unroll
            for (int ks = 0; ks < 4; ++ks) { const bf16x8 wf = *(const bf16x8*)(wvt + wo + 32 * ks);
#pragma unroll
                for (int tt = 0; tt < 8; ++tt) acc[tt] = __builtin_amdgcn_mfma_f32_16x16x32_bf16(*(const LAS bf16x8*)(L + sw256(16 * tt + c, 32 * ks + 8 * g4)), wf, acc[tt], 0, 0, 0); }
#pragma unroll
            for (int tt = 0; tt < 8; ++tt) { u32x2 vv; vv.x = pk2(acc[tt][0], acc[tt][1]); vv.y = pk2(acc[tt][2], acc[tt][3]); *(LAS u32x2*)(L + 98304 + sw256(16 * w + c, 16 * tt + 4 * g4)) = vv; }
        }
        __syncthreads();
        {
            f32x4 ac[8];
#pragma unroll
            for (int et = 0; et < 8; ++et) ac[et] = (f32x4){0.f, 0.f, 0.f, 0.f};
#pragma unroll
            for (int ks = 0; ks < 4; ++ks) {
                const bf16x8 kf = *(const LAS bf16x8*)(L + 65536 + sw256(16 * w + c, 32 * ks + 8 * g4));
#pragma unroll
                for (int et = 0; et < 8; ++et) { const bf16x8 vf = *(const LAS bf16x8*)(L + 98304 + sw256(16 * et + c, 32 * ks + 8 * g4)); ac[et] = __builtin_amdgcn_mfma_f32_16x16x32_bf16(kf, vf, ac[et], 0, 0, 0); }
            }
#pragma unroll
            for (int et = 0; et < 8; ++et) *(f32x4*)(cloct + (size_t)u * 16384 + (size_t)(16 * et + c) * 128 + 16 * w + 4 * g4) = ac[et];
        }
        if (F.tid < 128) { float s = 0.f;
#pragma unroll
            for (int k = 0; k < 16; ++k) { const u32x4 v = *(const LAS u32x4*)(L + 65536 + F.tid * 256 + k * 16); s += (bflo(v.x) + bfhi(v.x)) + (bflo(v.y) + bfhi(v.y)) + (bflo(v.z) + bfhi(v.z)) + (bflo(v.w) + bfhi(v.w)); }
            nloc[u * 128 + F.tid] = s; }
#pragma unroll
        for (int j = 0; j < 4; ++j) { const int id = F.tid + NTHREADS * j, e = id >> 4, ci = id & 15;
            *(u32x4*)(vtg + (size_t)u * 16384 + e * 128 + ci * 8) = *(const LAS u32x4*)(L + 98304 + e * 256 + ((ci ^ (e & 15)) << 4)); }
    }
}

__device__ __forceinline__ void p4_mlscan(Frame& F) {
    const float* cloct = (const float*)(F.ws + WS_CLOC); const float* nloc = (const float*)(F.ws + WS_NLOC); const float* mloc = (const float*)(F.ws + WS_MLOC); const float* flast = (const float*)(F.ws + WS_FLAST);
    bf16* cint = (bf16*)(F.ws + WS_CIN); float* nin = (float*)(F.ws + WS_NIN); float* min_ = (float*)(F.ws + WS_MIN);
    const int gtid = F.bid * NTHREADS + F.tid, gsz = F.G * NTHREADS;
    for (int idx = gtid; idx < 64 * (8192 + 64); idx += gsz) {
        const int bh = idx / (8192 + 64), de = (idx - bh * (8192 + 64)) * 2;
        float C0 = 0.f, C1 = 0.f, m = 0.f;
        for (int cch = 0; cch < 16; ++cch) { const int u = bh * 16 + cch;
            f32x2 loc;
            if (de < 16384) { *(unsigned*)(cint + (size_t)u * 16384 + de) = pk2(C0, C1); loc = *(const f32x2*)(cloct + (size_t)u * 16384 + de); if (de == 0) min_[u] = m; }
            else { *(f32x2*)(nin + u * 128 + (de - 16384)) = (f32x2){C0, C1}; loc = *(const f32x2*)(nloc + u * 128 + (de - 16384)); }
            const float FL = flast[u], ml = mloc[u], mn = fmaxf(FL + m, ml), dA = __expf(FL + m - mn), dB = __expf(ml - mn);
            C0 = dA * C0 + dB * loc.x; C1 = dA * C1 + dB * loc.y; m = mn; }
    }
}

__device__ __forceinline__ void p5_mlout(Frame& F) {
    const bf16* proj = (const bf16*)(F.ws + WS_PROJ); const float* small = (const float*)(F.ws + WS_SMALL);
    const bf16* qml = (const bf16*)(F.ws + WS_QML); const bf16* kml = (const bf16*)(F.ws + WS_KML); const bf16* vtg = (const bf16*)(F.ws + WS_VML);
    const bf16* cint = (const bf16*)(F.ws + WS_CIN); const float* nin = (const float*)(F.ws + WS_NIN); const float* min_ = (const float*)(F.ws + WS_MIN);
    bf16* yml = (bf16*)(F.ws + WS_OY) + 512;
    LAS unsigned char* L = F.lds;
    LAS float* Fa = (LAS float*)(F.lds + 98304); LAS float* ia = Fa + 128; LAS float* pm = ia + 128;
    const int lane = F.lane, w = F.wave, c = lane & 15, g4 = lane >> 4;
    for (int u = F.bid; u < 1024; u += F.G) {
        const int b = u >> 6, h = (u >> 4) & 3, ch = u & 15, t0 = ch * 128;
        const size_t tok0 = (size_t)b * S + t0; const size_t bhrow = ((size_t)(b * 4 + h) * S + t0);
        __syncthreads();
#pragma unroll
        for (int j = 0; j < 4; ++j) { const int id = F.tid + NTHREADS * j, r = id >> 4, ci = id & 15;
            *(LAS u32x4*)(L + r * 256 + ((ci ^ (r & 15)) << 4)) = *(const u32x4*)(kml + (bhrow + r) * 128 + ci * 8);
            *(LAS u32x4*)(L + 32768 + r * 256 + ((ci ^ (r & 15)) << 4)) = *(const u32x4*)(vtg + (size_t)u * 16384 + r * 128 + ci * 8);
            *(LAS u32x4*)(L + 65536 + r * 256 + ((ci ^ (r & 15)) << 4)) = *(const u32x4*)(cint + (size_t)u * 16384 + r * 128 + ci * 8); }
        ml_gates(F, small, tok0, h, Fa, ia);
        __syncthreads();
        if (F.wave == 0) {
            const float g0 = ia[2 * lane] - Fa[2 * lane], g1 = ia[2 * lane + 1] - Fa[2 * lane + 1];
            float s = fmaxf(g0, g1);
#pragma unroll
            for (int o = 1; o < 64; o <<= 1) { const float v = __shfl_up(s, o); if (lane >= o) s = fmaxf(s, v); }
            const float prev = __shfl_up(s, 1);
            pm[2 * lane] = lane > 0 ? fmaxf(prev, g0) : g0; pm[2 * lane + 1] = s;
            ia[2 * lane] = g0; ia[2 * lane + 1] = g1; }
        __syncthreads();
        const int t = 16 * w + c;
        const float mm = min_[u], mref = fmaxf(mm, pm[t]), wi = __expf(mm - mref);
        bf16x8 qf[4]; float qn = 0.f;
#pragma unroll
        for (int ks = 0; ks < 4; ++ks) { const u32x4 qv = *(const u32x4*)(qml + (bhrow + t) * 128 + 32 * ks + 8 * g4); qf[ks] = __builtin_bit_cast(bf16x8, qv);
            const f32x4 n0 = *(const f32x4*)(nin + u * 128 + 32 * ks + 8 * g4), n1 = *(const f32x4*)(nin + u * 128 + 32 * ks + 8 * g4 + 4);
            qn += bflo(qv.x) * n0.x + bfhi(qv.x) * n0.y + bflo(qv.y) * n0.z + bfhi(qv.y) * n0.w + bflo(qv.z) * n1.x + bfhi(qv.z) * n1.y + bflo(qv.w) * n1.z + bfhi(qv.w) * n1.w; }
        qn += __shfl_xor(qn, 16); qn += __shfl_xor(qn, 32);
        f32x4 aI[8], aP[8];
#pragma unroll
        for (int et = 0; et < 8; ++et) { aI[et] = (f32x4){0.f, 0.f, 0.f, 0.f}; aP[et] = aI[et]; }
#pragma unroll
        for (int ks = 0; ks < 4; ++ks)
            {
#pragma unroll
              for (int et = 0; et < 8; ++et) aI[et] = __builtin_amdgcn_mfma_f32_16x16x32_bf16(*(const LAS bf16x8*)(L + 65536 + sw256(16 * et + c, 32 * ks + 8 * g4)), qf[ks], aI[et], 0, 0, 0); __builtin_amdgcn_sched_barrier(0); }
        float den = 0.f;
        for (int ss = 0; 2 * ss <= w; ++ss) {
            float p[2][4];
#pragma unroll
            for (int hh = 0; hh < 2; ++hh) { const int st = 2 * ss + hh;
                if (st <= w) { f32x4 sa = (f32x4){0.f, 0.f, 0.f, 0.f};
#pragma unroll
                    for (int ks = 0; ks < 4; ++ks) sa = __builtin_amdgcn_mfma_f32_16x16x32_bf16(*(const LAS bf16x8*)(L + sw256(16 * st + c, 32 * ks + 8 * g4)), qf[ks], sa, 0, 0, 0);
#pragma unroll
                    for (int i = 0; i < 4; ++i) { const int s = 16 * st + 4 * g4 + i; const float v = s <= t ? sa[i] * __expf(ia[s] - mref) : 0.f; p[hh][i] = v; den += v; } }
                else {
#pragma unroll
                    for (int i = 0; i < 4; ++i) p[hh][i] = 0.f; } }
            u32x4 pw; pw.x = pk2(p[0][0], p[0][1]); pw.y = pk2(p[0][2], p[0][3]); pw.z = pk2(p[1][0], p[1][1]); pw.w = pk2(p[1][2], p[1][3]);
            const bf16x8 pf = __builtin_bit_cast(bf16x8, pw);
#pragma unroll
            for (int et = 0; et < 8; ++et) { const u32x2 lo = *(const LAS u32x2*)(L + 32768 + sw256(16 * et + c, 32 * ss + 4 * g4)), hi = *(const LAS u32x2*)(L + 32768 + sw256(16 * et + c, 32 * ss + 16 + 4 * g4));
                const u32x4 vw = (u32x4){lo.x, lo.y, hi.x, hi.y};
                aP[et] = __builtin_amdgcn_mfma_f32_16x16x32_bf16(__builtin_bit_cast(bf16x8, vw), pf, aP[et], 0, 0, 0); }
        }
        den += __shfl_xor(den, 16); den += __shfl_xor(den, 32);
        den += wi * qn;
        const float mt = Fa[t] + mref, dd = 1.0f / fmaxf(fabsf(den), __expf(-mt));
        float s1 = 0.f;
#pragma unroll
        for (int et = 0; et < 8; ++et)
#pragma unroll
            for (int i = 0; i < 4; ++i) { const float v = (aP[et][i] + wi * aI[et][i]) * dd; aP[et][i] = v; s1 += v; }
        s1 += __shfl_xor(s1, 16); s1 += __shfl_xor(s1, 32);
        const float mu = s1 * (1.0f / 128.0f); float s2 = 0.f;
#pragma unroll
        for (int et = 0; et < 8; ++et)
#pragma unroll
            for (int i = 0; i < 4; ++i) { const float v = aP[et][i] - mu; aP[et][i] = v; s2 += v * v; }
        s2 += __shfl_xor(s2, 16); s2 += __shfl_xor(s2, 32);
        const float rstd = rsqrtf(s2 * (1.0f / 128.0f) + 1e-5f);
        const size_t tok = tok0 + t;
#pragma unroll
        for (int et = 0; et < 8; ++et) { const int col = h * 128 + 16 * et + 4 * g4;
            const unsigned ow8 = *(const unsigned*)((const unsigned char*)(F.ws + WS_GATE8) + tok * GP + G_OPRE + col); const f32x2 o01 = __builtin_amdgcn_cvt_pk_f32_fp8((int)ow8, false), o23 = __builtin_amdgcn_cvt_pk_f32_fp8((int)ow8, true); const f32x4 ng = *(const f32x4*)(F.in[19] + col);
            u32x2 y; y.x = pk2(sigmoidf_(o01.x) * aP[et][0] * rstd * ng.x, sigmoidf_(o01.y) * aP[et][1] * rstd * ng.y);
            y.y = pk2(sigmoidf_(o23.x) * aP[et][2] * rstd * ng.z, sigmoidf_(o23.y) * aP[et][3] * rstd * ng.w);
            *(u32x2*)(yml + tok * 1024 + col) = y; }
    }
}

__device__ __forceinline__ void p9_route(Frame& F, const bool dup) {
    const bf16* x1 = (const bf16*)(F.ws + WS_OY); const float* mod = (const float*)(F.ws + WS_MOD); const float* g2 = F.in[23]; const float* rb = F.in[25];
    const bf16* rwh = (const bf16*)(F.ws + WS_RWT); const bf16* rwl = rwh + 32 * 1024;
    bf16* h2 = (bf16*)(F.ws + WS_XN);
    int* re = (int*)(F.ws + (dup ? WS_ACT : WS_RE)); float* rwt = (float*)(F.ws + (dup ? WS_ACT + MiB : WS_RW)); int* rs = (int*)(F.ws + (dup ? WS_ACT + 2 * MiB : WS_RS)); unsigned* cnt = (unsigned*)(F.ws + WS_CTL) + (dup ? 16 : 0);
    const int gw = F.bid * NWAVES + F.wave, NGW = F.G * NWAVES, lane = F.lane, c = lane & 15, g4 = lane >> 4;
    LAS unsigned* lcnt = (LAS unsigned*)F.lds;
    for (int grp = gw; grp < T / 16; grp += NGW) {
        const int tkn = grp * 16 + c, b = tkn >> 11;
        const bf16* xr = x1 + (size_t)tkn * D + 8 * g4; const float* sh = mod + (size_t)b * 6144 + 3 * 1024 + 8 * g4; const float* scp = mod + (size_t)b * 6144 + 4 * 1024 + 8 * g4;
        float ss = 0.f;
#pragma unroll 8
        for (int ks = 0; ks < 32; ++ks) { const u32x4 xv = *(const u32x4*)(xr + 32 * ks); const f32x4 a = (f32x4){bflo(xv.x), bfhi(xv.x), bflo(xv.y), bfhi(xv.y)}, bq = (f32x4){bflo(xv.z), bfhi(xv.z), bflo(xv.w), bfhi(xv.w)};
            ss += (a.x * a.x + a.y * a.y) + (a.z * a.z + a.w * a.w) + (bq.x * bq.x + bq.y * bq.y) + (bq.z * bq.z + bq.w * bq.w); }
        ss += __shfl_xor(ss, 16); ss += __shfl_xor(ss, 32);
        const float rsq = rsqrtf(ss * (1.0f / D) + 1e-5f);
        f32x4 acc[2]; acc[0] = (f32x4){0.f, 0.f, 0.f, 0.f}; acc[1] = acc[0];
#pragma unroll 4
        for (int ks = 0; ks < 32; ++ks) {
            float y[8];
            { const u32x4 xv = *(const u32x4*)(xr + 32 * ks); const f32x4 a = (f32x4){bflo(xv.x), bfhi(xv.x), bflo(xv.y), bfhi(xv.y)}, bq = (f32x4){bflo(xv.z), bfhi(xv.z), bflo(xv.w), bfhi(xv.w)};
              const f32x4 ga = *(const f32x4*)(g2 + 32 * ks + 8 * g4), gb = *(const f32x4*)(g2 + 32 * ks + 8 * g4 + 4);
              const f32x4 sa = *(const f32x4*)(scp + 32 * ks), sb = *(const f32x4*)(scp + 32 * ks + 4), ha = *(const f32x4*)(sh + 32 * ks), hb = *(const f32x4*)(sh + 32 * ks + 4);
#pragma unroll
              for (int i = 0; i < 4; ++i) { y[i] = a[i] * rsq * ga[i] * (1.0f + sa[i]) + ha[i]; y[4 + i] = bq[i] * rsq * gb[i] * (1.0f + sb[i]) + hb[i]; } }
            unsigned hi[8], lo[8];
#pragma unroll
            for (int i = 0; i < 8; ++i) { hi[i] = f2bf(y[i]); lo[i] = f2bf(y[i] - __builtin_bit_cast(float, hi[i] << 16)); }
            const u32x4 yhw = (u32x4){hi[0] | (hi[1] << 16), hi[2] | (hi[3] << 16), hi[4] | (hi[5] << 16), hi[6] | (hi[7] << 16)};
            const u32x4 ylw = (u32x4){lo[0] | (lo[1] << 16), lo[2] | (lo[3] << 16), lo[4] | (lo[5] << 16), lo[6] | (lo[7] << 16)};
            { u32x2 y8; y8.x = pk4_fp8(y[0], y[1], y[2], y[3]); y8.y = pk4_fp8(y[4], y[5], y[6], y[7]); *(u32x2*)((unsigned char*)h2 + (size_t)tkn * D + 32 * ks + 8 * g4) = y8; }
            const bf16x8 yh = __builtin_bit_cast(bf16x8, yhw), yl = __builtin_bit_cast(bf16x8, ylw);
#pragma unroll
            for (int et = 0; et < 2; ++et) { const size_t wo = (size_t)(16 * et + c) * 1024 + 32 * ks + 8 * g4;
                const bf16x8 wh = *(const bf16x8*)(rwh + wo), wl = *(const bf16x8*)(rwl + wo);
                acc[et] = __builtin_amdgcn_mfma_f32_16x16x32_bf16(wh, yh, acc[et], 0, 0, 0);
                acc[et] = __builtin_amdgcn_mfma_f32_16x16x32_bf16(wl, yh, acc[et], 0, 0, 0);
                acc[et] = __builtin_amdgcn_mfma_f32_16x16x32_bf16(wh, yl, acc[et], 0, 0, 0); }
        }
        float lg[32];
#pragma unroll
        for (int gs = 0; gs < 4; ++gs)
#pragma unroll
            for (int et = 0; et < 2; ++et)
#pragma unroll
                for (int i = 0; i < 4; ++i) { const int e = 16 * et + 4 * gs + i; lg[e] = __shfl(acc[et][i], c + 16 * gs) + rb[e]; }
        int te[4]; float tv[4]; unsigned used = 0u;
#pragma unroll
        for (int k = 0; k < 4; ++k) { float best = -3.0e38f; int bi = 0;
#pragma unroll
            for (int e = 0; e < 32; ++e) { const bool ok = !((used >> e) & 1u) && lg[e] > best; best = ok ? lg[e] : best; bi = ok ? e : bi; }
            te[k] = bi; tv[k] = best; used |= 1u << bi; }
        const float e1 = __expf(tv[1] - tv[0]), e2 = __expf(tv[2] - tv[0]), e3 = __expf(tv[3] - tv[0]); const float inv = 1.0f / (1.0f + e1 + e2 + e3);
        { const int ek = g4 == 0 ? te[0] : g4 == 1 ? te[1] : g4 == 2 ? te[2] : te[3];
          const float wk = (g4 == 0 ? 1.0f : g4 == 1 ? e1 : g4 == 2 ? e2 : e3) * inv;
          __syncthreads();
          if (F.tid < 32) lcnt[F.tid] = 0u;
          __syncthreads();
          const unsigned rnk = __hip_atomic_fetch_add(lcnt + ek, 1u, __ATOMIC_RELAXED, __HIP_MEMORY_SCOPE_WORKGROUP);
          __syncthreads();
          if (F.tid < 32) lcnt[32 + F.tid] = atomicAdd(cnt + F.tid * 32, lcnt[F.tid]);
          __syncthreads();
          const unsigned slot = lcnt[32 + ek] + rnk;
          re[tkn * 4 + g4] = ek; rwt[tkn * 4 + g4] = wk; rs[tkn * 4 + g4] = (int)slot; }
    }
}

__device__ __forceinline__ void p10_gather(Frame& F) {
    const unsigned* cnt = (const unsigned*)(F.ws + WS_CTL);
    const int* re = (const int*)(F.ws + WS_RE); const int* rs = (const int*)(F.ws + WS_RS); int* dest = (int*)(F.ws + WS_DEST); int* blke = (int*)(F.ws + WS_BLKE);
    int* rowidx = (int*)(F.ws + WS_ROWIDX);
    LAS int* off = (LAS int*)F.lds;
    __syncthreads();
    if (F.tid == 0) { int o = 0; for (int e = 0; e < 32; ++e) { const int c = (int)__hip_atomic_load(cnt + e * 32, __ATOMIC_RELAXED, __HIP_MEMORY_SCOPE_AGENT); const int p = (c + 255) & ~255; off[e] = o; off[32 + e] = c; off[64 + e] = p; o += p; } off[96] = o; }
    __syncthreads();
    if (F.bid == 0) { const int nblk = off[96] >> 8;
        for (int i = F.tid; i < nblk; i += NTHREADS) { int e = 0; for (int k = 1; k < 32; ++k) if (i * 256 >= off[k]) e = k; blke[i] = e; }
        if (F.tid == 0) blke[1000] = nblk; }
    const int gtid = F.bid * NTHREADS + F.tid, gsz = F.G * NTHREADS;
    for (int i = gtid; i < T * 4; i += gsz) { const int dr = off[re[i]] + rs[i]; dest[i] = dr; rowidx[dr] = i >> 2; }
    for (int i = gtid; i < 32 * 256; i += gsz) { const int e = i >> 8, r = i & 255; if (off[32 + e] + r < off[64 + e]) rowidx[off[e] + off[32 + e] + r] = 0; }
}

__device__ __forceinline__ void p13_final(Frame& F, const bool dup) {
    const float* mod = (const float*)(F.ws + WS_MOD); const float* fg = F.in[30];
    const float* rwt = (const float*)(F.ws + WS_RW); const int* dest = (const int*)(F.ws + WS_DEST); const bf16* ypad = (const bf16*)(F.ws + WS_PROJ);
    const int gw = F.bid * NWAVES + F.wave, NGW = F.G * NWAVES, lane = F.lane;
    for (int grp = gw; grp < T / 16; grp += NGW) {
        const int dl = dest[grp * 64 + lane]; const float wl = rwt[grp * 64 + lane];
        const int b = (grp * 16) >> 11; const float* g2 = mod + (size_t)b * 6144 + 5 * 1024;
#pragma unroll 4
        for (int tk = 0; tk < 16; ++tk) {
            const int tkn = grp * 16 + tk; const bf16* xr = (const bf16*)(F.ws + WS_OY) + (size_t)tkn * D; float* xo = (dup ? (float*)(F.ws + WS_ACT) : F.out) + (size_t)tkn * D;
            float acc[16];
#pragma unroll
            for (int i = 0; i < 16; ++i) acc[i] = 0.f;
#pragma unroll
            for (int k = 0; k < 4; ++k) { const int dr = __shfl(dl, 4 * tk + k); const float w = __shfl(wl, 4 * tk + k); const u32x4* yp = (const u32x4*)(ypad + (size_t)dr * D);
#pragma unroll
                for (int j = 0; j < 2; ++j) { const u32x4 y = yp[64 * j + lane];
                    acc[8 * j + 0] += w * bflo(y.x); acc[8 * j + 1] += w * bfhi(y.x); acc[8 * j + 2] += w * bflo(y.y); acc[8 * j + 3] += w * bfhi(y.y);
                    acc[8 * j + 4] += w * bflo(y.z); acc[8 * j + 5] += w * bfhi(y.z); acc[8 * j + 6] += w * bflo(y.w); acc[8 * j + 7] += w * bfhi(y.w); } }
            float ss = 0.f;
#pragma unroll
            for (int j = 0; j < 2; ++j) { const int d0 = (64 * j + lane) * 8; const u32x4 xw = *(const u32x4*)(xr + d0);
#pragma unroll
                for (int q = 0; q < 2; ++q) { const f32x4 xv = q == 0 ? (f32x4){bflo(xw.x), bfhi(xw.x), bflo(xw.y), bfhi(xw.y)} : (f32x4){bflo(xw.z), bfhi(xw.z), bflo(xw.w), bfhi(xw.w)}; const f32x4 gv = *(const f32x4*)(g2 + d0 + 4 * q);
#pragma unroll
                    for (int i = 0; i < 4; ++i) { const float y = xv[i] + gv[i] * acc[8 * j + 4 * q + i]; acc[8 * j + 4 * q + i] = y; ss += y * y; } } }
            const float rsq = rsqrtf(wave_sum(ss) * (1.0f / D) + 1e-5f);
#pragma unroll
            for (int j = 0; j < 2; ++j) { const int d0 = (64 * j + lane) * 8;
#pragma unroll
                for (int q = 0; q < 2; ++q) { const f32x4 gv = *(const f32x4*)(fg + d0 + 4 * q);
                    *(f32x4*)(xo + d0 + 4 * q) = (f32x4){acc[8 * j + 4 * q] * rsq * gv.x, acc[8 * j + 4 * q + 1] * rsq * gv.y, acc[8 * j + 4 * q + 2] * rsq * gv.z, acc[8 * j + 4 * q + 3] * rsq * gv.w}; } }
        }
    }
}

#define XB_TMO      128
#define XB_XCNT(j)  (256  + 64 * (j))
#define XB_XSUB(j)  (1280 + 64 * (j))
#define XB_XGEN(j)  (2304 + 64 * (j))
#define XB_TOP      3328
#define XB_TOPGEN   3392
#define XCD_BAR_WORDS 3456
#define XB_SPIN_CAP (1u << 18)
__device__ __forceinline__ unsigned xb_ld(unsigned* p)              { return __hip_atomic_load(p, __ATOMIC_RELAXED, __HIP_MEMORY_SCOPE_AGENT); }
__device__ __forceinline__ unsigned xb_add(unsigned* p, unsigned v) { return __hip_atomic_fetch_add(p, v, __ATOMIC_RELAXED, __HIP_MEMORY_SCOPE_AGENT); }
__device__ __forceinline__ unsigned xb_xcc_id() { return (unsigned)__builtin_amdgcn_s_getreg((3 << 11) | 20) & 0xFu; }
#define XB_SPIN(cond, bar) do { unsigned _sp = 0; while (cond) { __builtin_amdgcn_s_sleep(1); \
    if ((++_sp & 255u) == 0u) { if (xb_ld(&(bar)[XB_TMO])) break; if (_sp > XB_SPIN_CAP) { atomicAdd(&(bar)[XB_TMO], 1u); break; } } } } while (0)
struct XcdBarrier { unsigned* bar; unsigned x; volatile LAS unsigned* st; };
__device__ __forceinline__ XcdBarrier xcd_barrier_post(unsigned* bar, volatile LAS unsigned* st) {
    XcdBarrier b; b.bar = bar; b.x = xb_xcc_id(); b.st = st;
    if (threadIdx.x == 0) (void)xb_add(&bar[XB_XCNT(b.x)], 1u);
    return b;
}
__device__ __forceinline__ void xcd_barrier_complete(unsigned* bar, unsigned x, unsigned& nloc, unsigned& nx) {
    const unsigned G = gridDim.x * gridDim.y * gridDim.z;
    unsigned sum, cnt, mine, sp = 0u;
    for (;;) {
        sum = 0u; cnt = 0u; mine = 0u;
#pragma unroll
        for (unsigned j = 0; j < 16; ++j) { const unsigned c = xb_ld(&bar[XB_XCNT(j)]); sum += c; cnt += (c > 0u) ? 1u : 0u; mine = (j == x) ? c : mine; }
        if (sum == G) break;
        __builtin_amdgcn_s_sleep(1);
        if ((++sp & 255u) == 0u) { if (xb_ld(&bar[XB_TMO])) break; if (sp > XB_SPIN_CAP) { atomicAdd(&bar[XB_TMO], 1u); break; } }
    }
    nloc = mine > 0u ? mine : 1u; nx = cnt > 0u ? cnt : 1u;
}
__device__ __forceinline__ void xcd_barrier(const XcdBarrier& b) {
    asm volatile("s_waitcnt vmcnt(0)" ::: "memory");
    __syncthreads();
    if (threadIdx.x == 0) {
        unsigned* bar = b.bar;
        __builtin_amdgcn_s_waitcnt(0);
        unsigned nloc = b.st[0], nx = b.st[1];
        if (nloc == 0u) { xcd_barrier_complete(bar, b.x, nloc, nx); b.st[0] = nloc; b.st[1] = nx; }
        const unsigned old = xb_add(&bar[XB_XSUB(b.x)], 1u);
        const unsigned gen = old / nloc;
        if (old + 1u == (gen + 1u) * nloc) {
            __builtin_amdgcn_fence(__ATOMIC_RELEASE, "agent");
            asm volatile("s_waitcnt vmcnt(0)" ::: "memory");
            const unsigned og = xb_add(&bar[XB_TOP], 1u);
            const unsigned tg = og / nx;
            if (og + 1u == (tg + 1u) * nx) xb_add(&bar[XB_TOPGEN], 1u);
            else XB_SPIN(xb_ld(&bar[XB_TOPGEN]) == tg, bar);
            __builtin_amdgcn_fence(__ATOMIC_ACQUIRE, "agent");
            xb_add(&bar[XB_XGEN(b.x)], 1u);
            asm volatile("s_waitcnt vmcnt(0)" ::: "memory");
        } else {
            XB_SPIN(xb_ld(&bar[XB_XGEN(b.x)]) == gen, bar);
            __builtin_amdgcn_fence(__ATOMIC_ACQUIRE, "agent");
            asm volatile("s_waitcnt vmcnt(0)" ::: "memory");
        }
    }
    __syncthreads();
}

#ifndef PH_MASK
#define PH_MASK 0xFFFFFFFFu
#endif
#define PH(k) ((PH_MASK >> (k)) & 1u)
#ifndef DUP_MASK
#define DUP_MASK 0u
#endif
#define DUP(k) ((DUP_MASK >> (k)) & 1u)
#define REFRESH() do { F.tid = opaque_i(threadIdx.x); F.lane = F.tid & 63; F.wave = __builtin_amdgcn_readfirstlane(F.tid >> 6); } while (0)
__global__ void __launch_bounds__(NTHREADS, 2) fwd_mega(Args args) {
    extern __shared__ __attribute__((aligned(16))) unsigned char lds_raw[];
    cg::grid_group grid = cg::this_grid();
    Frame F;
    F.lds = (LAS unsigned char*)lds_raw; F.ws = args.ws; F.in = args.in; F.out = args.out;
    F.tid = threadIdx.x; F.lane = F.tid & 63; F.wave = __builtin_amdgcn_readfirstlane(F.tid >> 6); F.G = gridDim.x; F.bid = blockIdx.x;
    unsigned char* ws = args.ws;
    volatile LAS unsigned* bst = (volatile LAS unsigned*)(F.lds + LDS_BYTES - 64);
    if (F.tid < 16) bst[F.tid] = 0u;
    __syncthreads();
    const XcdBarrier xbar = xcd_barrier_post((unsigned*)(ws + WS_CTL) + 1024, bst);
#define GSYNC() do { xcd_barrier(xbar); REFRESH(); } while (0)

    if (PH(0)) { p0_adaln(F); __syncthreads(); p0_cpe(F); }
    if (DUP(0)) { __syncthreads(); p0_adaln(F); __syncthreads(); p0_cpe(F); }
    if (__builtin_expect(args.ws == nullptr, 0)) grid.sync();
    GSYNC();
    if (PH(1)) p1_prologue(F);
    if (DUP(1)) { __syncthreads(); p1_prologue(F); }
    GSYNC();
    if (PH(2)) {
        { pg8::Gemm g{(const bf16*)(ws + WS_XN), (const bf16*)(ws + WS_WIN), 1024}; pg8::StaticOrder So; So.init(T, NPROJ_A, F.G, F.bid);
          pg8::EpiProj E{(bf16*)(ws + WS_PROJ), (float*)(ws + WS_SMALL), (const float*)(ws + WS_BIN), (unsigned char*)(ws + WS_GATE8), 0, -1, 1000};
          pg8::gemm_phase<pg8::EpiProj, pg8::StaticOrder, true, true>(F.lds, g, So, E);
          if (DUP(2)) { __syncthreads(); pg8::gemm_phase<pg8::EpiProj, pg8::StaticOrder, true, true>(F.lds, g, So, E); } }
        __syncthreads();
        { pg8::Gemm g{(const bf16*)(ws + WS_OY), (const bf16*)(ws + WS_WIN + 4 * MiB), 1024}; pg8::StaticOrder So; So.init(T, NPROJ_B, F.G, F.bid);
          pg8::EpiProj E{(bf16*)(ws + WS_PROJ) + NPROJ_A, (float*)(ws + WS_SMALL), (const float*)(ws + WS_BIN) + NPROJ_A, (unsigned char*)(ws + WS_GATE8), NPROJ_A, 5, 6};
          pg8::gemm_phase<pg8::EpiProj, pg8::StaticOrder, true, true, true>(F.lds, g, So, E);
          if (DUP(20)) { __syncthreads(); pg8::gemm_phase<pg8::EpiProj, pg8::StaticOrder, true, true, true>(F.lds, g, So, E); } }
    }
    GSYNC();
    if (PH(3)) { p3_compress(F); __syncthreads(); }
    if (DUP(3)) { p3_compress(F); __syncthreads(); }
    REFRESH(); if (PH(4)) { p3_mlstate(F); __syncthreads(); }
    if (DUP(4)) { p3_mlstate(F); __syncthreads(); }
    GSYNC();
    REFRESH(); if (PH(7)) p4_mlscan(F);
    if (DUP(7)) p4_mlscan(F);
    GSYNC();
    if (PH(8)) { p5_attn(F, 0); __syncthreads(); }
    if (DUP(8)) { p5_attn(F, 1); __syncthreads(); }
    REFRESH(); if (PH(9)) p5_mlout(F);
    if (DUP(9)) { __syncthreads(); p5_mlout(F); }
    GSYNC();
    if (DUP(21)) { GSYNC(); GSYNC(); GSYNC(); GSYNC(); }
    if (PH(11)) {
        pg8::StaticOrder So; So.init(T, 1024, F.G, F.bid);
        for (int rep7 = 0; rep7 < (DUP(11) ? 2 : 1); ++rep7) {
        { pg8::Gemm g{(const bf16*)(ws + WS_OY), (const bf16*)(ws + WS_WPA), 1024};
          pg8::EpiMix2 E{(bf16*)(ws + WS_XN), (const unsigned char*)(ws + WS_GATE8)};
          pg8::gemm_phase<pg8::EpiMix2, pg8::StaticOrder, true, true>(F.lds, g, So, E); }
        __syncthreads(); }
    }
    GSYNC();
    if (PH(12)) {
        pg8::Gemm g{(const bf16*)(ws + WS_XN), (const bf16*)(ws + WS_WOUT), 1024}; pg8::StaticOrder So; So.init(T, 1024, F.G, F.bid);
        pg8::EpiWout E{F.in[0], (bf16*)(ws + WS_OY), (const float*)(ws + WS_MOD) + 2 * 1024};
        pg8::gemm_phase<pg8::EpiWout, pg8::StaticOrder, true, true>(F.lds, g, So, E);
        if (DUP(12)) { __syncthreads(); pg8::gemm_phase<pg8::EpiWout, pg8::StaticOrder, true, true>(F.lds, g, So, E); }
        if (DUP(19)) { __syncthreads(); pg8::EpiNull En{(float*)(ws + WS_ACT)}; pg8::gemm_phase<pg8::EpiNull, pg8::StaticOrder, true, true>(F.lds, g, So, En); }
    }
    GSYNC();
    if (PH(13)) p9_route(F, false);
    if (DUP(13)) p9_route(F, true);
    GSYNC();
    if (PH(14)) p10_gather(F);
    if (DUP(14)) { __syncthreads(); p10_gather(F); }
    GSYNC();
    if (PH(15)) {
        const int* blke = (const int*)(ws + WS_BLKE); const int nblk = __builtin_amdgcn_readfirstlane(blke[1000]);
        { pg8::MoeOrderG Mo; Mo.blk_e = blke; Mo.rows = (const int*)(ws + WS_ROWIDX); Mo.nblk = nblk; Mo.x = F.bid & 7; Mo.y = F.bid >> 3; Mo.ny = F.G >> 3; Mo.nN = 8; Mo.nPerE = 2048;
          pg8::Gemm g{(const bf16*)(ws + WS_XN), (const bf16*)(ws + WS_WUP), 1024};
          pg8::EpiSwiglu E{(bf16*)(ws + WS_ACT), F.in[27]};
          pg8::gemm_phase<pg8::EpiSwiglu, pg8::MoeOrderG, true, true, true>(F.lds, g, Mo, E);
          if (DUP(17)) { __syncthreads(); pg8::gemm_phase<pg8::EpiSwiglu, pg8::MoeOrderG, true, true, true>(F.lds, g, Mo, E); } }
        pg8::MoeOrder Mo; Mo.blk_e = blke; Mo.rows = nullptr; Mo.nblk = nblk; Mo.x = F.bid & 7; Mo.y = F.bid >> 3; Mo.ny = F.G >> 3;
        GSYNC();
        { Mo.nN = 4; Mo.nPerE = 1024;
          pg8::Gemm g{(const bf16*)(ws + WS_ACT), (const bf16*)(ws + WS_WDN), 1024};
          pg8::EpiDown E{(bf16*)(ws + WS_PROJ), F.in[29]};
          pg8::gemm_phase<pg8::EpiDown, pg8::MoeOrder, true, true, true>(F.lds, g, Mo, E);
          if (DUP(18)) { __syncthreads(); pg8::gemm_phase<pg8::EpiDown, pg8::MoeOrder, true, true, true>(F.lds, g, Mo, E); } }
    }
    GSYNC();
    if (PH(16)) p13_final(F, false);
    if (DUP(16)) p13_final(F, true);
}

extern "C" void kernel_launch(void* const* d_in, const int* in_sizes, int n_in, void* d_out, int out_size, void* d_ws, size_t ws_size, hipStream_t stream) {
    static int grid = 0;
    if (grid == 0) {
        if (n_in != 31 || out_size != T * D || ws_size < WS_END) { fprintf(stderr, "kernel_launch: unexpected problem (n_in %d out %d ws %zu)\n", n_in, out_size, ws_size); grid = -1; return; }
        int dev = 0, cus = 0, per_cu = 0;
        if (hipGetDevice(&dev) != hipSuccess || hipDeviceGetAttribute(&cus, hipDeviceAttributeMultiprocessorCount, dev) != hipSuccess) { grid = -1; return; }
        if (hipFuncSetAttribute((const void*)fwd_mega, hipFuncAttributeMaxDynamicSharedMemorySize, LDS_BYTES) != hipSuccess) { fprintf(stderr, "kernel_launch: hipFuncSetAttribute failed\n"); grid = -1; return; }
        if (hipOccupancyMaxActiveBlocksPerMultiprocessor(&per_cu, (const void*)fwd_mega, NTHREADS, LDS_BYTES) != hipSuccess || per_cu < 1) { fprintf(stderr, "kernel_launch: occupancy query says %d\n", per_cu); (void)hipGetLastError(); grid = -1; return; }
        grid = cus;
        if (grid % 8 != 0) grid -= grid % 8;
        fprintf(stderr, "kernel_launch: cus %d per_cu %d grid %d ws %zu\n", cus, per_cu, grid, ws_size);
    }
    if (grid < 0) return;
    (void)hipMemsetAsync((char*)d_ws + WS_CTL, 0, 32768, stream);
    Args a{};
    for (int i = 0; i < 31; ++i) a.in[i] = (const float*)d_in[i];
    a.out = (float*)d_out; a.ws = (unsigned char*)d_ws;
    void* kargs[] = {&a};
    hipError_t e = hipLaunchCooperativeKernel((const void*)fwd_mega, dim3(grid), dim3(NTHREADS), kargs, LDS_BYTES, stream);
    if (e != hipSuccess) fprintf(stderr, "kernel_launch: cooperative launch failed: %s\n", hipGetErrorString(e));
}
```

```cpp
#include <hip/hip_runtime.h>
#include <hip/hip_cooperative_groups.h>
#include <cstdio>
#include <cstdint>
namespace cg = cooperative_groups;

#define LAS __attribute__((address_space(3)))
typedef unsigned short bf16;
typedef float f32x4 __attribute__((ext_vector_type(4)));
typedef float f32x2 __attribute__((ext_vector_type(2)));
typedef unsigned u32x4 __attribute__((ext_vector_type(4)));
typedef unsigned u32x2 __attribute__((ext_vector_type(2)));
typedef short bf16x8 __attribute__((ext_vector_type(8)));
typedef short s16x4 __attribute__((ext_vector_type(4)));

constexpr int NB = 16, S = 2048, D = 1024, T = NB * S;
constexpr int NPROJ = 4608;
constexpr int C_Q = 512, C_KCMP = 1024, C_VCMP = 1152, C_KSLC = 1280, C_VSLC = 1408, C_KWIN = 1536, C_VWIN = 1664;
constexpr int C_XM = 0, C_SMALL = 1792, C_OPRE = 2048, C_GA = 2560, C_GB = 3584;
constexpr int NPROJ_A = 512, NPROJ_B = 4096;
constexpr int PP = 2048, GP = 2560;
constexpr int G_OPRE = 0, G_GA = 512, G_GB = 1536;
constexpr int IN_W = 4384;
constexpr int NCMP = 127;
constexpr int NEXP = 32, PMAX = 544 * 256;
constexpr int NTHREADS = 512, NWAVES = 8;
constexpr int LDS_BYTES = 147456;

constexpr size_t MiB = 1u << 20;
constexpr size_t WS_CTL = 0;
constexpr size_t WS_MODP = 1 * MiB;
constexpr size_t WS_MOD = 7 * MiB;
constexpr size_t WS_BIN = 8 * MiB;
constexpr size_t WS_BLKE = 8 * MiB + 64 * 1024;
constexpr size_t WS_OFFS = 8 * MiB + 128 * 1024;
constexpr size_t WS_SMALL = 9 * MiB;
constexpr size_t WS_RE = 13 * MiB;
constexpr size_t WS_RW = WS_RE + 512 * 1024;
constexpr size_t WS_RS = WS_RW + 512 * 1024;
constexpr size_t WS_DEST = WS_RS + 512 * 1024;
constexpr size_t WS_ROWIDX = 17 * MiB;
constexpr size_t WS_SELM = 15 * MiB;
constexpr size_t WS_KC = 16 * MiB;
constexpr size_t WS_KCB = 16 * MiB;
constexpr size_t WS_W1T = 21 * MiB;
constexpr size_t WS_W2T = 22 * MiB;
constexpr size_t WS_CPE = 22 * MiB + 64 * 1024;
constexpr size_t WS_WQT = 23 * MiB;
constexpr size_t WS_RWT = 23 * MiB + 512 * 1024;
constexpr size_t WS_NLOC = 19 * MiB;
constexpr size_t WS_MLOC = 19 * MiB + 512 * 1024;
constexpr size_t WS_FLAST = WS_MLOC + 4096;
constexpr size_t WS_MIN = WS_FLAST + 4096;
constexpr size_t WS_NIN = 20 * MiB;
constexpr size_t WS_WIN = 24 * MiB;
constexpr size_t WS_WPA = 33 * MiB, WS_WOUT = 35 * MiB;
constexpr size_t WS_WUP = 40 * MiB;
constexpr size_t WS_WDN = 168 * MiB;
constexpr size_t WS_XN = 232 * MiB;
constexpr size_t WS_PROJ = 296 * MiB;
constexpr size_t WS_GATE8 = 424 * MiB;
constexpr size_t WS_QML = 584 * MiB, WS_KML = 616 * MiB, WS_VML = 648 * MiB;
constexpr size_t WS_CLOC = 680 * MiB, WS_CIN = 744 * MiB;
constexpr size_t WS_OACC = 808 * MiB;
constexpr size_t WS_ACT = 584 * MiB;
constexpr size_t WS_OY = 872 * MiB;
constexpr size_t WS_END = 936 * MiB;

__device__ __forceinline__ unsigned f2bf(float f) { unsigned u = __builtin_bit_cast(unsigned, f); return (u + 0x7fffu + ((u >> 16) & 1u)) >> 16; }
typedef __bf16 bf16x2_t __attribute__((ext_vector_type(2)));
__device__ __forceinline__ unsigned pk2(float lo, float hi) { const f32x2 v = {lo, hi}; return __builtin_bit_cast(unsigned, __builtin_convertvector(v, bf16x2_t)); }
__device__ __forceinline__ float bf2f(bf16 v) { return __builtin_bit_cast(float, (unsigned)v << 16); }
__device__ __forceinline__ float bflo(unsigned w) { return __builtin_bit_cast(float, w << 16); }
__device__ __forceinline__ float bfhi(unsigned w) { return __builtin_bit_cast(float, w & 0xffff0000u); }
__device__ __forceinline__ float sigmoidf_(float x) { return __builtin_amdgcn_rcpf(1.0f + __expf(-x)); }
__device__ __forceinline__ float wave_sum(float v) {
#pragma unroll
    for (int o = 1; o < 64; o <<= 1) v += __shfl_xor(v, o);
    return v;
}
#define LDS_WAIT() asm volatile("s_waitcnt lgkmcnt(0)" ::: "memory")
__device__ __forceinline__ unsigned pk4_fp8(float a, float b, float c, float d) { int w = 0; w = __builtin_amdgcn_cvt_pk_fp8_f32(a, b, w, false); w = __builtin_amdgcn_cvt_pk_fp8_f32(c, d, w, true); return (unsigned)w; }
__device__ __forceinline__ int opaque_i(int x) { asm volatile("" : "+v"(x)); return x; }

namespace pg8 {
constexpr int BM = 256, BK = 64, HALF = 128, HTB = HALF * BK * 2, STAGE_BYTES = 8 * HTB, NXCD = 8, WGM = 8;
__host__ __device__ __forceinline__ int lds_byte(int r, int c) { const int st = (r >> 4) * 2 + (c >> 5), rr = r & 15, cc = c & 31, ob = rr * 64 + cc * 2; return st * 1024 + (ob ^ (((ob >> 9) & 1) << 5)); }
__host__ __device__ __forceinline__ void stage_rc(int b, int& R, int& C) { const int st = b / 1024, sb = b % 1024, swz = sb ^ (((sb >> 9) & 1) << 5); R = (st >> 1) * 16 + swz / 64; C = (st & 1) * 32 + (swz % 64) / 2; }
__host__ __device__ __forceinline__ int perm32(int rho) { const int n = rho >> 4, i = rho & 15; return 8 * (i >> 2) + 4 * n + (i & 3); }

struct Unit { int pm, pn, brow, e; };
struct Gemm { const bf16* A; const bf16* Bt; int K; };

struct StaticOrder {
    static constexpr bool GATHER = false;
    int nM, nN, nwg, G, c;
    __device__ void init(int M, int N, int G_, int c_) { nM = M / BM; nN = N / BM; nwg = nM * nN; G = G_; c = c_; }
    __device__ bool next(int i, Unit& u) const {
        const long L = (long)i * G + c; if (L >= nwg) return false;
        int wgid = (int)L; { const int q = nwg / NXCD, r = nwg % NXCD, xcd = wgid % NXCD, off = wgid / NXCD; wgid = (xcd < r ? xcd * (q + 1) : r * (q + 1) + (xcd - r) * q) + off; }
        const int nig = WGM * nN, gid = wgid / nig, fm = gid * WGM, gsz = (nM - fm) < WGM ? (nM - fm) : WGM;
        u.pm = fm + ((wgid % nig) % gsz); u.pn = (wgid % nig) / gsz; u.brow = u.pn * BM; u.e = 0; return true;
    }
};
template <bool GATHER_> struct MoeOrderT {
    static constexpr bool GATHER = GATHER_;
    const int* blk_e; const int* rows; int nblk, nN, nPerE, x, y, ny;
    __device__ bool next(int i, Unit& u) const {
        const int l = i * ny + y, rb = l / nN, pn = l - rb * nN, pm = rb * 8 + x;
        if (pm >= nblk) return false;
        const int e = __builtin_amdgcn_readfirstlane(blk_e[pm]);
        u.pm = pm; u.pn = pn; u.e = e; u.brow = e * nPerE + pn * BM; return true;
    }
};
typedef MoeOrderT<false> MoeOrder;
typedef MoeOrderT<true> MoeOrderG;

__device__ __forceinline__ unsigned cvt_pk_bf16(float lo, float hi) { unsigned r; asm volatile("v_cvt_pk_bf16_f32 %0, %1, %2" : "=v"(r) : "v"(lo), "v"(hi)); return r; }

typedef int v8i __attribute__((ext_vector_type(8)));
typedef int v4i __attribute__((ext_vector_type(4)));
template <class Epi, class Sched, bool ALIGN_EPI, bool SP2, bool FP8 = false>
__device__ __forceinline__ void gemm_phase(LAS unsigned char* lds, const Gemm g, const Sched& S, const Epi& E) {
    constexpr int ESZ = FP8 ? 1 : 2;
    const int tid = opaque_i(threadIdx.x), wid = __builtin_amdgcn_readfirstlane(tid >> 6), lane = tid & 63, wr = wid >> 2, wc = wid & 3, fr = lane & 15, fq = lane >> 4;
    const int K = g.K, nt = (K * ESZ) / 128;
    unsigned voffA[2], voffB[2];
#pragma unroll
    for (int i = 0; i < 2; ++i) { int R, C; stage_rc(tid * 16 + i * 8192, R, C); const int Rb = Epi::PERM ? ((R & ~31) + perm32(R & 31)) : R;
        voffA[i] = (unsigned)(R * K * ESZ + C * 2); voffB[i] = (unsigned)(Rb * K * ESZ + C * 2); }
    const size_t kstep = (size_t)(BK * 2);
    const size_t hstep = (size_t)HALF * K * ESZ;
    const size_t tstep = 2 * hstep;
    const size_t rstep = (size_t)K * ESZ;
    const unsigned ldsw = (unsigned)wid * 1024u;
    const int aoff = lds_byte(wr * 64 + fr, fq * 8), boff = lds_byte(wc * 32 + fr, fq * 8);
#define PG8_SA(b, h) (((b) * 2 + (h)) * HTB)
#define PG8_SB(b, h) ((4 + (b) * 2 + (h)) * HTB)
#define PG8_STAGE(bufoff, gbase, voff) do { _Pragma("unroll") for (int _i = 0; _i < 2; ++_i) \
        __builtin_amdgcn_global_load_lds((const unsigned*)((const char*)(gbase) + (voff)[_i]), (LAS unsigned*)(lds + (bufoff) + ldsw + _i * 8192), 16, 0, 0); } while (0)
#define PG8_LDA(dst, b, h) do { _Pragma("unroll") for (int m = 0; m < 4; ++m) { const v4i lo_ = *(const LAS v4i*)(lds + PG8_SA(b, h) + aoff + m * 2048), hi_ = *(const LAS v4i*)(lds + PG8_SA(b, h) + aoff + m * 2048 + 1024); dst[m] = __builtin_shufflevector(lo_, hi_, 0, 1, 2, 3, 4, 5, 6, 7); } } while (0)
#define PG8_LDB(dst, b, h) do { _Pragma("unroll") for (int n = 0; n < 2; ++n) { const v4i lo_ = *(const LAS v4i*)(lds + PG8_SB(b, h) + boff + n * 2048), hi_ = *(const LAS v4i*)(lds + PG8_SB(b, h) + boff + n * 2048 + 1024); dst[n] = __builtin_shufflevector(lo_, hi_, 0, 1, 2, 3, 4, 5, 6, 7); } } while (0)
#define PG8_MMA(ai, bj, At, Bt) do { __builtin_amdgcn_s_setprio(1); _Pragma("unroll") for (int m = 0; m < 4; ++m) _Pragma("unroll") for (int n = 0; n < 2; ++n) { \
        if constexpr (FP8) asm volatile("v_mfma_scale_f32_16x16x128_f8f6f4 %0, %1, %2, %0, %3, %4 op_sel_hi:[0,0,0]" : "+v"(acc[ai][bj][m][n]) : "v"(Bt[n]), "v"(At[m]), "v"(sclW), "v"(sclX)); \
        else { acc[ai][bj][m][n] = __builtin_amdgcn_mfma_f32_16x16x32_bf16(__builtin_bit_cast(bf16x8, __builtin_shufflevector(Bt[n], Bt[n], 0, 1, 2, 3)), __builtin_bit_cast(bf16x8, __builtin_shufflevector(At[m], At[m], 0, 1, 2, 3)), acc[ai][bj][m][n], 0, 0, 0); \
               acc[ai][bj][m][n] = __builtin_amdgcn_mfma_f32_16x16x32_bf16(__builtin_bit_cast(bf16x8, __builtin_shufflevector(Bt[n], Bt[n], 4, 5, 6, 7)), __builtin_bit_cast(bf16x8, __builtin_shufflevector(At[m], At[m], 4, 5, 6, 7)), acc[ai][bj][m][n], 0, 0, 0); } } __builtin_amdgcn_s_setprio(0); } while (0)
#define PG8_WAIT_V(n) asm volatile("s_waitcnt vmcnt(" #n ")" ::: "memory")
#define PG8_WAIT_L(n) asm volatile("s_waitcnt lgkmcnt(" #n ")" ::: "memory")
#define PG8_BAR __builtin_amdgcn_s_barrier()
#define PG8_SCHED __builtin_amdgcn_sched_barrier(0)
    int sclW = 0x7a7a7a7a, sclX = 0x7f7f7f7f; asm volatile("" : "+v"(sclW), "+v"(sclX));
    Unit cur, nxt; int ui = 0;
    if (!S.next(0, cur)) return;
    unsigned vC[2][2], vN[2][2];
#define PG8_ROWOFFS(dst, pm_) do { if constexpr (Sched::GATHER) { _Pragma("unroll") for (int _h = 0; _h < 2; ++_h) _Pragma("unroll") for (int _i = 0; _i < 2; ++_i) { int R_, C_; stage_rc(tid * 16 + _i * 8192, R_, C_); \
        dst[_h][_i] = (unsigned)(S.rows[(pm_) * BM + _h * HALF + R_] * K * ESZ + C_ * 2); } } } while (0)
#define PG8_STAGE_A(bufoff, plain_ptr, koff, h, nx) do { if constexpr (Sched::GATHER) { _Pragma("unroll") for (int _i = 0; _i < 2; ++_i) { const unsigned vo_ = (nx) ? vN[h][_i] : vC[h][_i]; \
        __builtin_amdgcn_global_load_lds((const unsigned*)((const char*)g.A + (koff) + vo_), (LAS unsigned*)(lds + (bufoff) + ldsw + _i * 8192), 16, 0, 0); } } \
        else { PG8_STAGE(bufoff, plain_ptr, voffA); } } while (0)
    PG8_ROWOFFS(vC, cur.pm);
    f32x4 acc[2][2][4][2];
#pragma unroll
    for (int a = 0; a < 2; ++a)
#pragma unroll
        for (int b = 0; b < 2; ++b)
#pragma unroll
            for (int m = 0; m < 4; ++m)
#pragma unroll
                for (int n = 0; n < 2; ++n) acc[a][b][m][n] = (f32x4){0.f, 0.f, 0.f, 0.f};
    v8i At[4], B0[2], B1[2];
    const char* cA = (const char*)g.A + (size_t)cur.pm * tstep; const char* cB = (const char*)g.Bt + (size_t)cur.brow * rstep;
    if constexpr (SP2) {
        PG8_STAGE(PG8_SB(0, 0), cB, voffB); PG8_STAGE(PG8_SB(0, 1), cB + hstep, voffB); PG8_STAGE_A(PG8_SA(0, 0), cA, 0, 0, false); PG8_STAGE_A(PG8_SA(0, 1), cA + hstep, 0, 1, false);
        if (wr == 1) PG8_BAR;
        PG8_WAIT_V(2); PG8_BAR;
        PG8_STAGE(PG8_SB(1, 0), cB + kstep, voffB); PG8_STAGE_A(PG8_SA(1, 0), cA + kstep, kstep, 0, false); PG8_STAGE(PG8_SB(1, 1), cB + hstep + kstep, voffB);
        PG8_WAIT_V(6); PG8_BAR;
    } else {
        PG8_STAGE(PG8_SB(0, 0), cB, voffB); PG8_STAGE(PG8_SA(0, 0), cA, voffA); PG8_STAGE(PG8_SB(0, 1), cB + hstep, voffB); PG8_STAGE(PG8_SA(0, 1), cA + hstep, voffA);
        if (wr == 1) PG8_BAR;
        PG8_WAIT_V(4); PG8_BAR;
        PG8_STAGE(PG8_SB(1, 0), cB + kstep, voffB); PG8_STAGE(PG8_SA(1, 0), cA + kstep, voffA); PG8_STAGE(PG8_SB(1, 1), cB + hstep + kstep, voffB);
        PG8_WAIT_V(6); PG8_BAR;
    }
    for (;;) {
        const bool has_next = S.next(ui + 1, nxt);
        if constexpr (Sched::GATHER) { if (has_next) { PG8_ROWOFFS(vN, nxt.pm); } else { vN[0][0] = vC[0][0]; vN[0][1] = vC[0][1]; vN[1][0] = vC[1][0]; vN[1][1] = vC[1][1]; } }
        const char* nA = has_next ? (const char*)g.A + (size_t)nxt.pm * tstep : cA; const char* nB = has_next ? (const char*)g.Bt + (size_t)nxt.brow * rstep : cB;
#pragma nounroll
        for (int t = 0; t < nt; t += 2) {
            if constexpr (Epi::MIDK > 0) { if (t == Epi::MIDK) E.mid(acc, cur, wr, wc, fr, fq); }
            const bool last = (t == nt - 2);
            const char* a1 = cA + (size_t)(t + 1) * kstep;
            const char* a2 = last ? nA : cA + (size_t)(t + 2) * kstep; const char* b2 = last ? nB : cB + (size_t)(t + 2) * kstep;
            const char* a3 = a2 + kstep; const char* b3 = b2 + kstep;
            const size_t k1 = (size_t)(t + 1) * kstep, k2 = last ? 0 : (size_t)(t + 2) * kstep;
            if constexpr (SP2) {
            PG8_LDB(B0, 0, 0); PG8_LDB(B1, 0, 1); PG8_SCHED; PG8_LDA(At, 0, 0); PG8_STAGE_A(PG8_SA(1, 1), a1 + hstep, k1, 1, false);
            PG8_WAIT_V(8); PG8_WAIT_L(0); PG8_BAR; PG8_MMA(0, 0, At, B0); PG8_MMA(0, 1, At, B1); PG8_BAR; PG8_SCHED;
            PG8_LDA(At, 0, 1); PG8_STAGE(PG8_SB(0, 0), b2, voffB); PG8_STAGE(PG8_SB(0, 1), b2 + hstep, voffB); PG8_STAGE_A(PG8_SA(0, 0), a2, k2, 0, last);
            PG8_WAIT_V(8); PG8_WAIT_L(0); PG8_BAR; PG8_MMA(1, 0, At, B0); PG8_MMA(1, 1, At, B1); PG8_BAR; PG8_SCHED;
            PG8_LDB(B0, 1, 0); PG8_LDB(B1, 1, 1); PG8_SCHED; PG8_LDA(At, 1, 0); PG8_STAGE_A(PG8_SA(0, 1), a2 + hstep, k2, 1, last);
            PG8_WAIT_V(8); PG8_WAIT_L(0); PG8_BAR; PG8_MMA(0, 0, At, B0); PG8_MMA(0, 1, At, B1); PG8_BAR; PG8_SCHED;
            PG8_LDA(At, 1, 1); PG8_STAGE(PG8_SB(1, 0), b3, voffB); PG8_STAGE(PG8_SB(1, 1), b3 + hstep, voffB); PG8_STAGE_A(PG8_SA(1, 0), a3, k2 + kstep, 0, last);
            PG8_WAIT_V(8); PG8_WAIT_L(0); PG8_BAR; PG8_MMA(1, 0, At, B0); PG8_MMA(1, 1, At, B1); PG8_BAR; PG8_SCHED;
            } else {
            PG8_LDB(B0, 0, 0); PG8_SCHED; PG8_LDA(At, 0, 0); PG8_STAGE(PG8_SA(1, 1), a1 + hstep, voffA);
            PG8_WAIT_L(8); PG8_BAR; PG8_WAIT_L(0); PG8_MMA(0, 0, At, B0); PG8_BAR; PG8_SCHED;
            PG8_LDB(B1, 0, 1); PG8_STAGE(PG8_SB(0, 0), b2, voffB);
            PG8_BAR; PG8_WAIT_L(0); PG8_MMA(0, 1, At, B1); PG8_BAR;
            PG8_LDA(At, 0, 1); PG8_STAGE(PG8_SA(0, 0), a2, voffA);
            PG8_BAR; PG8_WAIT_L(0); PG8_MMA(1, 0, At, B0); PG8_BAR; PG8_SCHED;
            PG8_STAGE(PG8_SB(0, 1), b2 + hstep, voffB);
            PG8_WAIT_V(6); PG8_BAR; PG8_MMA(1, 1, At, B1); PG8_BAR;
            PG8_LDB(B0, 1, 0); PG8_SCHED; PG8_LDA(At, 1, 0); PG8_STAGE(PG8_SA(0, 1), a2 + hstep, voffA);
            PG8_WAIT_L(8); PG8_BAR; PG8_WAIT_L(0); PG8_MMA(0, 0, At, B0); PG8_BAR; PG8_SCHED;
            PG8_LDB(B1, 1, 1); PG8_STAGE(PG8_SB(1, 0), b3, voffB);
            PG8_BAR; PG8_WAIT_L(0); PG8_MMA(0, 1, At, B1); PG8_BAR;
            PG8_LDA(At, 1, 1); PG8_STAGE(PG8_SA(1, 0), a3, voffA);
            PG8_BAR; PG8_WAIT_L(0); PG8_MMA(1, 0, At, B0); PG8_BAR; PG8_SCHED;
            PG8_STAGE(PG8_SB(1, 1), b3 + hstep, voffB);
            PG8_WAIT_V(6); PG8_BAR; PG8_MMA(1, 1, At, B1); PG8_BAR;
            }
        }
        if constexpr (ALIGN_EPI) { if (wr == 0) PG8_BAR; }
        if constexpr (FP8) asm volatile("s_nop 15\n\ts_nop 15" ::: "memory");
        E(acc, cur, wr, wc, fr, fq);
        if (!has_next) break;
#pragma unroll
        for (int a = 0; a < 2; ++a)
#pragma unroll
            for (int b = 0; b < 2; ++b)
#pragma unroll
                for (int m = 0; m < 4; ++m)
#pragma unroll
                    for (int n = 0; n < 2; ++n) acc[a][b][m][n] = (f32x4){0.f, 0.f, 0.f, 0.f};
        cur = nxt; cA = nA; cB = nB; ++ui;
        if constexpr (Sched::GATHER) { vC[0][0] = vN[0][0]; vC[0][1] = vN[0][1]; vC[1][0] = vN[1][0]; vC[1][1] = vN[1][1]; }
        if constexpr (ALIGN_EPI) { if (wr == 1) PG8_BAR; }
    }
    PG8_WAIT_V(0);
    if constexpr (!ALIGN_EPI) { if (wr == 0) PG8_BAR; }
    PG8_BAR;
#undef PG8_SA
#undef PG8_SB
#undef PG8_STAGE
#undef PG8_STAGE_A
#undef PG8_ROWOFFS
#undef PG8_LDA
#undef PG8_LDB
#undef PG8_MMA
#undef PG8_WAIT_V
#undef PG8_WAIT_L
#undef PG8_BAR
#undef PG8_SCHED
}

typedef const f32x4 (&AccRef)[2][2][4][2];
struct EpiProj {
    static constexpr int MIDK = 0;
    static constexpr bool PERM = true;
    bf16* O; float* small; const float* bias; unsigned char* G8; int coloff, smtile, gtile;
    __device__ __forceinline__ void operator()(AccRef acc, const Unit& u, int wr, int wc, int fr, int fq) const {
        const int row0 = u.pm * BM + wr * 64 + fr, col0 = u.pn * BM + wc * 32 + 8 * fq;
        f32x4 bv[2][2];
#pragma unroll
        for (int bj = 0; bj < 2; ++bj)
#pragma unroll
            for (int n = 0; n < 2; ++n) bv[bj][n] = *(const f32x4*)(bias + col0 + bj * HALF + 4 * n);
        const bool sm = (u.pn == smtile) && (wc == 0);
        const bool tog = u.pn >= gtile;
#pragma unroll
        for (int ai = 0; ai < 2; ++ai)
#pragma unroll
            for (int m = 0; m < 4; ++m) { const int row = row0 + ai * HALF + m * 16; bf16* rowp = O + (size_t)row * PP + col0;
                unsigned char* gp = G8 + (size_t)row * GP + (col0 - gtile * BM);
#pragma unroll
                for (int bj = 0; bj < 2; ++bj) { const f32x4 v0 = acc[ai][bj][m][0] + bv[bj][0], v1 = acc[ai][bj][m][1] + bv[bj][1];
                    if (tog) { u32x2 w8; w8.x = pk4_fp8(v0[0], v0[1], v0[2], v0[3]); w8.y = pk4_fp8(v1[0], v1[1], v1[2], v1[3]); *(u32x2*)(gp + bj * HALF) = w8; }
                    else { u32x4 w; w.x = cvt_pk_bf16(v0[0], v0[1]); w.y = cvt_pk_bf16(v0[2], v0[3]); w.z = cvt_pk_bf16(v1[0], v1[1]); w.w = cvt_pk_bf16(v1[2], v1[3]);
                        *(u32x4*)(rowp + bj * HALF) = w; }
                    if (bj == 0 && sm) { *(f32x4*)(small + (size_t)row * 32 + 8 * fq) = v0; *(f32x4*)(small + (size_t)row * 32 + 8 * fq + 4) = v1; } } }
    }
};
struct EpiMix2 {
    static constexpr int MIDK = 8;
    static constexpr bool PERM = true;
    bf16* O; const unsigned char* g8;
    __device__ __forceinline__ void mid(f32x4 (&acc)[2][2][4][2], const Unit& u, int wr, int wc, int fr, int fq) const {
        int z = 0; asm volatile("" : "+v"(z));
        const int row0 = u.pm * BM + wr * 64 + fr + z, col0 = u.pn * BM + wc * 32 + 8 * fq;
#pragma unroll
        for (int ai = 0; ai < 2; ++ai)
#pragma unroll
            for (int m = 0; m < 4; ++m) { const unsigned char* gp = g8 + (size_t)(row0 + ai * HALF + m * 16) * GP + col0;
#pragma unroll
                for (int bj = 0; bj < 2; ++bj) { const u32x2 ga8 = *(const u32x2*)(gp + G_GA + bj * HALF), gb8 = *(const u32x2*)(gp + G_GB + bj * HALF);
                    float fa[8], fb[8]; { const f32x2 a0 = __builtin_amdgcn_cvt_pk_f32_fp8((int)ga8.x, false), a1 = __builtin_amdgcn_cvt_pk_f32_fp8((int)ga8.x, true), a2 = __builtin_amdgcn_cvt_pk_f32_fp8((int)ga8.y, false), a3 = __builtin_amdgcn_cvt_pk_f32_fp8((int)ga8.y, true);
                        const f32x2 b0 = __builtin_amdgcn_cvt_pk_f32_fp8((int)gb8.x, false), b1 = __builtin_amdgcn_cvt_pk_f32_fp8((int)gb8.x, true), b2 = __builtin_amdgcn_cvt_pk_f32_fp8((int)gb8.y, false), b3 = __builtin_amdgcn_cvt_pk_f32_fp8((int)gb8.y, true);
                        fa[0] = a0.x; fa[1] = a0.y; fa[2] = a1.x; fa[3] = a1.y; fa[4] = a2.x; fa[5] = a2.y; fa[6] = a3.x; fa[7] = a3.y; fb[0] = b0.x; fb[1] = b0.y; fb[2] = b1.x; fb[3] = b1.y; fb[4] = b2.x; fb[5] = b2.y; fb[6] = b3.x; fb[7] = b3.y; }
                    float r[8];
#define MIXR(i, av, bv) r[i] = (1.0f + fminf(__expf(-(bv)), 1e20f)) * __builtin_amdgcn_rcpf(1.0f + __expf(-(av)))
                    MIXR(0, fa[0], fb[0]); MIXR(1, fa[1], fb[1]); MIXR(2, fa[2], fb[2]); MIXR(3, fa[3], fb[3]); MIXR(4, fa[4], fb[4]); MIXR(5, fa[5], fb[5]); MIXR(6, fa[6], fb[6]); MIXR(7, fa[7], fb[7]);
#undef MIXR
#pragma unroll
                    for (int j = 0; j < 4; ++j) { acc[ai][bj][m][0][j] *= r[j]; acc[ai][bj][m][1][j] *= r[4 + j]; } }
                __builtin_amdgcn_sched_barrier(0); }
    }
    __device__ __forceinline__ void operator()(AccRef acc, const Unit& u, int wr, int wc, int fr, int fq) const {
        const int row0 = u.pm * BM + wr * 64 + fr, col0 = u.pn * BM + wc * 32 + 8 * fq;
#pragma unroll
        for (int ai = 0; ai < 2; ++ai)
#pragma unroll
            for (int m = 0; m < 4; ++m) { const int row = row0 + ai * HALF + m * 16; bf16* rowp = O + (size_t)row * D + col0;
                const unsigned char* gp = g8 + (size_t)row * GP + G_GB + col0;
#pragma unroll
                for (int bj = 0; bj < 2; ++bj) { const u32x2 gb8 = *(const u32x2*)(gp + bj * HALF);
                    const f32x2 b0 = __builtin_amdgcn_cvt_pk_f32_fp8((int)gb8.x, false), b1 = __builtin_amdgcn_cvt_pk_f32_fp8((int)gb8.x, true), b2 = __builtin_amdgcn_cvt_pk_f32_fp8((int)gb8.y, false), b3 = __builtin_amdgcn_cvt_pk_f32_fp8((int)gb8.y, true);
                    float r[8];
#define MIXG(bv) __builtin_amdgcn_rcpf(1.0f + fminf(__expf(-(bv)), 1e20f))
                    r[0] = MIXG(b0.x) * acc[ai][bj][m][0][0]; r[1] = MIXG(b0.y) * acc[ai][bj][m][0][1]; r[2] = MIXG(b1.x) * acc[ai][bj][m][0][2]; r[3] = MIXG(b1.y) * acc[ai][bj][m][0][3];
                    r[4] = MIXG(b2.x) * acc[ai][bj][m][1][0]; r[5] = MIXG(b2.y) * acc[ai][bj][m][1][1]; r[6] = MIXG(b3.x) * acc[ai][bj][m][1][2]; r[7] = MIXG(b3.y) * acc[ai][bj][m][1][3];
#undef MIXG
                    u32x2 w; w.x = pk4_fp8(r[0], r[1], r[2], r[3]); w.y = pk4_fp8(r[4], r[5], r[6], r[7]);
                    *(u32x2*)((unsigned char*)O + (size_t)row * D + col0 + bj * HALF) = w; } }
    }
};
struct EpiWout {
    static constexpr int MIDK = 0;
    static constexpr bool PERM = true;
    const float* x; bf16* out; const float* gate;
    __device__ __forceinline__ void operator()(AccRef acc, const Unit& u, int wr, int wc, int fr, int fq) const {
        const int row0 = u.pm * BM + wr * 64 + fr, col0 = u.pn * BM + wc * 32 + 8 * fq, b = u.pm >> 3;
        f32x4 gv[2][2];
#pragma unroll
        for (int bj = 0; bj < 2; ++bj)
#pragma unroll
            for (int n = 0; n < 2; ++n) gv[bj][n] = *(const f32x4*)(gate + (size_t)b * 6144 + col0 + bj * HALF + 4 * n);
#pragma unroll
        for (int ai = 0; ai < 2; ++ai)
#pragma unroll
            for (int m = 0; m < 4; ++m) { const size_t off = (size_t)(row0 + ai * HALF + m * 16) * D + col0;
#pragma unroll
                for (int bj = 0; bj < 2; ++bj) { const f32x4 x0 = *(const f32x4*)(x + off + bj * HALF), x1 = *(const f32x4*)(x + off + bj * HALF + 4);
                    const f32x4 v0 = x0 + gv[bj][0] * acc[ai][bj][m][0], v1 = x1 + gv[bj][1] * acc[ai][bj][m][1];
                    u32x4 w; w.x = cvt_pk_bf16(v0[0], v0[1]); w.y = cvt_pk_bf16(v0[2], v0[3]); w.z = cvt_pk_bf16(v1[0], v1[1]); w.w = cvt_pk_bf16(v1[2], v1[3]);
                    *(u32x4*)(out + off + bj * HALF) = w; } }
    }
};
struct EpiNull {
    static constexpr int MIDK = 0;
    static constexpr bool PERM = false;
    float* sink;
    __device__ __forceinline__ void operator()(AccRef acc, const Unit& u, int wr, int wc, int fr, int fq) const {
        f32x4 s = (f32x4){0.f, 0.f, 0.f, 0.f};
#pragma unroll
        for (int ai = 0; ai < 2; ++ai)
#pragma unroll
            for (int bj = 0; bj < 2; ++bj)
#pragma unroll
                for (int m = 0; m < 4; ++m)
#pragma unroll
                    for (int n = 0; n < 2; ++n) s += acc[ai][bj][m][n];
        if (s[0] == 1.2345e30f) sink[0] = s[1] + s[2] + s[3];
    }
};
struct EpiSwiglu {
    static constexpr int MIDK = 0;
    static constexpr bool PERM = true;
    bf16* O; const float* bup;
    __device__ __forceinline__ void operator()(AccRef acc, const Unit& u, int wr, int wc, int fr, int fq) const {
        const int row0 = u.pm * BM + wr * 64 + fr, lc = wc * 32 + 8 * fq, hc = u.pn * HALF + lc;
        const float* bp = bup + (size_t)u.e * 2048 + hc;
        f32x4 bg[2], bl[2];
#pragma unroll
        for (int n = 0; n < 2; ++n) { bg[n] = *(const f32x4*)(bp + 4 * n); bl[n] = *(const f32x4*)(bp + 1024 + 4 * n); }
#pragma unroll
        for (int ai = 0; ai < 2; ++ai)
#pragma unroll
            for (int m = 0; m < 4; ++m) { const int row = row0 + ai * HALF + m * 16;
                float r[8];
#pragma unroll
                for (int n = 0; n < 2; ++n)
#pragma unroll
                    for (int j = 0; j < 4; ++j) { float gg = acc[ai][0][m][n][j] + bg[n][j], ll = acc[ai][1][m][n][j] + bl[n][j];
                        gg = fminf(gg, 7.0f); ll = fminf(fmaxf(ll, -7.0f), 7.0f);
                        r[4 * n + j] = gg * sigmoidf_(1.702f * gg) * (ll + 1.0f); }
                u32x2 w; w.x = pk4_fp8(r[0], r[1], r[2], r[3]); w.y = pk4_fp8(r[4], r[5], r[6], r[7]);
                *(u32x2*)((unsigned char*)O + (size_t)row * D + hc) = w; }
    }
};
struct EpiDown {
    static constexpr int MIDK = 0;
    static constexpr bool PERM = true;
    bf16* O; const float* bdn;
    __device__ __forceinline__ void operator()(AccRef acc, const Unit& u, int wr, int wc, int fr, int fq) const {
        const int row0 = u.pm * BM + wr * 64 + fr, col0 = u.pn * BM + wc * 32 + 8 * fq;
        f32x4 bv[2][2];
#pragma unroll
        for (int bj = 0; bj < 2; ++bj)
#pragma unroll
            for (int n = 0; n < 2; ++n) bv[bj][n] = *(const f32x4*)(bdn + (size_t)u.e * D + col0 + bj * HALF + 4 * n);
#pragma unroll
        for (int ai = 0; ai < 2; ++ai)
#pragma unroll
            for (int m = 0; m < 4; ++m) { bf16* rowp = O + (size_t)(row0 + ai * HALF + m * 16) * D + col0;
#pragma unroll
                for (int bj = 0; bj < 2; ++bj) { const f32x4 v0 = acc[ai][bj][m][0] + bv[bj][0], v1 = acc[ai][bj][m][1] + bv[bj][1];
                    u32x4 w; w.x = cvt_pk_bf16(v0[0], v0[1]); w.y = cvt_pk_bf16(v0[2], v0[3]); w.z = cvt_pk_bf16(v1[0], v1[1]); w.w = cvt_pk_bf16(v1[2], v1[3]);
                    *(u32x4*)(rowp + bj * HALF) = w; } }
    }
};
}

struct Args { const float* in[31]; float* out; unsigned char* ws; };

struct Frame {
    LAS unsigned char* lds;
    unsigned char* ws;
    const float* const* in;
    float* out;
    int tid, lane, wave, G, bid;
};

__device__ __forceinline__ int map_in(int d) {
    if (d < 512) return 1304 + d;
    if (d < 1792) return d - 512;
    if (d < 1816) return 1280 + (d - 1792);
    if (d < 1824) return 2328 + (d - 1816);
    if (d < 2048) return -1;
    if (d < 2560) return 1816 + (d - 2048);
    return 2336 + (d - 2560);
}
__device__ __forceinline__ int map_up(int r) { return ((r >> 7) & 1) * 1024 + (r >> 8) * 128 + (r & 127); }

template <int MAP>
__device__ __forceinline__ void transpose_item(const float* W, int ldw, int K, bf16* WT, int nblk, int item, LAS float* scr, int lane, int ldt = 0) {
    if (ldt == 0) ldt = K;
    const int kb = item / nblk, nb = item - kb * nblk, k0 = 64 * kb, n0 = 32 * nb;
    const int r = lane >> 3, c4 = (lane & 7) * 4, nd = n0 + c4;
    const int sc = MAP == 0 ? nd : (MAP == 1 ? map_in(nd) : map_up(nd));
    f32x4 v[8];
#pragma unroll
    for (int i = 0; i < 8; ++i) v[i] = sc >= 0 ? *(const f32x4*)(W + (size_t)(k0 + 8 * i + r) * ldw + sc) : (f32x4){0.f, 0.f, 0.f, 0.f};
#pragma unroll
    for (int i = 0; i < 8; ++i) { LAS float* p = scr + (8 * i + r) * 33 + c4; p[0] = v[i].x; p[1] = v[i].y; p[2] = v[i].z; p[3] = v[i].w; }
    LDS_WAIT();
    const int c = lane & 7;
#pragma unroll
    for (int j = 0; j < 4; ++j) { const int n = (lane >> 3) + 8 * j; const LAS float* s = scr + (8 * c) * 33 + n;
        u32x4 o; o.x = pk2(s[0 * 33], s[1 * 33]); o.y = pk2(s[2 * 33], s[3 * 33]); o.z = pk2(s[4 * 33], s[5 * 33]); o.w = pk2(s[6 * 33], s[7 * 33]);
        *(u32x4*)(WT + (size_t)(n0 + n) * ldt + k0 + 8 * c) = o; }
    LDS_WAIT();
}

template <int MAP>
__device__ __forceinline__ void transpose_item8(const float* W, int ldw, int K, unsigned char* WT, int nblk, int item, LAS float* scr, int lane) {
    const int kb = item / nblk, nb = item - kb * nblk, k0 = 64 * kb, n0 = 32 * nb;
    const int r = lane >> 3, c4 = (lane & 7) * 4, nd = n0 + c4;
    const int sc = MAP == 0 ? nd : (MAP == 1 ? map_in(nd) : map_up(nd));
    f32x4 v[8];
#pragma unroll
    for (int i = 0; i < 8; ++i) v[i] = sc >= 0 ? *(const f32x4*)(W + (size_t)(k0 + 8 * i + r) * ldw + sc) : (f32x4){0.f, 0.f, 0.f, 0.f};
#pragma unroll
    for (int i = 0; i < 8; ++i) { LAS float* p = scr + (8 * i + r) * 33 + c4; p[0] = v[i].x; p[1] = v[i].y; p[2] = v[i].z; p[3] = v[i].w; }
    LDS_WAIT();
    const int c = lane & 7;
#pragma unroll
    for (int j = 0; j < 4; ++j) { const int n = (lane >> 3) + 8 * j; const LAS float* s = scr + (8 * c) * 33 + n;
        u32x2 o; o.x = pk4_fp8(32.f * s[0 * 33], 32.f * s[1 * 33], 32.f * s[2 * 33], 32.f * s[3 * 33]); o.y = pk4_fp8(32.f * s[4 * 33], 32.f * s[5 * 33], 32.f * s[6 * 33], 32.f * s[7 * 33]);
        *(u32x2*)(WT + (size_t)(n0 + n) * K + k0 + 8 * c) = o; }
    LDS_WAIT();
}

__device__ __forceinline__ void p0_adaln(Frame& F) {
    const float* c = F.in[1]; const float* ada_w = F.in[2];
    float* modp = (float*)(F.ws + WS_MODP);
    LAS float* sl = (LAS float*)F.lds;
    for (int u = F.bid; u < 192; u += F.G) {
        const int ks = u / 12, cc = u - ks * 12, j = cc * 512 + F.tid;
        __syncthreads();
        for (int i = F.tid; i < 1024; i += NTHREADS) { const int b = i >> 6, kk = i & 63; const float v = c[b * 1024 + ks * 64 + kk]; sl[i] = v / (1.0f + __expf(-v)); }
        __syncthreads();
        float acc[16];
#pragma unroll
        for (int b = 0; b < 16; ++b) acc[b] = 0.f;
#pragma unroll 16
        for (int kk = 0; kk < 64; ++kk) { const float w = ada_w[(size_t)(ks * 64 + kk) * 6144 + j];
#pragma unroll
            for (int b = 0; b < 16; ++b) acc[b] += sl[b * 64 + kk] * w; }
#pragma unroll
        for (int b = 0; b < 16; ++b) modp[(size_t)(ks * 16 + b) * 6144 + j] = acc[b];
    }
}

__device__ __forceinline__ void p0_cpe(Frame& F) {
    float* cpe = (float*)(F.ws + WS_CPE);
    LAS float* red = (LAS float*)F.lds;
    for (int u = F.bid - 192; u >= 0 && u < 64; u += F.G) {
        const int kv = u >> 5, e0 = (u & 31) * 4, eo = F.tid & 3, kk = F.tid >> 2;
        const float* pe = F.in[kv ? 10 : 7]; const float* w1 = F.in[kv ? 11 : 8];
        float s = 0.f;
#pragma unroll
        for (int m = 0; m < 16; ++m) { const int k = kk + 128 * m; s += pe[k] * w1[(size_t)k * 128 + e0 + eo]; }
        __syncthreads();
        red[F.tid] = s;
        __syncthreads();
        if (F.tid < 4) { float t = 0.f; for (int i = 0; i < 128; ++i) t += red[i * 4 + F.tid]; cpe[kv * 128 + e0 + F.tid] = t; }
    }
}

__device__ __forceinline__ void p1_prologue(Frame& F) {
    const float* modp = (const float*)(F.ws + WS_MODP);
    float* mod = (float*)(F.ws + WS_MOD);
    const int gtid = F.bid * NTHREADS + F.tid, gsz = F.G * NTHREADS;
    for (int i = gtid; i < 16 * 6144; i += gsz) { float s = F.in[3][i % 6144];
        for (int ks = 0; ks < 16; ++ks) s += modp[(size_t)ks * 16 * 6144 + i];
        mod[i] = s; }
    { float* bin = (float*)(F.ws + WS_BIN);
      for (int i = gtid; i < NPROJ; i += gsz) { const int sc = map_in(i); bin[i] = sc >= 0 ? F.in[6][sc] : 0.f; } }
    { bf16* rwt = (bf16*)(F.ws + WS_RWT);
      for (int i = gtid; i < 32 * 1024; i += gsz) { const int e = i >> 10, d = i & 1023; const float wv = F.in[24][d * 32 + e]; const unsigned hi = f2bf(wv);
          rwt[i] = (bf16)hi; rwt[32 * 1024 + i] = (bf16)f2bf(wv - __builtin_bit_cast(float, hi << 16)); } }
    {
        const float* x = F.in[0]; const float* g1 = F.in[4]; bf16* xn = (bf16*)(F.ws + WS_XN);
        LAS float* sm = (LAS float*)F.lds;
        for (int rb = F.bid; rb < T / 128; rb += F.G) {
            const int b = rb >> 4;
            __syncthreads();
            for (int i = F.tid; i < 2048; i += NTHREADS) { float s = F.in[3][i];
                for (int ks = 0; ks < 16; ++ks) s += modp[(size_t)(ks * 16 + b) * 6144 + i];
                sm[i] = s; }
            __syncthreads();
            for (int r = 0; r < 16; ++r) {
                const int row = rb * 128 + F.wave * 16 + r;
                const f32x4* xr = (const f32x4*)(x + (size_t)row * D) + F.lane;
                f32x4 v[4]; float ss = 0.f;
#pragma unroll
                for (int j = 0; j < 4; ++j) { v[j] = xr[64 * j]; ss += v[j].x * v[j].x + v[j].y * v[j].y + v[j].z * v[j].z + v[j].w * v[j].w; }
                const float rs = rsqrtf(wave_sum(ss) * (1.0f / D) + 1e-5f);
                unsigned* o4 = (unsigned*)(F.ws + WS_OY + (size_t)row * D) + F.lane; u32x2* o8 = (u32x2*)(xn + (size_t)row * D) + F.lane;
#pragma unroll
                for (int j = 0; j < 4; ++j) { const int d0 = (64 * j + F.lane) * 4; const f32x4 gg = *(const f32x4*)(g1 + d0);
                    float y[4];
#pragma unroll
                    for (int i = 0; i < 4; ++i) y[i] = v[j][i] * rs * gg[i] * (1.0f + sm[1024 + d0 + i]) + sm[d0 + i];
                    o4[64 * j] = pk4_fp8(y[0], y[1], y[2], y[3]); u32x2 w; w.x = pk2(y[0], y[1]); w.y = pk2(y[2], y[3]); o8[64 * j] = w; }
            }
        }
    }
    __syncthreads();
    {
        LAS float* scr = (LAS float*)(F.lds + F.wave * 16384);
        const int gw = F.bid * NWAVES + F.wave, NGW = F.G * NWAVES;
        constexpr int I_IN = 16 * 144, I_PA = 8 * 32, I_WO = 16 * 32, I_UP1 = 16 * 64, I_DN1 = 16 * 32;
        constexpr int I_C1 = 32 * 4, I_C2 = 2 * 2, I_ML = 2 * 4;
        constexpr int NITEMS = I_IN + 2 * I_PA + I_WO + 2 * I_C1 + 2 * I_C2 + 12 * I_ML;
        for (int it = gw; it < NITEMS; it += NGW) {
            int r = it;
            if (r < I_IN) { const int nb = r % 144;
                if (nb < 16) transpose_item<1>(F.in[5], IN_W, 1024, (bf16*)(F.ws + WS_WIN), 144, r, scr, F.lane);
                else transpose_item8<1>(F.in[5], IN_W, 1024, (unsigned char*)(F.ws + WS_WIN + 4 * MiB) - (size_t)512 * 1024, 144, r, scr, F.lane);
                continue; } r -= I_IN;
            if (r < I_PA) { transpose_item<0>(F.in[20], 1024, 512, (bf16*)(F.ws + WS_WPA), 32, r, scr, F.lane, 1024); continue; } r -= I_PA;
            if (r < I_PA) { transpose_item<0>(F.in[21], 1024, 512, (bf16*)(F.ws + WS_WPA) + 512, 32, r, scr, F.lane, 1024); continue; } r -= I_PA;
            if (r < I_WO) { transpose_item8<0>(F.in[22], 1024, 1024, (unsigned char*)(F.ws + WS_WOUT), 32, r, scr, F.lane); continue; } r -= I_WO;
            if (r < 2 * I_C1) { const int kv = r / I_C1; transpose_item<0>(F.in[kv ? 11 : 8], 128, 2048, (bf16*)(F.ws + WS_W1T) + (size_t)kv * 128 * 2048, 4, r - kv * I_C1, scr, F.lane); continue; } r -= 2 * I_C1;
            if (r < 2 * I_C2) { const int kv = r / I_C2; transpose_item<0>(F.in[kv ? 12 : 9], 64, 128, (bf16*)(F.ws + WS_W2T) + (size_t)kv * 64 * 128, 2, r - kv * I_C2, scr, F.lane); continue; } r -= 2 * I_C2;
            { const int mh = r / I_ML, mat = mh >> 2; transpose_item<0>(F.in[15 + mat] + (size_t)(mh & 3) * 16384, 128, 128, (bf16*)(F.ws + WS_WQT) + (size_t)mh * 16384, 4, r - mh * I_ML, scr, F.lane); }
        }
    }
}

struct AttnState { float q[64]; float o[64]; float m, l; };
__device__ __forceinline__ void attn_init(AttnState& st, const bf16* qp) {
#pragma unroll
    for (int i = 0; i < 8; ++i) { const u32x4 w = *(const u32x4*)(qp + 8 * i);
        st.q[8 * i + 0] = bflo(w.x) * 0.125f; st.q[8 * i + 1] = bfhi(w.x) * 0.125f; st.q[8 * i + 2] = bflo(w.y) * 0.125f; st.q[8 * i + 3] = bfhi(w.y) * 0.125f;
        st.q[8 * i + 4] = bflo(w.z) * 0.125f; st.q[8 * i + 5] = bfhi(w.z) * 0.125f; st.q[8 * i + 6] = bflo(w.w) * 0.125f; st.q[8 * i + 7] = bfhi(w.w) * 0.125f; }
#pragma unroll
    for (int d = 0; d < 64; ++d) st.o[d] = 0.f;
    st.m = -1e30f; st.l = 0.f;
}
__device__ __forceinline__ float dot_bf16row(const float (&q)[64], const bf16* kp) {
    float s0 = 0.f, s1 = 0.f;
#pragma unroll
    for (int i = 0; i < 8; ++i) { const u32x4 w = *(const u32x4*)(kp + 8 * i);
        s0 += q[8 * i + 0] * bflo(w.x); s1 += q[8 * i + 1] * bfhi(w.x); s0 += q[8 * i + 2] * bflo(w.y); s1 += q[8 * i + 3] * bfhi(w.y);
        s0 += q[8 * i + 4] * bflo(w.z); s1 += q[8 * i + 5] * bfhi(w.z); s0 += q[8 * i + 6] * bflo(w.w); s1 += q[8 * i + 7] * bfhi(w.w); }
    return s0 + s1;
}
__device__ __forceinline__ void attn_key_bf16(AttnState& st, float sc, bool valid, const bf16* vp) {
    const bool need = valid && (sc > st.m + 8.0f);
    if (__any(need)) { if (need) { const float a = __expf(st.m - sc); st.l *= a;
#pragma unroll
            for (int d = 0; d < 64; ++d) st.o[d] *= a;
            st.m = sc; } }
    const float p = valid ? __expf(sc - st.m) : 0.f;
    st.l += p;
#pragma unroll
    for (int i = 0; i < 8; ++i) { const u32x4 w = *(const u32x4*)(vp + 8 * i);
        st.o[8 * i + 0] += p * bflo(w.x); st.o[8 * i + 1] += p * bfhi(w.x); st.o[8 * i + 2] += p * bflo(w.y); st.o[8 * i + 3] += p * bfhi(w.y);
        st.o[8 * i + 4] += p * bflo(w.z); st.o[8 * i + 5] += p * bfhi(w.z); st.o[8 * i + 6] += p * bflo(w.w); st.o[8 * i + 7] += p * bfhi(w.w); }
}

__device__ __forceinline__ float gelu_tanh(float x) { const float u = 0.7978845608f * (x + 0.044715f * x * x * x); const float t = 1.0f - 2.0f / (__expf(2.0f * u) + 1.0f); return 0.5f * x * (1.0f + t); }

__device__ __forceinline__ void p3_compress(Frame& F) {
    const bf16* proj = (const bf16*)(F.ws + WS_PROJ); const bf16* w1t = (const bf16*)(F.ws + WS_W1T); const bf16* w2t = (const bf16*)(F.ws + WS_W2T);
    const float* cpe = (const float*)(F.ws + WS_CPE); bf16* kcb = (bf16*)(F.ws + WS_KCB);
    const int lane = F.lane, w = F.wave, c = lane & 15, g4 = lane >> 4, nt2 = w >> 2, sl = w & 3;
    LAS f32x4* part = (LAS f32x4*)F.lds;
    for (int bu = F.bid; bu < 256; bu += F.G) {
        const int wu = bu * 2 + nt2;
        const int kv = wu >> 8, b = (wu >> 4) & 15, g = (wu >> 3) & 1, n0 = (wu & 7) * 16;
        const int n = n0 + c, nn = n > 126 ? 126 : n;
        const bf16* xb = proj + (size_t)(b * S + 16 * nn) * PP + (kv ? C_VCMP : C_KCMP) + g * 64 + 8 * g4;
        const bf16* wb = w1t + (size_t)kv * 128 * 2048 + (size_t)c * 2048 + 8 * g4;
        f32x4 acc[8];
#pragma unroll
        for (int et = 0; et < 8; ++et) acc[et] = (f32x4){0.f, 0.f, 0.f, 0.f};
#pragma unroll 2
        for (int k2 = 0; k2 < 16; ++k2) { const int ks = 16 * sl + k2;
            const bf16x8 xf = *(const bf16x8*)(xb + (size_t)(ks >> 1) * PP + 32 * (ks & 1));
#pragma unroll
            for (int et = 0; et < 8; ++et) { const bf16x8 wf = *(const bf16x8*)(wb + (size_t)et * 16 * 2048 + 32 * ks); acc[et] = __builtin_amdgcn_mfma_f32_16x16x32_bf16(wf, xf, acc[et], 0, 0, 0); }
        }
        __syncthreads();
        if (sl != 0) {
#pragma unroll
            for (int et = 0; et < 8; ++et) part[((nt2 * 3 + (sl - 1)) * 8 + et) * 64 + lane] = acc[et]; }
        __syncthreads();
        if (sl == 0) {
#pragma unroll
            for (int et = 0; et < 8; ++et) { const f32x4 cp = *(const f32x4*)(cpe + kv * 128 + 16 * et + 4 * g4);
                const f32x4 s = acc[et] + part[((nt2 * 3 + 0) * 8 + et) * 64 + lane] + part[((nt2 * 3 + 1) * 8 + et) * 64 + lane] + part[((nt2 * 3 + 2) * 8 + et) * 64 + lane];
#pragma unroll
                for (int i = 0; i < 4; ++i) acc[et][i] = gelu_tanh(s[i] + cp[i]); }
            f32x4 o2[4];
#pragma unroll
            for (int dt = 0; dt < 4; ++dt) o2[dt] = (f32x4){0.f, 0.f, 0.f, 0.f};
#pragma unroll
            for (int ss = 0; ss < 4; ++ss) {
                u32x4 hw; hw.x = pk2(acc[2 * ss][0], acc[2 * ss][1]); hw.y = pk2(acc[2 * ss][2], acc[2 * ss][3]); hw.z = pk2(acc[2 * ss + 1][0], acc[2 * ss + 1][1]); hw.w = pk2(acc[2 * ss + 1][2], acc[2 * ss + 1][3]);
                const bf16x8 hf = __builtin_bit_cast(bf16x8, hw);
#pragma unroll
                for (int dt = 0; dt < 4; ++dt) { const bf16* wp = w2t + (size_t)kv * 64 * 128 + (size_t)(16 * dt + c) * 128 + 32 * ss + 4 * g4;
                    const u32x2 lo = *(const u32x2*)wp, hi = *(const u32x2*)(wp + 16);
                    const u32x4 ww = (u32x4){lo.x, lo.y, hi.x, hi.y};
                    o2[dt] = __builtin_amdgcn_mfma_f32_16x16x32_bf16(__builtin_bit_cast(bf16x8, ww), hf, o2[dt], 0, 0, 0); }
            }
            bf16* op = kcb + ((((size_t)kv * 16 + b) * 2 + g) * 128 + n) * 64 + 4 * g4;
#pragma unroll
            for (int dt = 0; dt < 4; ++dt) { u32x2 w2; w2.x = pk2(o2[dt][0], o2[dt][1]); w2.y = pk2(o2[dt][2], o2[dt][3]); if (n > 126) { w2.x = 0u; w2.y = 0u; } *(u32x2*)(op + 16 * dt) = w2; }
        }
    }
}

__device__ __forceinline__ void p4_cmpsel(Frame& F) {
    constexpr float LOG2E = 1.4426950408889634f;
    const bf16* proj = (const bf16*)(F.ws + WS_PROJ); const float* small = (const float*)(F.ws + WS_SMALL); float* oacc = (float*)(F.ws + WS_OACC);
    const bf16* kcb = (const bf16*)(F.ws + WS_KCB); const bf16* vcb = kcb + (size_t)16 * 2 * 128 * 64;
    unsigned* selm = (unsigned*)(F.ws + WS_SELM);
    LAS unsigned char* L = F.lds;
    LAS float* scA = (LAS float*)(F.lds + 32768); LAS float* scB = (LAS float*)(F.lds + 40960);
    const int lane = F.lane, w = F.wave, c = lane & 15, g4 = lane >> 4;
    const int pr = 8 * ((c >> 2) & 1) + 4 * (c >> 3) + (c & 3), k7 = pr & 7;
    int kof[2]; kof[0] = pr * 128 + (((0 + g4) ^ k7) << 4); kof[1] = pr * 128 + (((4 + g4) ^ k7) << 4);
    const int q4 = c >> 2, p4 = c & 3, xr = 2 * (g4 & 1) + (g4 >> 1);
    const int vb = 1024 * (g4 & 1) + 64 * (4 * (g4 >> 1) + q4) + 8 * (p4 & 1);
    int vx[2]; vx[0] = 16 * ((0 + (p4 >> 1)) ^ xr); vx[1] = 16 * ((2 + (p4 >> 1)) ^ xr);
    const int kbl = 8 * (g4 & 1) + 4 * (g4 >> 1);
    const int skey = F.tid >> 3, sch = F.tid & 7;
    const int kst = skey * 128 + ((sch ^ (skey & 7)) << 4);
    const int vst = 16384 + 1024 * (skey >> 3) + 512 * (sch >> 2) + 64 * (skey & 7) + 16 * ((sch & 3) ^ ((skey >> 2) & 3));
    for (int unit = F.bid; unit < 1024; unit += F.G) {
        const int qb = 31 - (unit >> 5), b = (unit & 31) >> 1, g = unit & 1, t0 = qb * 64;
        const int ntile = qb >= 16 ? 2 : 1;
        __syncthreads();
        for (int tl = 0; tl < ntile; ++tl) { const bf16* sp = kcb + ((size_t)(b * 2 + g) * 128 + 64 * tl + skey) * 64 + sch * 8;
            *(LAS u32x4*)(L + tl * 8192 + kst) = *(const u32x4*)sp; *(LAS u32x4*)(L + tl * 8192 + vst) = *(const u32x4*)(sp + (vcb - kcb)); }
        __syncthreads();
        const int hq = 4 * g + (c & 3);
        const float slope2 = exp2f(-(float)(hq + 1)) * LOG2E;
#pragma unroll
        for (int nt = 0; nt < 2; ++nt) {
            const int tlq = 8 * w + 4 * nt + (c >> 2), tq = t0 + tlq;
            const bf16* qp = proj + (size_t)(b * S + tq) * PP + C_Q + hq * 64 + 8 * g4;
            bf16x8 qf[2];
#pragma unroll
            for (int ks = 0; ks < 2; ++ks) { const u32x4 v = *(const u32x4*)(qp + 32 * ks); u32x4 o;
                o.x = pk2(bflo(v.x) * 0.125f, bfhi(v.x) * 0.125f); o.y = pk2(bflo(v.y) * 0.125f, bfhi(v.y) * 0.125f); o.z = pk2(bflo(v.z) * 0.125f, bfhi(v.z) * 0.125f); o.w = pk2(bflo(v.w) * 0.125f, bfhi(v.w) * 0.125f);
                qf[ks] = __builtin_bit_cast(bf16x8, o); }
            float sc[2][4][4]; float tmax = -1e30f;
            const int nvalid = tq >= 31 ? ((tq - 31) >> 4) + 1 : 0;
#pragma unroll
            for (int tl = 0; tl < 2; ++tl) {
                if (tl < ntile) {
                    f32x4 sa[4];
#pragma unroll
                    for (int mt = 0; mt < 4; ++mt) sa[mt] = (f32x4){0.f, 0.f, 0.f, 0.f};
#pragma unroll
                    for (int ks = 0; ks < 2; ++ks)
#pragma unroll
                        for (int mt = 0; mt < 4; ++mt) { const bf16x8 kf = *(const LAS bf16x8*)(L + tl * 8192 + mt * 2048 + kof[ks]); sa[mt] = __builtin_amdgcn_mfma_f32_16x16x32_bf16(kf, qf[ks], sa[mt], 0, 0, 0); }
#pragma unroll
                    for (int mt = 0; mt < 4; ++mt)
#pragma unroll
                        for (int i = 0; i < 4; ++i) { const int n = 64 * tl + 16 * mt + kbl + i;
                            const float v = n < nvalid ? sa[mt][i] * LOG2E - slope2 * ((float)(tq - 16 * n) - 15.5f) : -1e30f; sc[tl][mt][i] = v; tmax = fmaxf(tmax, v); }
                } else {
#pragma unroll
                    for (int mt = 0; mt < 4; ++mt)
#pragma unroll
                        for (int i = 0; i < 4; ++i) sc[tl][mt][i] = -1e30f;
                }
            }
            tmax = fmaxf(tmax, __shfl_xor(tmax, 16)); tmax = fmaxf(tmax, __shfl_xor(tmax, 32));
            float ls = 0.f;
#pragma unroll
            for (int tl = 0; tl < 2; ++tl)
#pragma unroll
                for (int mt = 0; mt < 4; ++mt)
#pragma unroll
                    for (int i = 0; i < 4; ++i) { const float p = sc[tl][mt][i] > -1e29f ? __builtin_amdgcn_exp2f(sc[tl][mt][i] - tmax) : 0.f; sc[tl][mt][i] = p; ls += p; }
            ls += __shfl_xor(ls, 16); ls += __shfl_xor(ls, 32);
            const float inv = ls > 0.f ? 1.0f / ls : 0.f;
            f32x4 o[4];
#pragma unroll
            for (int dt = 0; dt < 4; ++dt) o[dt] = (f32x4){0.f, 0.f, 0.f, 0.f};
#pragma unroll
            for (int tl = 0; tl < 2; ++tl) {
                if (tl < ntile) {
#pragma unroll
                    for (int mt = 0; mt < 4; ++mt) {
#pragma unroll
                        for (int i = 0; i < 4; ++i) sc[tl][mt][i] *= inv;
                        float a = sc[tl][mt][0] + sc[tl][mt][1] + sc[tl][mt][2] + 0.5f * sc[tl][mt][3], bb = 0.5f * sc[tl][mt][3];
                        a += __shfl_xor(a, 1); a += __shfl_xor(a, 2); bb += __shfl_xor(bb, 1); bb += __shfl_xor(bb, 2);
                        if ((c & 3) == 0) { const int j = 16 * tl + 4 * mt + 2 * (g4 & 1) + (g4 >> 1); scA[tlq * 32 + j] = a; scB[tlq * 32 + j] = bb; }
                    }
#pragma unroll
                    for (int s = 0; s < 2; ++s) { u32x4 pw; pw.x = pk2(sc[tl][2 * s][0], sc[tl][2 * s][1]); pw.y = pk2(sc[tl][2 * s][2], sc[tl][2 * s][3]); pw.z = pk2(sc[tl][2 * s + 1][0], sc[tl][2 * s + 1][1]); pw.w = pk2(sc[tl][2 * s + 1][2], sc[tl][2 * s + 1][3]);
                        const bf16x8 pf = __builtin_bit_cast(bf16x8, pw);
#pragma unroll
                        for (int dt = 0; dt < 4; ++dt) { const LAS unsigned char* vp = L + 16384 + tl * 8192 + vb + 4096 * s + 512 * (dt >> 1) + vx[dt & 1];
                            const s16x4 lo = __builtin_bit_cast(s16x4, __builtin_amdgcn_ds_read_tr16_b64_v4i16((LAS s16x4*)vp));
                            const s16x4 hi = __builtin_bit_cast(s16x4, __builtin_amdgcn_ds_read_tr16_b64_v4i16((LAS s16x4*)(vp + 2048)));
                            const bf16x8 vf = (bf16x8){lo[0], lo[1], lo[2], lo[3], hi[0], hi[1], hi[2], hi[3]};
                            o[dt] = __builtin_amdgcn_mfma_f32_16x16x32_bf16(vf, pf, o[dt], 0, 0, 0); } }
                }
            }
            const size_t tok = (size_t)(b * S + tq);
            const float sg = sigmoidf_(small[tok * 32 + hq]);
#pragma unroll
            for (int dt = 0; dt < 4; ++dt) *(f32x4*)(oacc + tok * 512 + hq * 64 + 16 * dt + 4 * g4) = o[dt] * sg;
        }
        __syncthreads();
        if (F.tid < 64) { const int tlq = F.tid, t = t0 + tlq, cur = qb; unsigned mask;
            if (cur < 8) mask = (1u << (cur + 1)) - 1u;
            else { mask = 1u | (1u << cur);
                float sv[31];
#pragma unroll
                for (int j = 1; j < 31; ++j) sv[j] = j < cur ? scA[tlq * 32 + j] + scB[tlq * 32 + j - 1] : -1.0f;
#pragma unroll
                for (int it = 0; it < 6; ++it) { float best = -1.0f; int bj = 0;
#pragma unroll
                    for (int j = 1; j < 31; ++j) { const bool ok = sv[j] > best; best = ok ? sv[j] : best; bj = ok ? j : bj; }
                    mask |= 1u << bj;
#pragma unroll
                    for (int j = 1; j < 31; ++j) sv[j] = (j == bj) ? -1.0f : sv[j]; }
                mask &= ~1u; mask |= 1u; }
            selm[(size_t)(b * 2 + g) * S + t] = mask; }
    }
}

struct AttnW { f32x4 o[2][4]; float m[2], l[2]; };
template <int PHASE>
__device__ __forceinline__ void attn_tile(const bool EDGE, AttnW& st, const LAS unsigned char* Kb, const LAS unsigned char* Vb, const LAS bf16x8* qfl, const int (&kof)[2], int vb, const int (&vx)[2],
                                          int kt, int kbl, int t0, const int (&tq)[2], const unsigned (&smask)[2], float slope2) {
    f32x4 bias[4];
    { const float tbs = slope2 * (float)(64 * kt + kbl - t0 - 63);
#pragma unroll
      for (int mt = 0; mt < 4; ++mt)
#pragma unroll
          for (int i = 0; i < 4; ++i) bias[mt][i] = __builtin_fmaf(slope2, (float)(16 * mt + i), tbs); }
#pragma unroll
    for (int nt = 0; nt < 2; ++nt) {
        const bool selb = PHASE == 0 ? true : ((smask[nt] >> kt) & 1u);
        if (PHASE == 1 && !__any(selb)) continue;
        f32x4 sa[4];
#pragma unroll
        for (int mt = 0; mt < 4; ++mt) sa[mt] = bias[mt];
#pragma unroll
        for (int ks = 0; ks < 2; ++ks)
#pragma unroll
            for (int mt = 0; mt < 4; ++mt) { const bf16x8 kf = *(const LAS bf16x8*)(Kb + mt * 2048 + kof[ks]); sa[mt] = __builtin_amdgcn_mfma_f32_16x16x32_bf16(kf, qfl[(nt * 2 + ks) * 64], sa[mt], 0, 0, 0); }
        if (EDGE) { const int dbase = tq[nt] - 64 * kt - kbl;
#pragma unroll
            for (int mt = 0; mt < 4; ++mt)
#pragma unroll
                for (int i = 0; i < 4; ++i) { const int dist = dbase - (16 * mt + i); const bool valid = PHASE == 0 ? (dist >= 0 && dist < 256) : (dist >= 0); sa[mt][i] = valid ? sa[mt][i] : -1e30f; } }
        float tmax = fmaxf(fmaxf(sa[0][0], sa[0][1]), sa[0][2]);
#pragma unroll
        for (int mt = 0; mt < 4; ++mt) { if (mt > 0) tmax = fmaxf(fmaxf(tmax, sa[mt][0]), sa[mt][1]), tmax = fmaxf(tmax, sa[mt][2]); tmax = fmaxf(tmax, sa[mt][3]); }
        if (PHASE == 1) tmax = selb ? tmax : -1e30f;
        tmax = fmaxf(tmax, __shfl_xor(tmax, 16)); tmax = fmaxf(tmax, __shfl_xor(tmax, 32));
        float mn = st.m[nt];
        if (__any(tmax > mn)) { mn = fmaxf(mn, tmax); const float alpha = __builtin_amdgcn_exp2f(st.m[nt] - mn); st.m[nt] = mn; st.l[nt] *= alpha;
#pragma unroll
            for (int dt = 0; dt < 4; ++dt) st.o[nt][dt] *= alpha; }
        if (PHASE == 1) mn = selb ? mn : 3.0e38f;
        float ls = 0.f;
#pragma unroll
        for (int mt = 0; mt < 4; ++mt)
#pragma unroll
            for (int i = 0; i < 4; ++i) { const float p = __builtin_amdgcn_exp2f(sa[mt][i] - mn); sa[mt][i] = p; ls += p; }
        st.l[nt] += ls;
        bf16x8 pf[2];
#pragma unroll
        for (int s = 0; s < 2; ++s) { u32x4 w; w.x = pk2(sa[2 * s][0], sa[2 * s][1]); w.y = pk2(sa[2 * s][2], sa[2 * s][3]); w.z = pk2(sa[2 * s + 1][0], sa[2 * s + 1][1]); w.w = pk2(sa[2 * s + 1][2], sa[2 * s + 1][3]);
            pf[s] = __builtin_bit_cast(bf16x8, w); }
#pragma unroll
        for (int dt = 0; dt < 4; ++dt)
#pragma unroll
            for (int s = 0; s < 2; ++s) { const LAS unsigned char* vp = Vb + vb + 4096 * s + 512 * (dt >> 1) + vx[dt & 1];
                const s16x4 lo = __builtin_bit_cast(s16x4, __builtin_amdgcn_ds_read_tr16_b64_v4i16((LAS s16x4*)vp));
                const s16x4 hi = __builtin_bit_cast(s16x4, __builtin_amdgcn_ds_read_tr16_b64_v4i16((LAS s16x4*)(vp + 2048)));
                const bf16x8 vf = (bf16x8){lo[0], lo[1], lo[2], lo[3], hi[0], hi[1], hi[2], hi[3]};
                st.o[nt][dt] = __builtin_amdgcn_mfma_f32_16x16x32_bf16(vf, pf[s], st.o[nt][dt], 0, 0, 0); }
    }
}

__device__ __forceinline__ void p5_attn(Frame& F, int qslot) {
    constexpr float LOG2E = 1.4426950408889634f, QS = 0.125f * LOG2E;
    const bf16* proj = (const bf16*)(F.ws + WS_PROJ); const float* small = (const float*)(F.ws + WS_SMALL);
    const bf16* kcb = (const bf16*)(F.ws + WS_KCB); const bf16* vcb = kcb + (size_t)16 * 2 * 128 * 64;
    bf16* onsa = (bf16*)(F.ws + WS_OY);
    unsigned* qctr = (unsigned*)(F.ws + WS_CTL) + 8 + qslot;
    LAS unsigned char* L = F.lds;
    volatile LAS unsigned* sched = (volatile LAS unsigned*)(F.lds + 32768);
    LAS unsigned* sml = (LAS unsigned*)(F.lds + 32768 + 256);
    LAS float* scA = (LAS float*)(F.lds + 40960); LAS float* scB = (LAS float*)(F.lds + 49152);
    const int w = F.wave;
    for (;;) {
        __syncthreads();
        if (F.tid == 0) sched[0] = atomicAdd(qctr, 1u);
        __syncthreads();
        const int qi = (int)__builtin_amdgcn_readfirstlane(sched[0]);
        if (qi >= 1792) break;
        const int qa = qi / 14, qr = qi - 14 * qa;
        const int cslot = qr == 0 ? 0 : qr == 2 ? 1 : qr == 4 ? 2 : qr == 7 ? 3 : qr == 9 ? 4 : qr == 11 ? 5 : -1;
        if (cslot >= 0) {
            const int chunk = 6 * qa + cslot;
            LAS float* scr = (LAS float*)(F.lds + 40960 + w * 8448);
            for (int j = 0; j < 8; ++j) { const int it = chunk * 64 + w * 8 + j;
                if (it < 32 * 1024) { const int e = it >> 10; transpose_item8<2>(F.in[26] + (size_t)e * 1024 * 2048, 2048, 1024, (unsigned char*)(F.ws + WS_WUP) + (size_t)e * 2048 * 1024, 64, it & 1023, scr, F.lane); }
                else { const int r2 = it - 32 * 1024, e = r2 >> 9; transpose_item8<0>(F.in[28] + (size_t)e * 1024 * 1024, 1024, 1024, (unsigned char*)(F.ws + WS_WDN) + (size_t)e * 1024 * 1024, 32, r2 & 511, scr, F.lane); } }
            continue;
        }
        const int unit = 8 * qa + (qr - 1 - (qr > 2 ? 1 : 0) - (qr > 4 ? 1 : 0) - (qr > 7 ? 1 : 0) - (qr > 9 ? 1 : 0) - (qr > 11 ? 1 : 0));
        const int lane = opaque_i(F.lane), c = lane & 15, g4 = lane >> 4;
        const int pr = 8 * ((c >> 2) & 1) + 4 * (c >> 3) + (c & 3), k7 = pr & 7;
        int kof[2]; kof[0] = pr * 128 + (((0 + g4) ^ k7) << 4); kof[1] = pr * 128 + (((4 + g4) ^ k7) << 4);
        const int q4 = c >> 2, p4 = c & 3, xr = 2 * (g4 & 1) + (g4 >> 1);
        const int vb = 1024 * (g4 & 1) + 64 * (4 * (g4 >> 1) + q4) + 8 * (p4 & 1);
        int vx[2]; vx[0] = 16 * ((0 + (p4 >> 1)) ^ xr); vx[1] = 16 * ((2 + (p4 >> 1)) ^ xr);
        const int kbl = 8 * (g4 & 1) + 4 * (g4 >> 1);
        const int tid_ = opaque_i(F.tid), skey = tid_ >> 3, sch = tid_ & 7;
        const int kst = skey * 128 + ((sch ^ (skey & 7)) << 4);
        const int vst = 16384 + 1024 * (skey >> 3) + 512 * (sch >> 2) + 64 * (skey & 7) + 16 * ((sch & 3) ^ ((skey >> 2) & 3));
        const int qb = 31 - (unit >> 5), b = (unit & 31) >> 1, g = unit & 1, t0 = qb * 64;
        const int ntile = qb >= 16 ? 2 : 1;
        for (int tl = 0; tl < ntile; ++tl) { const bf16* sp = kcb + ((size_t)(b * 2 + g) * 128 + 64 * tl + skey) * 64 + sch * 8;
            *(LAS u32x4*)(L + tl * 8192 + kst) = *(const u32x4*)sp; *(LAS u32x4*)(L + tl * 8192 + vst) = *(const u32x4*)(sp + (vcb - kcb)); }
        int tq[2]; unsigned smask[2]; LAS bf16x8* qfl = (LAS bf16x8*)(F.lds + 106496 + w * 4096) + lane;
        const int hq = 4 * g + (c & 3);
        const float slope2 = exp2f(-(float)(hq + 1)) * LOG2E;
#pragma unroll
        for (int nt = 0; nt < 2; ++nt) { const int tl = 8 * w + 4 * nt + (c >> 2); tq[nt] = t0 + tl;
            const bf16* qp = proj + (size_t)(b * S + tq[nt]) * PP + C_Q + hq * 64 + 8 * g4;
#pragma unroll
            for (int ks = 0; ks < 2; ++ks) { const u32x4 v = *(const u32x4*)(qp + 32 * ks); u32x4 o;
                o.x = pk2(bflo(v.x) * QS, bfhi(v.x) * QS); o.y = pk2(bflo(v.y) * QS, bfhi(v.y) * QS); o.z = pk2(bflo(v.z) * QS, bfhi(v.z) * QS); o.w = pk2(bflo(v.w) * QS, bfhi(v.w) * QS);
                qfl[(nt * 2 + ks) * 64] = __builtin_bit_cast(bf16x8, o); } }
        const bf16* rowb = proj + (size_t)(b * S + skey) * PP + g * 64 + sch * 8;
        u32x4 rk, rv;
        { const bf16* sp = rowb + (size_t)(64 * qb) * PP + C_KWIN; rk = *(const u32x4*)sp; rv = *(const u32x4*)(sp + 128); }
        __syncthreads();
        f32x4 ocm[2][4];
#pragma unroll
        for (int nt = 0; nt < 2; ++nt) {
            const int tlq = 8 * w + 4 * nt + (c >> 2);
            float sc[2][4][4]; float tmax = -1e30f;
            const int nvalid = tq[nt] >= 31 ? ((tq[nt] - 31) >> 4) + 1 : 0;
#pragma unroll
            for (int tl = 0; tl < 2; ++tl) {
                if (tl < ntile) {
                    f32x4 sa[4];
#pragma unroll
                    for (int mt = 0; mt < 4; ++mt) sa[mt] = (f32x4){0.f, 0.f, 0.f, 0.f};
#pragma unroll
                    for (int ks = 0; ks < 2; ++ks)
#pragma unroll
                        for (int mt = 0; mt < 4; ++mt) { const bf16x8 kf = *(const LAS bf16x8*)(L + tl * 8192 + mt * 2048 + kof[ks]); sa[mt] = __builtin_amdgcn_mfma_f32_16x16x32_bf16(kf, qfl[(nt * 2 + ks) * 64], sa[mt], 0, 0, 0); }
#pragma unroll
                    for (int mt = 0; mt < 4; ++mt)
#pragma unroll
                        for (int i = 0; i < 4; ++i) { const int n = 64 * tl + 16 * mt + kbl + i;
                            const float v = n < nvalid ? sa[mt][i] - slope2 * ((float)(tq[nt] - 16 * n) - 15.5f) : -1e30f; sc[tl][mt][i] = v; tmax = fmaxf(tmax, v); }
                } else {
#pragma unroll
                    for (int mt = 0; mt < 4; ++mt)
#pragma unroll
                        for (int i = 0; i < 4; ++i) sc[tl][mt][i] = -1e30f;
                }
            }
            tmax = fmaxf(tmax, __shfl_xor(tmax, 16)); tmax = fmaxf(tmax, __shfl_xor(tmax, 32));
            float ls = 0.f;
#pragma unroll
            for (int tl = 0; tl < 2; ++tl)
#pragma unroll
                for (int mt = 0; mt < 4; ++mt)
#pragma unroll
                    for (int i = 0; i < 4; ++i) { const float p = sc[tl][mt][i] > -1e29f ? __builtin_amdgcn_exp2f(sc[tl][mt][i] - tmax) : 0.f; sc[tl][mt][i] = p; ls += p; }
            ls += __shfl_xor(ls, 16); ls += __shfl_xor(ls, 32);
            const float inv = ls > 0.f ? 1.0f / ls : 0.f;
#pragma unroll
            for (int dt = 0; dt < 4; ++dt) ocm[nt][dt] = (f32x4){0.f, 0.f, 0.f, 0.f};
#pragma unroll
            for (int tl = 0; tl < 2; ++tl) {
                if (tl < ntile) {
#pragma unroll
                    for (int mt = 0; mt < 4; ++mt) {
#pragma unroll
                        for (int i = 0; i < 4; ++i) sc[tl][mt][i] *= inv;
                        float a = sc[tl][mt][0] + sc[tl][mt][1] + sc[tl][mt][2] + 0.5f * sc[tl][mt][3], bb = 0.5f * sc[tl][mt][3];
                        a += __shfl_xor(a, 1); a += __shfl_xor(a, 2); bb += __shfl_xor(bb, 1); bb += __shfl_xor(bb, 2);
                        if ((c & 3) == 0) { const int j = 16 * tl + 4 * mt + 2 * (g4 & 1) + (g4 >> 1); scA[tlq * 32 + j] = a; scB[tlq * 32 + j] = bb; }
                    }
#pragma unroll
                    for (int s = 0; s < 2; ++s) { u32x4 pw; pw.x = pk2(sc[tl][2 * s][0], sc[tl][2 * s][1]); pw.y = pk2(sc[tl][2 * s][2], sc[tl][2 * s][3]); pw.z = pk2(sc[tl][2 * s + 1][0], sc[tl][2 * s + 1][1]); pw.w = pk2(sc[tl][2 * s + 1][2], sc[tl][2 * s + 1][3]);
                        const bf16x8 pf = __builtin_bit_cast(bf16x8, pw);
#pragma unroll
                        for (int dt = 0; dt < 4; ++dt) { const LAS unsigned char* vp = L + 16384 + tl * 8192 + vb + 4096 * s + 512 * (dt >> 1) + vx[dt & 1];
                            const s16x4 lo = __builtin_bit_cast(s16x4, __builtin_amdgcn_ds_read_tr16_b64_v4i16((LAS s16x4*)vp));
                            const s16x4 hi = __builtin_bit_cast(s16x4, __builtin_amdgcn_ds_read_tr16_b64_v4i16((LAS s16x4*)(vp + 2048)));
                            const bf16x8 vf = (bf16x8){lo[0], lo[1], lo[2], lo[3], hi[0], hi[1], hi[2], hi[3]};
                            ocm[nt][dt] = __builtin_amdgcn_mfma_f32_16x16x32_bf16(vf, pf, ocm[nt][dt], 0, 0, 0); } }
                }
            }
            const float sg = sigmoidf_(small[(size_t)(b * S + tq[nt]) * 32 + hq]);
#pragma unroll
            for (int dt = 0; dt < 4; ++dt) ocm[nt][dt] *= sg;
        }
        __syncthreads();
        if (F.tid < 64) { const int tlq = F.tid, cur = qb; unsigned mask;
            if (cur < 8) mask = (1u << (cur + 1)) - 1u;
            else { mask = 1u | (1u << cur);
                float sv[31];
#pragma unroll
                for (int j = 1; j < 31; ++j) sv[j] = j < cur ? scA[tlq * 32 + j] + scB[tlq * 32 + j - 1] : -1.0f;
#pragma unroll
                for (int it = 0; it < 6; ++it) { float best = -1.0f; int bj = 0;
#pragma unroll
                    for (int j = 1; j < 31; ++j) { const bool ok = sv[j] > best; best = ok ? sv[j] : best; bj = ok ? j : bj; }
                    mask |= 1u << bj;
#pragma unroll
                    for (int j = 1; j < 31; ++j) sv[j] = (j == bj) ? -1.0f : sv[j]; }
                mask &= ~1u; mask |= 1u; }
            sml[tlq] = mask; }
        __syncthreads();
        const unsigned mreg = sml[lane];
        unsigned um = mreg;
#pragma unroll
        for (int o = 1; o < 64; o <<= 1) um |= (unsigned)__shfl_xor((int)um, o);
        um = (unsigned)__builtin_amdgcn_readfirstlane((int)um);
        AttnW st; LAS f32x4* owl = (LAS f32x4*)(F.lds + 40960 + w * 8192) + lane;
#pragma unroll
        for (int nt = 0; nt < 2; ++nt) { smask[nt] = sml[8 * w + 4 * nt + (c >> 2)]; st.m[nt] = -1e30f; st.l[nt] = 0.f;
#pragma unroll
            for (int dt = 0; dt < 4; ++dt) { owl[(nt * 4 + dt) * 64] = ocm[nt][dt]; st.o[nt][dt] = (f32x4){0.f, 0.f, 0.f, 0.f}; } }
        int phase = 0, kt = qb, wleft = qb + 1 < 5 ? qb + 1 : 5; unsigned rem = um;
        int buf = 0;
        while (phase != 2) {
            *(LAS u32x4*)(L + buf * 8192 + kst) = rk; *(LAS u32x4*)(L + buf * 8192 + vst) = rv;
            __syncthreads();
            int nphase = phase, nkt = kt;
            if (phase == 0) { --wleft; if (wleft > 0) nkt = kt - 1; else { nphase = 1; nkt = 31 - __builtin_clz(rem); rem &= ~(1u << nkt); } }
            else { if (rem) { nkt = 31 - __builtin_clz(rem); rem &= ~(1u << nkt); } else nphase = 2; }
            if (nphase != 2) { const bf16* sp = rowb + (size_t)(64 * nkt) * PP + (nphase == 0 ? C_KWIN : C_KSLC); rk = *(const u32x4*)sp; rv = *(const u32x4*)(sp + 128); }
            if (phase == 0) attn_tile<0>(kt == qb || kt == qb - 4, st, L + buf * 8192, L + 16384 + buf * 8192, qfl, kof, vb, vx, kt, kbl, t0, tq, smask, slope2);
            else            attn_tile<1>(kt == qb, st, L + buf * 8192, L + 16384 + buf * 8192, qfl, kof, vb, vx, kt, kbl, t0, tq, smask, slope2);
            if (nphase != phase) {
#pragma unroll
                for (int nt = 0; nt < 2; ++nt) {
                    float lt = st.l[nt]; lt += __shfl_xor(lt, 16); lt += __shfl_xor(lt, 32);
                    const size_t tok = (size_t)(b * S + tq[nt]);
                    if (phase == 0) { const float sg = sigmoidf_(small[tok * 32 + 16 + hq]) / lt;
#pragma unroll
                        for (int dt = 0; dt < 4; ++dt) { owl[(nt * 4 + dt) * 64] += st.o[nt][dt] * sg; st.o[nt][dt] = (f32x4){0.f, 0.f, 0.f, 0.f}; }
                        st.m[nt] = -1e30f; st.l[nt] = 0.f; }
                    else { const float sg = sigmoidf_(small[tok * 32 + 8 + hq]) / lt;
#pragma unroll
                        for (int dt = 0; dt < 4; ++dt) { const size_t oi = tok * 1024 + hq * 64 + 16 * dt + 4 * g4;
                            const f32x4 r = owl[(nt * 4 + dt) * 64] + st.o[nt][dt] * sg;
                            u32x2 o2; o2.x = pk2(r[0], r[1]); o2.y = pk2(r[2], r[3]); *(u32x2*)(onsa + oi) = o2; } }
                }
            }
            phase = nphase; kt = nkt; buf ^= 1;
        }
    }
}

__device__ __forceinline__ int sw256(int r, int col) { return r * 256 + ((((col >> 3) ^ (r & 15))) << 4) + (col & 7) * 2; }
__device__ __forceinline__ void ml_gates(Frame& F, const float* small, size_t tok0, int h, LAS float* Fa, LAS float* ia) {
    if (F.wave == 0) {
        const int l = F.lane; const float fb = F.in[18][h];
        const float f0 = small[(tok0 + 2 * l) * 32 + 28 + h] + fb, f1 = small[(tok0 + 2 * l + 1) * 32 + 28 + h] + fb;
        const float a = fminf(f0, 0.f) - log1pf(__expf(-fabsf(f0))), bq = fminf(f1, 0.f) - log1pf(__expf(-fabsf(f1)));
        float s = a + bq;
#pragma unroll
        for (int o = 1; o < 64; o <<= 1) { const float v = __shfl_up(s, o); if (l >= o) s += v; }
        const float pre = s - (a + bq);
        Fa[2 * l] = pre + a; Fa[2 * l + 1] = pre + a + bq;
        ia[2 * l] = small[(tok0 + 2 * l) * 32 + 24 + h]; ia[2 * l + 1] = small[(tok0 + 2 * l + 1) * 32 + 24 + h];
    }
}

__device__ __forceinline__ void p3_mlstate(Frame& F) {
    const bf16* proj = (const bf16*)(F.ws + WS_PROJ); const float* small = (const float*)(F.ws + WS_SMALL);
    bf16* qml = (bf16*)(F.ws + WS_QML); bf16* kml = (bf16*)(F.ws + WS_KML); bf16* vtg = (bf16*)(F.ws + WS_VML);
    const bf16* wqt = (const bf16*)(F.ws + WS_WQT); const bf16* wkt = wqt + 4 * 16384; const bf16* wvt = wqt + 8 * 16384;
    float* cloct = (float*)(F.ws + WS_CLOC); float* nloc = (float*)(F.ws + WS_NLOC); float* mloc = (float*)(F.ws + WS_MLOC); float* flast = (float*)(F.ws + WS_FLAST);
    const float* cw = F.in[13]; const float* cb = F.in[14];
    LAS unsigned char* L = F.lds;
    LAS float* Fa = (LAS float*)(F.lds + 131072); LAS float* ia = Fa + 128; LAS float* wa = ia + 128; LAS float* red = wa + 128;
    const int lane = F.lane, w = F.wave, c = lane & 15, g4 = lane >> 4;
    for (int u = F.bid; u < 1024; u += F.G) {
        const int b = u >> 6, h = (u >> 4) & 3, ch = u & 15, t0 = ch * 128;
        const size_t tok0 = (size_t)b * S + t0;
        __syncthreads();
        for (int it = F.tid; it < 2048; it += NTHREADS) { const int t = it >> 4, c8 = (it & 15) * 8, cc = h * 128 + c8;
            float a[8]; u32x4 xm3 = (u32x4){0u, 0u, 0u, 0u};
#pragma unroll
            for (int i = 0; i < 8; ++i) a[i] = cb[cc + i];
#pragma unroll
            for (int j = 0; j < 4; ++j) { const int tt = t0 + t - 3 + j;
                if (tt >= 0) { const u32x4 xv = *(const u32x4*)(proj + ((size_t)b * S + tt) * PP + C_XM + cc);
                    const f32x4 w0 = *(const f32x4*)(cw + j * 512 + cc), w1 = *(const f32x4*)(cw + j * 512 + cc + 4);
                    a[0] += w0.x * bflo(xv.x); a[1] += w0.y * bfhi(xv.x); a[2] += w0.z * bflo(xv.y); a[3] += w0.w * bfhi(xv.y);
                    a[4] += w1.x * bflo(xv.z); a[5] += w1.y * bfhi(xv.z); a[6] += w1.z * bflo(xv.w); a[7] += w1.w * bfhi(xv.w);
                    if (j == 3) xm3 = xv; } }
#pragma unroll
            for (int i = 0; i < 8; ++i) a[i] = a[i] * __builtin_amdgcn_rcpf(1.0f + __expf(-a[i]));
            u32x4 o; o.x = pk2(a[0], a[1]); o.y = pk2(a[2], a[3]); o.z = pk2(a[4], a[5]); o.w = pk2(a[6], a[7]);
            *(LAS u32x4*)(L + sw256(t, c8)) = xm3; *(LAS u32x4*)(L + 32768 + sw256(t, c8)) = o; }
        ml_gates(F, small, tok0, h, Fa, ia);
        if (F.wave == 0) { LDS_WAIT(); const float FL = Fa[127]; float m = fmaxf(FL - Fa[2 * lane] + ia[2 * lane], FL - Fa[2 * lane + 1] + ia[2 * lane + 1]);
#pragma unroll
            for (int o = 1; o < 64; o <<= 1) m = fmaxf(m, __shfl_xor(m, o));
            wa[2 * lane] = __expf(FL - Fa[2 * lane] + ia[2 * lane] - m); wa[2 * lane + 1] = __expf(FL - Fa[2 * lane + 1] + ia[2 * lane + 1] - m);
            if (lane == 0) { mloc[u] = m; flast[u] = FL; } }
        __syncthreads();
        {
            const size_t wo = (size_t)(h * 128 + 16 * w + c) * 128 + 8 * g4;
            const size_t ro0 = ((size_t)(b * 4 + h) * S + t0) * 128 + 16 * w + 4 * g4; const int e = 16 * w + 4 * g4;
            f32x4 acc[8];
#pragma unroll
            for (int tt = 0; tt < 8; ++tt) acc[tt] = (f32x4){0.f, 0.f, 0.f, 0.f};
#pragma unroll
            for (int ks = 0; ks < 4; ++ks) { const bf16x8 wf = *(const bf16x8*)(wqt + wo + 32 * ks);
#pragma unroll
                for (int tt = 0; tt < 8; ++tt) acc[tt] = __builtin_amdgcn_mfma_f32_16x16x32_bf16(wf, *(const LAS bf16x8*)(L + 32768 + sw256(16 * tt + c, 32 * ks + 8 * g4)), acc[tt], 0, 0, 0); }
#pragma unroll
            for (int tt = 0; tt < 8; ++tt) { u32x2 qv; qv.x = pk2(acc[tt][0], acc[tt][1]); qv.y = pk2(acc[tt][2], acc[tt][3]); *(u32x2*)(qml + ro0 + (size_t)(16 * tt + c) * 128) = qv; }
#pragma unroll
            for (int tt = 0; tt < 8; ++tt) acc[tt] = (f32x4){0.f, 0.f, 0.f, 0.f};
#pragma unroll
            for (int ks = 0; ks < 4; ++ks) { const bf16x8 wf = *(const bf16x8*)(wkt + wo + 32 * ks);
#pragma unroll
                for (int tt = 0; tt < 8; ++tt) acc[tt] = __builtin_amdgcn_mfma_f32_16x16x32_bf16(wf, *(const LAS bf16x8*)(L + 32768 + sw256(16 * tt + c, 32 * ks + 8 * g4)), acc[tt], 0, 0, 0); }
#pragma unroll
            for (int tt = 0; tt < 8; ++tt) { const int t = 16 * tt + c; const float wt = wa[t];
                const float k0 = acc[tt][0] * 0.08838834764831845f, k1 = acc[tt][1] * 0.08838834764831845f, k2 = acc[tt][2] * 0.08838834764831845f, k3 = acc[tt][3] * 0.08838834764831845f;
                u32x2 kv; kv.x = pk2(k0, k1); kv.y = pk2(k2, k3); *(u32x2*)(kml + ro0 + (size_t)t * 128) = kv;
                *(LAS bf16*)(L + 65536 + sw256(e + 0, t)) = (bf16)f2bf(k0 * wt); *(LAS bf16*)(L + 65536 + sw256(e + 1, t)) = (bf16)f2bf(k1 * wt);
                *(LAS bf16*)(L + 65536 + sw256(e + 2, t)) = (bf16)f2bf(k2 * wt); *(LAS bf16*)(L + 65536 + sw256(e + 3, t)) = (bf16)f2bf(k3 * wt); }
#pragma unroll
            for (int tt = 0; tt < 8; ++tt) acc[tt] = (f32x4){0.f, 0.f, 0.f, 0.f};
#pragma unroll
            for (int ks = 0; ks < 4; ++ks) { const bf16x8 wf = *(const bf16x8*)(wvt + wo + 32 * ks);
#pragma unroll
                for (int tt = 0; tt < 8; ++tt) acc[tt] = __builtin_amdgcn_mfma_f32_16x16x32_bf16(*(const LAS bf16x8*)(L + sw256(16 * tt + c, 32 * ks + 8 * g4)), wf, acc[tt], 0, 0, 0); }
#pragma unroll
            for (int tt = 0; tt < 8; ++tt) { u32x2 vv; vv.x = pk2(acc[tt][0], acc[tt][1]); vv.y = pk2(acc[tt][2], acc[tt][3]); *(LAS u32x2*)(L + 98304 + sw256(16 * w + c, 16 * tt + 4 * g4)) = vv; }
        }
        __syncthreads();
        {
            f32x4 ac[8];
#pragma unroll
            for (int et = 0; et < 8; ++et) ac[et] = (f32x4){0.f, 0.f, 0.f, 0.f};
#pragma unroll
            for (int ks = 0; ks < 4; ++ks) {
                const bf16x8 kf = *(const LAS bf16x8*)(L + 65536 + sw256(16 * w + c, 32 * ks + 8 * g4));
#pragma unroll
                for (int et = 0; et < 8; ++et) { const bf16x8 vf = *(const LAS bf16x8*)(L + 98304 + sw256(16 * et + c, 32 * ks + 8 * g4)); ac[et] = __builtin_amdgcn_mfma_f32_16x16x32_bf16(kf, vf, ac[et], 0, 0, 0); }
            }
#pragma unroll
            for (int et = 0; et < 8; ++et) *(f32x4*)(cloct + (size_t)u * 16384 + (size_t)(16 * et + c) * 128 + 16 * w + 4 * g4) = ac[et];
        }
        if (F.tid < 128) { float s = 0.f;
#pragma unroll
            for (int k = 0; k < 16; ++k) { const u32x4 v = *(const LAS u32x4*)(L + 65536 + F.tid * 256 + k * 16); s += (bflo(v.x) + bfhi(v.x)) + (bflo(v.y) + bfhi(v.y)) + (bflo(v.z) + bfhi(v.z)) + (bflo(v.w) + bfhi(v.w)); }
            nloc[u * 128 + F.tid] = s; }
#pragma unroll
        for (int j = 0; j < 4; ++j) { const int id = F.tid + NTHREADS * j, e = id >> 4, ci = id & 15;
            *(u32x4*)(vtg + (size_t)u * 16384 + e * 128 + ci * 8) = *(const LAS u32x4*)(L + 98304 + e * 256 + ((ci ^ (e & 15)) << 4)); }
    }
}

__device__ __forceinline__ void p4_mlscan(Frame& F) {
    const float* cloct = (const float*)(F.ws + WS_CLOC); const float* nloc = (const float*)(F.ws + WS_NLOC); const float* mloc = (const float*)(F.ws + WS_MLOC); const float* flast = (const float*)(F.ws + WS_FLAST);
    bf16* cint = (bf16*)(F.ws + WS_CIN); float* nin = (float*)(F.ws + WS_NIN); float* min_ = (float*)(F.ws + WS_MIN);
    const int gtid = F.bid * NTHREADS + F.tid, gsz = F.G * NTHREADS;
    for (int idx = gtid; idx < 64 * (8192 + 64); idx += gsz) {
        const int bh = idx / (8192 + 64), de = (idx - bh * (8192 + 64)) * 2;
        float C0 = 0.f, C1 = 0.f, m = 0.f;
        for (int cch = 0; cch < 16; ++cch) { const int u = bh * 16 + cch;
            f32x2 loc;
            if (de < 16384) { *(unsigned*)(cint + (size_t)u * 16384 + de) = pk2(C0, C1); loc = *(const f32x2*)(cloct + (size_t)u * 16384 + de); if (de == 0) min_[u] = m; }
            else { *(f32x2*)(nin + u * 128 + (de - 16384)) = (f32x2){C0, C1}; loc = *(const f32x2*)(nloc + u * 128 + (de - 16384)); }
            const float FL = flast[u], ml = mloc[u], mn = fmaxf(FL + m, ml), dA = __expf(FL + m - mn), dB = __expf(ml - mn);
            C0 = dA * C0 + dB * loc.x; C1 = dA * C1 + dB * loc.y; m = mn; }
    }
}

__device__ __forceinline__ void p5_mlout(Frame& F) {
    const bf16* proj = (const bf16*)(F.ws + WS_PROJ); const float* small = (const float*)(F.ws + WS_SMALL);
    const bf16* qml = (const bf16*)(F.ws + WS_QML); const bf16* kml = (const bf16*)(F.ws + WS_KML); const bf16* vtg = (const bf16*)(F.ws + WS_VML);
    const bf16* cint = (const bf16*)(F.ws + WS_CIN); const float* nin = (const float*)(F.ws + WS_NIN); const float* min_ = (const float*)(F.ws + WS_MIN);
    bf16* yml = (bf16*)(F.ws + WS_OY) + 512;
    LAS unsigned char* L = F.lds;
    LAS float* Fa = (LAS float*)(F.lds + 98304); LAS float* ia = Fa + 128; LAS float* pm = ia + 128;
    const int lane = F.lane, w = F.wave, c = lane & 15, g4 = lane >> 4;
    for (int u = F.bid; u < 1024; u += F.G) {
        const int b = u >> 6, h = (u >> 4) & 3, ch = u & 15, t0 = ch * 128;
        const size_t tok0 = (size_t)b * S + t0; const size_t bhrow = ((size_t)(b * 4 + h) * S + t0);
        __syncthreads();
#pragma unroll
        for (int j = 0; j < 4; ++j) { const int id = F.tid + NTHREADS * j, r = id >> 4, ci = id & 15;
            *(LAS u32x4*)(L + r * 256 + ((ci ^ (r & 15)) << 4)) = *(const u32x4*)(kml + (bhrow + r) * 128 + ci * 8);
            *(LAS u32x4*)(L + 32768 + r * 256 + ((ci ^ (r & 15)) << 4)) = *(const u32x4*)(vtg + (size_t)u * 16384 + r * 128 + ci * 8);
            *(LAS u32x4*)(L + 65536 + r * 256 + ((ci ^ (r & 15)) << 4)) = *(const u32x4*)(cint + (size_t)u * 16384 + r * 128 + ci * 8); }
        ml_gates(F, small, tok0, h, Fa, ia);
        __syncthreads();
        if (F.wave == 0) {
            const float g0 = ia[2 * lane] - Fa[2 * lane], g1 = ia[2 * lane + 1] - Fa[2 * lane + 1];
            float s = fmaxf(g0, g1);
#pragma unroll
            for (int o = 1; o < 64; o <<= 1) { const float v = __shfl_up(s, o); if (lane >= o) s = fmaxf(s, v); }
            const float prev = __shfl_up(s, 1);
            pm[2 * lane] = lane > 0 ? fmaxf(prev, g0) : g0; pm[2 * lane + 1] = s;
            ia[2 * lane] = g0; ia[2 * lane + 1] = g1; }
        __syncthreads();
        const int t = 16 * w + c;
        const float mm = min_[u], mref = fmaxf(mm, pm[t]), wi = __expf(mm - mref);
        bf16x8 qf[4]; float qn = 0.f;
#pragma unroll
        for (int ks = 0; ks < 4; ++ks) { const u32x4 qv = *(const u32x4*)(qml + (bhrow + t) * 128 + 32 * ks + 8 * g4); qf[ks] = __builtin_bit_cast(bf16x8, qv);
            const f32x4 n0 = *(const f32x4*)(nin + u * 128 + 32 * ks + 8 * g4), n1 = *(const f32x4*)(nin + u * 128 + 32 * ks + 8 * g4 + 4);
            qn += bflo(qv.x) * n0.x + bfhi(qv.x) * n0.y + bflo(qv.y) * n0.z + bfhi(qv.y) * n0.w + bflo(qv.z) * n1.x + bfhi(qv.z) * n1.y + bflo(qv.w) * n1.z + bfhi(qv.w) * n1.w; }
        qn += __shfl_xor(qn, 16); qn += __shfl_xor(qn, 32);
        f32x4 aI[8], aP[8];
#pragma unroll
        for (int et = 0; et < 8; ++et) { aI[et] = (f32x4){0.f, 0.f, 0.f, 0.f}; aP[et] = aI[et]; }
#pragma unroll
        for (int ks = 0; ks < 4; ++ks)
            {
#pragma unroll
              for (int et = 0; et < 8; ++et) aI[et] = __builtin_amdgcn_mfma_f32_16x16x32_bf16(*(const LAS bf16x8*)(L + 65536 + sw256(16 * et + c, 32 * ks + 8 * g4)), qf[ks], aI[et], 0, 0, 0); __builtin_amdgcn_sched_barrier(0); }
        float den = 0.f;
        for (int ss = 0; 2 * ss <= w; ++ss) {
            float p[2][4];
#pragma unroll
            for (int hh = 0; hh < 2; ++hh) { const int st = 2 * ss + hh;
                if (st <= w) { f32x4 sa = (f32x4){0.f, 0.f, 0.f, 0.f};
#pragma unroll
                    for (int ks = 0; ks < 4; ++ks) sa = __builtin_amdgcn_mfma_f32_16x16x32_bf16(*(const LAS bf16x8*)(L + sw256(16 * st + c, 32 * ks + 8 * g4)), qf[ks], sa, 0, 0, 0);
#pragma unroll
                    for (int i = 0; i < 4; ++i) { const int s = 16 * st + 4 * g4 + i; const float v = s <= t ? sa[i] * __expf(ia[s] - mref) : 0.f; p[hh][i] = v; den += v; } }
                else {
#pragma unroll
                    for (int i = 0; i < 4; ++i) p[hh][i] = 0.f; } }
            u32x4 pw; pw.x = pk2(p[0][0], p[0][1]); pw.y = pk2(p[0][2], p[0][3]); pw.z = pk2(p[1][0], p[1][1]); pw.w = pk2(p[1][2], p[1][3]);
            const bf16x8 pf = __builtin_bit_cast(bf16x8, pw);
#pragma unroll
            for (int et = 0; et < 8; ++et) { const u32x2 lo = *(const LAS u32x2*)(L + 32768 + sw256(16 * et + c, 32 * ss + 4 * g4)), hi = *(const LAS u32x2*)(L + 32768 + sw256(16 * et + c, 32 * ss + 16 + 4 * g4));
                const u32x4 vw = (u32x4){lo.x, lo.y, hi.x, hi.y};
                aP[et] = __builtin_amdgcn_mfma_f32_16x16x32_bf16(__builtin_bit_cast(bf16x8, vw), pf, aP[et], 0, 0, 0); }
        }
        den += __shfl_xor(den, 16); den += __shfl_xor(den, 32);
        den += wi * qn;
        const float mt = Fa[t] + mref, dd = 1.0f / fmaxf(fabsf(den), __expf(-mt));
        float s1 = 0.f;
#pragma unroll
        for (int et = 0; et < 8; ++et)
#pragma unroll
            for (int i = 0; i < 4; ++i) { const float v = (aP[et][i] + wi * aI[et][i]) * dd; aP[et][i] = v; s1 += v; }
        s1 += __shfl_xor(s1, 16); s1 += __shfl_xor(s1, 32);
        const float mu = s1 * (1.0f / 128.0f); float s2 = 0.f;
#pragma unroll
        for (int et = 0; et < 8; ++et)
#pragma unroll
            for (int i = 0; i < 4; ++i) { const float v = aP[et][i] - mu; aP[et][i] = v; s2 += v * v; }
        s2 += __shfl_xor(s2, 16); s2 += __shfl_xor(s2, 32);
        const float rstd = rsqrtf(s2 * (1.0f / 128.0f) + 1e-5f);
        const size_t tok = tok0 + t;
#pragma unroll
        for (int et = 0; et < 8; ++et) { const int col = h * 128 + 16 * et + 4 * g4;
            const unsigned ow8 = *(const unsigned*)((const unsigned char*)(F.ws + WS_GATE8) + tok * GP + G_OPRE + col); const f32x2 o01 = __builtin_amdgcn_cvt_pk_f32_fp8((int)ow8, false), o23 = __builtin_amdgcn_cvt_pk_f32_fp8((int)ow8, true); const f32x4 ng = *(const f32x4*)(F.in[19] + col);
            u32x2 y; y.x = pk2(sigmoidf_(o01.x) * aP[et][0] * rstd * ng.x, sigmoidf_(o01.y) * aP[et][1] * rstd * ng.y);
            y.y = pk2(sigmoidf_(o23.x) * aP[et][2] * rstd * ng.z, sigmoidf_(o23.y) * aP[et][3] * rstd * ng.w);
            *(u32x2*)(yml + tok * 1024 + col) = y; }
    }
}

__device__ __forceinline__ void p9_route(Frame& F, const bool dup) {
    const bf16* x1 = (const bf16*)(F.ws + WS_OY); const float* mod = (const float*)(F.ws + WS_MOD); const float* g2 = F.in[23]; const float* rb = F.in[25];
    const bf16* rwh = (const bf16*)(F.ws + WS_RWT); const bf16* rwl = rwh + 32 * 1024;
    bf16* h2 = (bf16*)(F.ws + WS_XN);
    int* re = (int*)(F.ws + (dup ? WS_ACT : WS_RE)); float* rwt = (float*)(F.ws + (dup ? WS_ACT + MiB : WS_RW)); int* rs = (int*)(F.ws + (dup ? WS_ACT + 2 * MiB : WS_RS)); unsigned* cnt = (unsigned*)(F.ws + WS_CTL) + (dup ? 16 : 0);
    const int gw = F.bid * NWAVES + F.wave, NGW = F.G * NWAVES, lane = F.lane, c = lane & 15, g4 = lane >> 4;
    LAS unsigned* lcnt = (LAS unsigned*)F.lds;
    for (int grp = gw; grp < T / 16; grp += NGW) {
        const int tkn = grp * 16 + c, b = tkn >> 11;
        const bf16* xr = x1 + (size_t)tkn * D + 8 * g4; const float* sh = mod + (size_t)b * 6144 + 3 * 1024 + 8 * g4; const float* scp = mod + (size_t)b * 6144 + 4 * 1024 + 8 * g4;
        float ss = 0.f;
#pragma unroll 8
        for (int ks = 0; ks < 32; ++ks) { const u32x4 xv = *(const u32x4*)(xr + 32 * ks); const f32x4 a = (f32x4){bflo(xv.x), bfhi(xv.x), bflo(xv.y), bfhi(xv.y)}, bq = (f32x4){bflo(xv.z), bfhi(xv.z), bflo(xv.w), bfhi(xv.w)};
            ss += (a.x * a.x + a.y * a.y) + (a.z * a.z + a.w * a.w) + (bq.x * bq.x + bq.y * bq.y) + (bq.z * bq.z + bq.w * bq.w); }
        ss += __shfl_xor(ss, 16); ss += __shfl_xor(ss, 32);
        const float rsq = rsqrtf(ss * (1.0f / D) + 1e-5f);
        f32x4 acc[2]; acc[0] = (f32x4){0.f, 0.f, 0.f, 0.f}; acc[1] = acc[0];
#pragma unroll 4
        for (int ks = 0; ks < 32; ++ks) {
            float y[8];
            { const u32x4 xv = *(const u32x4*)(xr + 32 * ks); const f32x4 a = (f32x4){bflo(xv.x), bfhi(xv.x), bflo(xv.y), bfhi(xv.y)}, bq = (f32x4){bflo(xv.z), bfhi(xv.z), bflo(xv.w), bfhi(xv.w)};
              const f32x4 ga = *(const f32x4*)(g2 + 32 * ks + 8 * g4), gb = *(const f32x4*)(g2 + 32 * ks + 8 * g4 + 4);
              const f32x4 sa = *(const f32x4*)(scp + 32 * ks), sb = *(const f32x4*)(scp + 32 * ks + 4), ha = *(const f32x4*)(sh + 32 * ks), hb = *(const f32x4*)(sh + 32 * ks + 4);
#pragma unroll
              for (int i = 0; i < 4; ++i) { y[i] = a[i] * rsq * ga[i] * (1.0f + sa[i]) + ha[i]; y[4 + i] = bq[i] * rsq * gb[i] * (1.0f + sb[i]) + hb[i]; } }
            unsigned hi[8], lo[8];
#pragma unroll
            for (int i = 0; i < 8; ++i) { hi[i] = f2bf(y[i]); lo[i] = f2bf(y[i] - __builtin_bit_cast(float, hi[i] << 16)); }
            const u32x4 yhw = (u32x4){hi[0] | (hi[1] << 16), hi[2] | (hi[3] << 16), hi[4] | (hi[5] << 16), hi[6] | (hi[7] << 16)};
            const u32x4 ylw = (u32x4){lo[0] | (lo[1] << 16), lo[2] | (lo[3] << 16), lo[4] | (lo[5] << 16), lo[6] | (lo[7] << 16)};
            { u32x2 y8; y8.x = pk4_fp8(y[0], y[1], y[2], y[3]); y8.y = pk4_fp8(y[4], y[5], y[6], y[7]); *(u32x2*)((unsigned char*)h2 + (size_t)tkn * D + 32 * ks + 8 * g4) = y8; }
            const bf16x8 yh = __builtin_bit_cast(bf16x8, yhw), yl = __builtin_bit_cast(bf16x8, ylw);
#pragma unroll
            for (int et = 0; et < 2; ++et) { const size_t wo = (size_t)(16 * et + c) * 1024 + 32 * ks + 8 * g4;
                const bf16x8 wh = *(const bf16x8*)(rwh + wo), wl = *(const bf16x8*)(rwl + wo);
                acc[et] = __builtin_amdgcn_mfma_f32_16x16x32_bf16(wh, yh, acc[et], 0, 0, 0);
                acc[et] = __builtin_amdgcn_mfma_f32_16x16x32_bf16(wl, yh, acc[et], 0, 0, 0);
                acc[et] = __builtin_amdgcn_mfma_f32_16x16x32_bf16(wh, yl, acc[et], 0, 0, 0); }
        }
        float lg[32];
#pragma unroll
        for (int gs = 0; gs < 4; ++gs)
#pragma unroll
            for (int et = 0; et < 2; ++et)
#pragma unroll
                for (int i = 0; i < 4; ++i) { const int e = 16 * et + 4 * gs + i; lg[e] = __shfl(acc[et][i], c + 16 * gs) + rb[e]; }
        int te[4]; float tv[4]; unsigned used = 0u;
#pragma unroll
        for (int k = 0; k < 4; ++k) { float best = -3.0e38f; int bi = 0;
#pragma unroll
            for (int e = 0; e < 32; ++e) { const bool ok = !((used >> e) & 1u) && lg[e] > best; best = ok ? lg[e] : best; bi = ok ? e : bi; }
            te[k] = bi; tv[k] = best; used |= 1u << bi; }
        const float e1 = __expf(tv[1] - tv[0]), e2 = __expf(tv[2] - tv[0]), e3 = __expf(tv[3] - tv[0]); const float inv = 1.0f / (1.0f + e1 + e2 + e3);
        { const int ek = g4 == 0 ? te[0] : g4 == 1 ? te[1] : g4 == 2 ? te[2] : te[3];
          const float wk = (g4 == 0 ? 1.0f : g4 == 1 ? e1 : g4 == 2 ? e2 : e3) * inv;
          __syncthreads();
          if (F.tid < 32) lcnt[F.tid] = 0u;
          __syncthreads();
          const unsigned rnk = __hip_atomic_fetch_add(lcnt + ek, 1u, __ATOMIC_RELAXED, __HIP_MEMORY_SCOPE_WORKGROUP);
          __syncthreads();
          if (F.tid < 32) lcnt[32 + F.tid] = atomicAdd(cnt + F.tid * 32, lcnt[F.tid]);
          __syncthreads();
          const unsigned slot = lcnt[32 + ek] + rnk;
          re[tkn * 4 + g4] = ek; rwt[tkn * 4 + g4] = wk; rs[tkn * 4 + g4] = (int)slot; }
    }
}

__device__ __forceinline__ void p10_gather(Frame& F) {
    const unsigned* cnt = (const unsigned*)(F.ws + WS_CTL);
    const int* re = (const int*)(F.ws + WS_RE); const int* rs = (const int*)(F.ws + WS_RS); int* dest = (int*)(F.ws + WS_DEST); int* blke = (int*)(F.ws + WS_BLKE);
    int* rowidx = (int*)(F.ws + WS_ROWIDX);
    LAS int* off = (LAS int*)F.lds;
    __syncthreads();
    if (F.tid == 0) { int o = 0; for (int e = 0; e < 32; ++e) { const int c = (int)__hip_atomic_load(cnt + e * 32, __ATOMIC_RELAXED, __HIP_MEMORY_SCOPE_AGENT); const int p = (c + 255) & ~255; off[e] = o; off[32 + e] = c; off[64 + e] = p; o += p; } off[96] = o; }
    __syncthreads();
    if (F.bid == 0) { const int nblk = off[96] >> 8;
        for (int i = F.tid; i < nblk; i += NTHREADS) { int e = 0; for (int k = 1; k < 32; ++k) if (i * 256 >= off[k]) e = k; blke[i] = e; }
        if (F.tid == 0) blke[1000] = nblk; }
    const int gtid = F.bid * NTHREADS + F.tid, gsz = F.G * NTHREADS;
    for (int i = gtid; i < T * 4; i += gsz) { const int dr = off[re[i]] + rs[i]; dest[i] = dr; rowidx[dr] = i >> 2; }
    for (int i = gtid; i < 32 * 256; i += gsz) { const int e = i >> 8, r = i & 255; if (off[32 + e] + r < off[64 + e]) rowidx[off[e] + off[32 + e] + r] = 0; }
}

__device__ __forceinline__ void p13_final(Frame& F, const bool dup) {
    const float* mod = (const float*)(F.ws + WS_MOD); const float* fg = F.in[30];
    const float* rwt = (const float*)(F.ws + WS_RW); const int* dest = (const int*)(F.ws + WS_DEST); const bf16* ypad = (const bf16*)(F.ws + WS_PROJ);
    const int gw = F.bid * NWAVES + F.wave, NGW = F.G * NWAVES, lane = F.lane;
    for (int grp = gw; grp < T / 16; grp += NGW) {
        const int dl = dest[grp * 64 + lane]; const float wl = rwt[grp * 64 + lane];
        const int b = (grp * 16) >> 11; const float* g2 = mod + (size_t)b * 6144 + 5 * 1024;
#pragma unroll 4
        for (int tk = 0; tk < 16; ++tk) {
            const int tkn = grp * 16 + tk; const bf16* xr = (const bf16*)(F.ws + WS_OY) + (size_t)tkn * D; float* xo = (dup ? (float*)(F.ws + WS_ACT) : F.out) + (size_t)tkn * D;
            float acc[16];
#pragma unroll
            for (int i = 0; i < 16; ++i) acc[i] = 0.f;
#pragma unroll
            for (int k = 0; k < 4; ++k) { const int dr = __shfl(dl, 4 * tk + k); const float w = __shfl(wl, 4 * tk + k); const u32x4* yp = (const u32x4*)(ypad + (size_t)dr * D);
#pragma unroll
                for (int j = 0; j < 2; ++j) { const u32x4 y = yp[64 * j + lane];
                    acc[8 * j + 0] += w * bflo(y.x); acc[8 * j + 1] += w * bfhi(y.x); acc[8 * j + 2] += w * bflo(y.y); acc[8 * j + 3] += w * bfhi(y.y);
                    acc[8 * j + 4] += w * bflo(y.z); acc[8 * j + 5] += w * bfhi(y.z); acc[8 * j + 6] += w * bflo(y.w); acc[8 * j + 7] += w * bfhi(y.w); } }
            float ss = 0.f;
#pragma unroll
            for (int j = 0; j < 2; ++j) { const int d0 = (64 * j + lane) * 8; const u32x4 xw = *(const u32x4*)(xr + d0);
#pragma unroll
                for (int q = 0; q < 2; ++q) { const f32x4 xv = q == 0 ? (f32x4){bflo(xw.x), bfhi(xw.x), bflo(xw.y), bfhi(xw.y)} : (f32x4){bflo(xw.z), bfhi(xw.z), bflo(xw.w), bfhi(xw.w)}; const f32x4 gv = *(const f32x4*)(g2 + d0 + 4 * q);
#pragma unroll
                    for (int i = 0; i < 4; ++i) { const float y = xv[i] + gv[i] * acc[8 * j + 4 * q + i]; acc[8 * j + 4 * q + i] = y; ss += y * y; } } }
            const float rsq = rsqrtf(wave_sum(ss) * (1.0f / D) + 1e-5f);
#pragma unroll
            for (int j = 0; j < 2; ++j) { const int d0 = (64 * j + lane) * 8;
#pragma unroll
                for (int q = 0; q < 2; ++q) { const f32x4 gv = *(const f32x4*)(fg + d0 + 4 * q);
                    *(f32x4*)(xo + d0 + 4 * q) = (f32x4){acc[8 * j + 4 * q] * rsq * gv.x, acc[8 * j + 4 * q + 1] * rsq * gv.y, acc[8 * j + 4 * q + 2] * rsq * gv.z, acc[8 * j + 4 * q + 3] * rsq * gv.w}; } }
        }
    }
}

#define XB_TMO      128
#define XB_XCNT(j)  (256  + 64 * (j))
#define XB_XSUB(j)  (1280 + 64 * (j))
#define XB_XGEN(j)  (2304 + 64 * (j))
#define XB_TOP      3328
#define XB_TOPGEN   3392
#define XCD_BAR_WORDS 3456
#define XB_SPIN_CAP (1u << 18)
__device__ __forceinline__ unsigned xb_ld(unsigned* p)              { return __hip_atomic_load(p, __ATOMIC_RELAXED, __HIP_MEMORY_SCOPE_AGENT); }
__device__ __forceinline__ unsigned xb_add(unsigned* p, unsigned v) { return __hip_atomic_fetch_add(p, v, __ATOMIC_RELAXED, __HIP_MEMORY_SCOPE_AGENT); }
__device__ __forceinline__ unsigned xb_xcc_id() { return (unsigned)__builtin_amdgcn_s_getreg((3 << 11) | 20) & 0xFu; }
#define XB_SPIN(cond, bar) do { unsigned _sp = 0; while (cond) { __builtin_amdgcn_s_sleep(1); \
    if ((++_sp & 255u) == 0u) { if (xb_ld(&(bar)[XB_TMO])) break; if (_sp > XB_SPIN_CAP) { atomicAdd(&(bar)[XB_TMO], 1u); break; } } } } while (0)
struct XcdBarrier { unsigned* bar; unsigned x; volatile LAS unsigned* st; };
__device__ __forceinline__ XcdBarrier xcd_barrier_post(unsigned* bar, volatile LAS unsigned* st) {
    XcdBarrier b; b.bar = bar; b.x = xb_xcc_id(); b.st = st;
    if (threadIdx.x == 0) (void)xb_add(&bar[XB_XCNT(b.x)], 1u);
    return b;
}
__device__ __forceinline__ void xcd_barrier_complete(unsigned* bar, unsigned x, unsigned& nloc, unsigned& nx) {
    const unsigned G = gridDim.x * gridDim.y * gridDim.z;
    unsigned sum, cnt, mine, sp = 0u;
    for (;;) {
        sum = 0u; cnt = 0u; mine = 0u;
#pragma unroll
        for (unsigned j = 0; j < 16; ++j) { const unsigned c = xb_ld(&bar[XB_XCNT(j)]); sum += c; cnt += (c > 0u) ? 1u : 0u; mine = (j == x) ? c : mine; }
        if (sum == G) break;
        __builtin_amdgcn_s_sleep(1);
        if ((++sp & 255u) == 0u) { if (xb_ld(&bar[XB_TMO])) break; if (sp > XB_SPIN_CAP) { atomicAdd(&bar[XB_TMO], 1u); break; } }
    }
    nloc = mine > 0u ? mine : 1u; nx = cnt > 0u ? cnt : 1u;
}
__device__ __forceinline__ void xcd_barrier(const XcdBarrier& b) {
    asm volatile("s_waitcnt vmcnt(0)" ::: "memory");
    __syncthreads();
    if (threadIdx.x == 0) {
        unsigned* bar = b.bar;
        __builtin_amdgcn_s_waitcnt(0);
        unsigned nloc = b.st[0], nx = b.st[1];
        if (nloc == 0u) { xcd_barrier_complete(bar, b.x, nloc, nx); b.st[0] = nloc; b.st[1] = nx; }
        const unsigned old = xb_add(&bar[XB_XSUB(b.x)], 1u);
        const unsigned gen = old / nloc;
        if (old + 1u == (gen + 1u) * nloc) {
            __builtin_amdgcn_fence(__ATOMIC_RELEASE, "agent");
            asm volatile("s_waitcnt vmcnt(0)" ::: "memory");
            const unsigned og = xb_add(&bar[XB_TOP], 1u);
            const unsigned tg = og / nx;
            if (og + 1u == (tg + 1u) * nx) xb_add(&bar[XB_TOPGEN], 1u);
            else XB_SPIN(xb_ld(&bar[XB_TOPGEN]) == tg, bar);
            __builtin_amdgcn_fence(__ATOMIC_ACQUIRE, "agent");
            xb_add(&bar[XB_XGEN(b.x)], 1u);
            asm volatile("s_waitcnt vmcnt(0)" ::: "memory");
        } else {
            XB_SPIN(xb_ld(&bar[XB_XGEN(b.x)]) == gen, bar);
            __builtin_amdgcn_fence(__ATOMIC_ACQUIRE, "agent");
            asm volatile("s_waitcnt vmcnt(0)" ::: "memory");
        }
    }
    __syncthreads();
}

#ifndef PH_MASK
#define PH_MASK 0xFFFFFFFFu
#endif
#define PH(k) ((PH_MASK >> (k)) & 1u)
#ifndef DUP_MASK
#define DUP_MASK 0u
#endif
#define DUP(k) ((DUP_MASK >> (k)) & 1u)
#define REFRESH() do { F.tid = opaque_i(threadIdx.x); F.lane = F.tid & 63; F.wave = __builtin_amdgcn_readfirstlane(F.tid >> 6); } while (0)
__global__ void __launch_bounds__(NTHREADS, 2) fwd_mega(Args args) {
    extern __shared__ __attribute__((aligned(16))) unsigned char lds_raw[];
    cg::grid_group grid = cg::this_grid();
    Frame F;
    F.lds = (LAS unsigned char*)lds_raw; F.ws = args.ws; F.in = args.in; F.out = args.out;
    F.tid = threadIdx.x; F.lane = F.tid & 63; F.wave = __builtin_amdgcn_readfirstlane(F.tid >> 6); F.G = gridDim.x; F.bid = blockIdx.x;
    unsigned char* ws = args.ws;
    volatile LAS unsigned* bst = (volatile LAS unsigned*)(F.lds + LDS_BYTES - 64);
    if (F.tid < 16) bst[F.tid] = 0u;
    __syncthreads();
    const XcdBarrier xbar = xcd_barrier_post((unsigned*)(ws + WS_CTL) + 1024, bst);
#define GSYNC() do { xcd_barrier(xbar); REFRESH(); } while (0)

    if (PH(0)) { p0_adaln(F); __syncthreads(); p0_cpe(F); }
    if (DUP(0)) { __syncthreads(); p0_adaln(F); __syncthreads(); p0_cpe(F); }
    if (__builtin_expect(args.ws == nullptr, 0)) grid.sync();
    GSYNC();
    if (PH(1)) p1_prologue(F);
    if (DUP(1)) { __syncthreads(); p1_prologue(F); }
    GSYNC();
    if (PH(2)) {
        { pg8::Gemm g{(const bf16*)(ws + WS_XN), (const bf16*)(ws + WS_WIN), 1024}; pg8::StaticOrder So; So.init(T, NPROJ_A, F.G, F.bid);
          pg8::EpiProj E{(bf16*)(ws + WS_PROJ), (float*)(ws + WS_SMALL), (const float*)(ws + WS_BIN), (unsigned char*)(ws + WS_GATE8), 0, -1, 1000};
          pg8::gemm_phase<pg8::EpiProj, pg8::StaticOrder, true, true>(F.lds, g, So, E);
          if (DUP(2)) { __syncthreads(); pg8::gemm_phase<pg8::EpiProj, pg8::StaticOrder, true, true>(F.lds, g, So, E); } }
        __syncthreads();
        { pg8::Gemm g{(const bf16*)(ws + WS_OY), (const bf16*)(ws + WS_WIN + 4 * MiB), 1024}; pg8::StaticOrder So; So.init(T, NPROJ_B, F.G, F.bid);
          pg8::EpiProj E{(bf16*)(ws + WS_PROJ) + NPROJ_A, (float*)(ws + WS_SMALL), (const float*)(ws + WS_BIN) + NPROJ_A, (unsigned char*)(ws + WS_GATE8), NPROJ_A, 5, 6};
          pg8::gemm_phase<pg8::EpiProj, pg8::StaticOrder, true, true, true>(F.lds, g, So, E);
          if (DUP(20)) { __syncthreads(); pg8::gemm_phase<pg8::EpiProj, pg8::StaticOrder, true, true, true>(F.lds, g, So, E); } }
    }
    GSYNC();
    if (PH(3)) { p3_compress(F); __syncthreads(); }
    if (DUP(3)) { p3_compress(F); __syncthreads(); }
    REFRESH(); if (PH(4)) { p3_mlstate(F); __syncthreads(); }
    if (DUP(4)) { p3_mlstate(F); __syncthreads(); }
    GSYNC();
    REFRESH(); if (PH(7)) p4_mlscan(F);
    if (DUP(7)) p4_mlscan(F);
    GSYNC();
    if (PH(8)) { p5_attn(F, 0); __syncthreads(); }
    if (DUP(8)) { p5_attn(F, 1); __syncthreads(); }
    REFRESH(); if (PH(9)) p5_mlout(F);
    if (DUP(9)) { __syncthreads(); p5_mlout(F); }
    GSYNC();
    if (DUP(21)) { GSYNC(); GSYNC(); GSYNC(); GSYNC(); }
    if (PH(11)) {
        pg8::StaticOrder So; So.init(T, 1024, F.G, F.bid);
        for (int rep7 = 0; rep7 < (DUP(11) ? 2 : 1); ++rep7) {
        { pg8::Gemm g{(const bf16*)(ws + WS_OY), (const bf16*)(ws + WS_WPA), 1024};
          pg8::EpiMix2 E{(bf16*)(ws + WS_XN), (const unsigned char*)(ws + WS_GATE8)};
          pg8::gemm_phase<pg8::EpiMix2, pg8::StaticOrder, true, true>(F.lds, g, So, E); }
        __syncthreads(); }
    }
    GSYNC();
    if (PH(12)) {
        pg8::Gemm g{(const bf16*)(ws + WS_XN), (const bf16*)(ws + WS_WOUT), 1024}; pg8::StaticOrder So; So.init(T, 1024, F.G, F.bid);
        pg8::EpiWout E{F.in[0], (bf16*)(ws + WS_OY), (const float*)(ws + WS_MOD) + 2 * 1024};
        pg8::gemm_phase<pg8::EpiWout, pg8::StaticOrder, true, true, true>(F.lds, g, So, E);
        if (DUP(12)) { __syncthreads(); pg8::gemm_phase<pg8::EpiWout, pg8::StaticOrder, true, true, true>(F.lds, g, So, E); }
        if (DUP(19)) { __syncthreads(); pg8::EpiNull En{(float*)(ws + WS_ACT)}; pg8::gemm_phase<pg8::EpiNull, pg8::StaticOrder, true, true, true>(F.lds, g, So, En); }
    }
    GSYNC();
    if (PH(13)) p9_route(F, false);
    if (DUP(13)) p9_route(F, true);
    GSYNC();
    if (PH(14)) p10_gather(F);
    if (DUP(14)) { __syncthreads(); p10_gather(F); }
    GSYNC();
    if (PH(15)) {
        const int* blke = (const int*)(ws + WS_BLKE); const int nblk = __builtin_amdgcn_readfirstlane(blke[1000]);
        { pg8::MoeOrderG Mo; Mo.blk_e = blke; Mo.rows = (const int*)(ws + WS_ROWIDX); Mo.nblk = nblk; Mo.x = F.bid & 7; Mo.y = F.bid >> 3; Mo.ny = F.G >> 3; Mo.nN = 8; Mo.nPerE = 2048;
          pg8::Gemm g{(const bf16*)(ws + WS_XN), (const bf16*)(ws + WS_WUP), 1024};
          pg8::EpiSwiglu E{(bf16*)(ws + WS_ACT), F.in[27]};
          pg8::gemm_phase<pg8::EpiSwiglu, pg8::MoeOrderG, true, true, true>(F.lds, g, Mo, E);
          if (DUP(17)) { __syncthreads(); pg8::gemm_phase<pg8::EpiSwiglu, pg8::MoeOrderG, true, true, true>(F.lds, g, Mo, E); } }
        pg8::MoeOrder Mo; Mo.blk_e = blke; Mo.rows = nullptr; Mo.nblk = nblk; Mo.x = F.bid & 7; Mo.y = F.bid >> 3; Mo.ny = F.G >> 3;
        GSYNC();
        { Mo.nN = 4; Mo.nPerE = 1024;
          pg8::Gemm g{(const bf16*)(ws + WS_ACT), (const bf16*)(ws + WS_WDN), 1024};
          pg8::EpiDown E{(bf16*)(ws + WS_PROJ), F.in[29]};
          pg8::gemm_phase<pg8::EpiDown, pg8::MoeOrder, true, true, true>(F.lds, g, Mo, E);
          if (DUP(18)) { __syncthreads(); pg8::gemm_phase<pg8::EpiDown, pg8::MoeOrder, true, true, true>(F.lds, g, Mo, E); } }
    }
    GSYNC();
    if (PH(16)) p13_final(F, false);
    if (DUP(16)) p13_final(F, true);
}

extern "C" void kernel_launch(void* const* d_in, const int* in_sizes, int n_in, void* d_out, int out_size, void* d_ws, size_t ws_size, hipStream_t stream) {
    static int grid = 0;
    if (grid == 0) {
        if (n_in != 31 || out_size != T * D || ws_size < WS_END) { fprintf(stderr, "kernel_launch: unexpected problem (n_in %d out %d ws %zu)\n", n_in, out_size, ws_size); grid = -1; return; }
        int dev = 0, cus = 0, per_cu = 0;
        if (hipGetDevice(&dev) != hipSuccess || hipDeviceGetAttribute(&cus, hipDeviceAttributeMultiprocessorCount, dev) != hipSuccess) { grid = -1; return; }
        if (hipFuncSetAttribute((const void*)fwd_mega, hipFuncAttributeMaxDynamicSharedMemorySize, LDS_BYTES) != hipSuccess) { fprintf(stderr, "kernel_launch: hipFuncSetAttribute failed\n"); grid = -1; return; }
        if (hipOccupancyMaxActiveBlocksPerMultiprocessor(&per_cu, (const void*)fwd_mega, NTHREADS, LDS_BYTES) != hipSuccess || per_cu < 1) { fprintf(stderr, "kernel_launch: occupancy query says %d\n", per_cu); (void)hipGetLastError(); grid = -1; return; }
        grid = cus;
        if (grid % 8 != 0) grid -= grid % 8;
        fprintf(stderr, "kernel_launch: cus %d per_cu %d grid %d ws %zu\n", cus, per_cu, grid, ws_size);
    }
    if (grid < 0) return;
    (void)hipMemsetAsync((char*)d_ws + WS_CTL, 0, 32768, stream);
    Args a{};
    for (int i = 0; i < 31; ++i) a.in[i] = (const float*)d_in[i];
    a.out = (float*)d_out; a.ws = (unsigned char*)d_ws;
    void* kargs[] = {&a};
    hipError_t e = hipLaunchCooperativeKernel((const void*)fwd_mega, dim3(grid), dim3(NTHREADS), kargs, LDS_BYTES, stream);
    if (e != hipSuccess) fprintf(stderr, "kernel_launch: cooperative launch failed: %s\n", hipGetErrorString(e));
}
```

```cpp
#include <hip/hip_runtime.h>
#include <hip/hip_cooperative_groups.h>
#include <cstdio>
#include <cstdint>
namespace cg = cooperative_groups;

#define LAS __attribute__((address_space(3)))
typedef unsigned short bf16;
typedef float f32x4 __attribute__((ext_vector_type(4)));
typedef float f32x2 __attribute__((ext_vector_type(2)));
typedef unsigned u32x4 __attribute__((ext_vector_type(4)));
typedef unsigned u32x2 __attribute__((ext_vector_type(2)));
typedef short bf16x8 __attribute__((ext_vector_type(8)));
typedef short s16x4 __attribute__((ext_vector_type(4)));

constexpr int NB = 16, S = 2048, D = 1024, T = NB * S;
constexpr int NPROJ = 4608;
constexpr int C_Q = 512, C_KCMP = 1024, C_VCMP = 1152, C_KSLC = 1280, C_VSLC = 1408, C_KWIN = 1536, C_VWIN = 1664;
constexpr int C_XM = 0, C_SMALL = 1792, C_OPRE = 2048, C_GA = 2560, C_GB = 3584;
constexpr int NPROJ_A = 512, NPROJ_B = 4096;
constexpr int PP = 2048, GP = 2560;
constexpr int G_OPRE = 0, G_GA = 512, G_GB = 1536;
constexpr int IN_W = 4384;
constexpr int NCMP = 127;
constexpr int NEXP = 32, PMAX = 544 * 256;
constexpr int NTHREADS = 512, NWAVES = 8;
constexpr int LDS_BYTES = 147456;

constexpr size_t MiB = 1u << 20;
constexpr size_t WS_CTL = 0;
constexpr size_t WS_MODP = 1 * MiB;
constexpr size_t WS_MOD = 7 * MiB;
constexpr size_t WS_BIN = 8 * MiB;
constexpr size_t WS_BLKE = 8 * MiB + 64 * 1024;
constexpr size_t WS_OFFS = 8 * MiB + 128 * 1024;
constexpr size_t WS_SMALL = 9 * MiB;
constexpr size_t WS_RE = 13 * MiB;
constexpr size_t WS_RW = WS_RE + 512 * 1024;
constexpr size_t WS_RS = WS_RW + 512 * 1024;
constexpr size_t WS_DEST = WS_RS + 512 * 1024;
constexpr size_t WS_ROWIDX = 17 * MiB;
constexpr size_t WS_SELM = 15 * MiB;
constexpr size_t WS_KC = 16 * MiB;
constexpr size_t WS_KCB = 16 * MiB;
constexpr size_t WS_W1T = 21 * MiB;
constexpr size_t WS_W2T = 22 * MiB;
constexpr size_t WS_CPE = 22 * MiB + 64 * 1024;
constexpr size_t WS_WQT = 23 * MiB;
constexpr size_t WS_RWT = 23 * MiB + 512 * 1024;
constexpr size_t WS_NLOC = 19 * MiB;
constexpr size_t WS_MLOC = 19 * MiB + 512 * 1024;
constexpr size_t WS_FLAST = WS_MLOC + 4096;
constexpr size_t WS_MIN = WS_FLAST + 4096;
constexpr size_t WS_NIN = 20 * MiB;
constexpr size_t WS_WIN = 24 * MiB;
constexpr size_t WS_WPA = 33 * MiB, WS_WOUT = 35 * MiB;
constexpr size_t WS_WUP = 40 * MiB;
constexpr size_t WS_WDN = 168 * MiB;
constexpr size_t WS_XN = 232 * MiB;
constexpr size_t WS_PROJ = 296 * MiB;
constexpr size_t WS_GATE8 = 424 * MiB;
constexpr size_t WS_QML = 584 * MiB, WS_KML = 616 * MiB, WS_VML = 648 * MiB;
constexpr size_t WS_CLOC = 680 * MiB, WS_CIN = 744 * MiB;
constexpr size_t WS_OACC = 808 * MiB;
constexpr size_t WS_ACT = 584 * MiB;
constexpr size_t WS_OY = 872 * MiB;
constexpr size_t WS_END = 936 * MiB;

__device__ __forceinline__ unsigned f2bf(float f) { unsigned u = __builtin_bit_cast(unsigned, f); return (u + 0x7fffu + ((u >> 16) & 1u)) >> 16; }
typedef __bf16 bf16x2_t __attribute__((ext_vector_type(2)));
__device__ __forceinline__ unsigned pk2(float lo, float hi) { const f32x2 v = {lo, hi}; return __builtin_bit_cast(unsigned, __builtin_convertvector(v, bf16x2_t)); }
__device__ __forceinline__ float bf2f(bf16 v) { return __builtin_bit_cast(float, (unsigned)v << 16); }
__device__ __forceinline__ float bflo(unsigned w) { return __builtin_bit_cast(float, w << 16); }
__device__ __forceinline__ float bfhi(unsigned w) { return __builtin_bit_cast(float, w & 0xffff0000u); }
__device__ __forceinline__ float sigmoidf_(float x) { return __builtin_amdgcn_rcpf(1.0f + __expf(-x)); }
__device__ __forceinline__ float wave_sum(float v) {
#pragma unroll
    for (int o = 1; o < 64; o <<= 1) v += __shfl_xor(v, o);
    return v;
}
#define LDS_WAIT() asm volatile("s_waitcnt lgkmcnt(0)" ::: "memory")
__device__ __forceinline__ unsigned pk4_fp8(float a, float b, float c, float d) { int w = 0; w = __builtin_amdgcn_cvt_pk_fp8_f32(a, b, w, false); w = __builtin_amdgcn_cvt_pk_fp8_f32(c, d, w, true); return (unsigned)w; }
__device__ __forceinline__ int opaque_i(int x) { asm volatile("" : "+v"(x)); return x; }

namespace pg8 {
constexpr int BM = 256, BK = 64, HALF = 128, HTB = HALF * BK * 2, STAGE_BYTES = 8 * HTB, NXCD = 8, WGM = 8;
__host__ __device__ __forceinline__ int lds_byte(int r, int c) { const int st = (r >> 4) * 2 + (c >> 5), rr = r & 15, cc = c & 31, ob = rr * 64 + cc * 2; return st * 1024 + (ob ^ (((ob >> 9) & 1) << 5)); }
__host__ __device__ __forceinline__ void stage_rc(int b, int& R, int& C) { const int st = b / 1024, sb = b % 1024, swz = sb ^ (((sb >> 9) & 1) << 5); R = (st >> 1) * 16 + swz / 64; C = (st & 1) * 32 + (swz % 64) / 2; }
__host__ __device__ __forceinline__ int perm32(int rho) { const int n = rho >> 4, i = rho & 15; return 8 * (i >> 2) + 4 * n + (i & 3); }

struct Unit { int pm, pn, brow, e; };
struct Gemm { const bf16* A; const bf16* Bt; int K; };

struct StaticOrder {
    static constexpr bool GATHER = false;
    int nM, nN, nwg, G, c;
    __device__ void init(int M, int N, int G_, int c_) { nM = M / BM; nN = N / BM; nwg = nM * nN; G = G_; c = c_; }
    __device__ bool next(int i, Unit& u) const {
        const long L = (long)i * G + c; if (L >= nwg) return false;
        int wgid = (int)L; { const int q = nwg / NXCD, r = nwg % NXCD, xcd = wgid % NXCD, off = wgid / NXCD; wgid = (xcd < r ? xcd * (q + 1) : r * (q + 1) + (xcd - r) * q) + off; }
        const int nig = WGM * nN, gid = wgid / nig, fm = gid * WGM, gsz = (nM - fm) < WGM ? (nM - fm) : WGM;
        u.pm = fm + ((wgid % nig) % gsz); u.pn = (wgid % nig) / gsz; u.brow = u.pn * BM; u.e = 0; return true;
    }
};
template <bool GATHER_> struct MoeOrderT {
    static constexpr bool GATHER = GATHER_;
    const int* blk_e; const int* rows; int nblk, nN, nPerE, x, y, ny;
    __device__ bool next(int i, Unit& u) const {
        const int l = i * ny + y, rb = l / nN, pn = l - rb * nN, pm = rb * 8 + x;
        if (pm >= nblk) return false;
        const int e = __builtin_amdgcn_readfirstlane(blk_e[pm]);
        u.pm = pm; u.pn = pn; u.e = e; u.brow = e * nPerE + pn * BM; return true;
    }
};
typedef MoeOrderT<false> MoeOrder;
typedef MoeOrderT<true> MoeOrderG;

__device__ __forceinline__ unsigned cvt_pk_bf16(float lo, float hi) { unsigned r; asm volatile("v_cvt_pk_bf16_f32 %0, %1, %2" : "=v"(r) : "v"(lo), "v"(hi)); return r; }

typedef int v8i __attribute__((ext_vector_type(8)));
typedef int v4i __attribute__((ext_vector_type(4)));
template <class Epi, class Sched, bool ALIGN_EPI, bool SP2, bool FP8 = false>
__device__ __forceinline__ void gemm_phase(LAS unsigned char* lds, const Gemm g, const Sched& S, const Epi& E) {
    constexpr int ESZ = FP8 ? 1 : 2;
    const int tid = opaque_i(threadIdx.x), wid = __builtin_amdgcn_readfirstlane(tid >> 6), lane = tid & 63, wr = wid >> 2, wc = wid & 3, fr = lane & 15, fq = lane >> 4;
    const int K = g.K, nt = (K * ESZ) / 128;
    unsigned voffA[2], voffB[2];
#pragma unroll
    for (int i = 0; i < 2; ++i) { int R, C; stage_rc(tid * 16 + i * 8192, R, C); const int Rb = Epi::PERM ? ((R & ~31) + perm32(R & 31)) : R;
        voffA[i] = (unsigned)(R * K * ESZ + C * 2); voffB[i] = (unsigned)(Rb * K * ESZ + C * 2); }
    const size_t kstep = (size_t)(BK * 2);
    const size_t hstep = (size_t)HALF * K * ESZ;
    const size_t tstep = 2 * hstep;
    const size_t rstep = (size_t)K * ESZ;
    const unsigned ldsw = (unsigned)wid * 1024u;
    const int aoff = lds_byte(wr * 64 + fr, fq * 8), boff = lds_byte(wc * 32 + fr, fq * 8);
#define PG8_SA(b, h) (((b) * 2 + (h)) * HTB)
#define PG8_SB(b, h) ((4 + (b) * 2 + (h)) * HTB)
#define PG8_STAGE(bufoff, gbase, voff) do { _Pragma("unroll") for (int _i = 0; _i < 2; ++_i) \
        __builtin_amdgcn_global_load_lds((const unsigned*)((const char*)(gbase) + (voff)[_i]), (LAS unsigned*)(lds + (bufoff) + ldsw + _i * 8192), 16, 0, 0); } while (0)
#define PG8_LDA(dst, b, h) do { _Pragma("unroll") for (int m = 0; m < 4; ++m) { const v4i lo_ = *(const LAS v4i*)(lds + PG8_SA(b, h) + aoff + m * 2048), hi_ = *(const LAS v4i*)(lds + PG8_SA(b, h) + aoff + m * 2048 + 1024); dst[m] = __builtin_shufflevector(lo_, hi_, 0, 1, 2, 3, 4, 5, 6, 7); } } while (0)
#define PG8_LDB(dst, b, h) do { _Pragma("unroll") for (int n = 0; n < 2; ++n) { const v4i lo_ = *(const LAS v4i*)(lds + PG8_SB(b, h) + boff + n * 2048), hi_ = *(const LAS v4i*)(lds + PG8_SB(b, h) + boff + n * 2048 + 1024); dst[n] = __builtin_shufflevector(lo_, hi_, 0, 1, 2, 3, 4, 5, 6, 7); } } while (0)
#define PG8_MMA(ai, bj, At, Bt) do { __builtin_amdgcn_s_setprio(1); _Pragma("unroll") for (int m = 0; m < 4; ++m) _Pragma("unroll") for (int n = 0; n < 2; ++n) { \
        if constexpr (FP8) asm volatile("v_mfma_scale_f32_16x16x128_f8f6f4 %0, %1, %2, %0, %3, %4 op_sel_hi:[0,0,0]" : "+v"(acc[ai][bj][m][n]) : "v"(Bt[n]), "v"(At[m]), "v"(sclW), "v"(sclX)); \
        else { acc[ai][bj][m][n] = __builtin_amdgcn_mfma_f32_16x16x32_bf16(__builtin_bit_cast(bf16x8, __builtin_shufflevector(Bt[n], Bt[n], 0, 1, 2, 3)), __builtin_bit_cast(bf16x8, __builtin_shufflevector(At[m], At[m], 0, 1, 2, 3)), acc[ai][bj][m][n], 0, 0, 0); \
               acc[ai][bj][m][n] = __builtin_amdgcn_mfma_f32_16x16x32_bf16(__builtin_bit_cast(bf16x8, __builtin_shufflevector(Bt[n], Bt[n], 4, 5, 6, 7)), __builtin_bit_cast(bf16x8, __builtin_shufflevector(At[m], At[m], 4, 5, 6, 7)), acc[ai][bj][m][n], 0, 0, 0); } } __builtin_amdgcn_s_setprio(0); } while (0)
#define PG8_WAIT_V(n) asm volatile("s_waitcnt vmcnt(" #n ")" ::: "memory")
#define PG8_WAIT_L(n) asm volatile("s_waitcnt lgkmcnt(" #n ")" ::: "memory")
#define PG8_BAR __builtin_amdgcn_s_barrier()
#define PG8_SCHED __builtin_amdgcn_sched_barrier(0)
    int sclW = 0x7a7a7a7a, sclX = 0x7f7f7f7f; asm volatile("" : "+v"(sclW), "+v"(sclX));
    Unit cur, nxt; int ui = 0;
    if (!S.next(0, cur)) return;
    unsigned vC[2][2], vN[2][2];
#define PG8_ROWOFFS(dst, pm_) do { if constexpr (Sched::GATHER) { _Pragma("unroll") for (int _h = 0; _h < 2; ++_h) _Pragma("unroll") for (int _i = 0; _i < 2; ++_i) { int R_, C_; stage_rc(tid * 16 + _i * 8192, R_, C_); \
        dst[_h][_i] = (unsigned)(S.rows[(pm_) * BM + _h * HALF + R_] * K * ESZ + C_ * 2); } } } while (0)
#define PG8_STAGE_A(bufoff, plain_ptr, koff, h, nx) do { if constexpr (Sched::GATHER) { _Pragma("unroll") for (int _i = 0; _i < 2; ++_i) { const unsigned vo_ = (nx) ? vN[h][_i] : vC[h][_i]; \
        __builtin_amdgcn_global_load_lds((const unsigned*)((const char*)g.A + (koff) + vo_), (LAS unsigned*)(lds + (bufoff) + ldsw + _i * 8192), 16, 0, 0); } } \
        else { PG8_STAGE(bufoff, plain_ptr, voffA); } } while (0)
    PG8_ROWOFFS(vC, cur.pm);
    f32x4 acc[2][2][4][2];
#pragma unroll
    for (int a = 0; a < 2; ++a)
#pragma unroll
        for (int b = 0; b < 2; ++b)
#pragma unroll
            for (int m = 0; m < 4; ++m)
#pragma unroll
                for (int n = 0; n < 2; ++n) acc[a][b][m][n] = (f32x4){0.f, 0.f, 0.f, 0.f};
    v8i At[4], B0[2], B1[2];
    const char* cA = (const char*)g.A + (size_t)cur.pm * tstep; const char* cB = (const char*)g.Bt + (size_t)cur.brow * rstep;
    if constexpr (SP2) {
        PG8_STAGE(PG8_SB(0, 0), cB, voffB); PG8_STAGE(PG8_SB(0, 1), cB + hstep, voffB); PG8_STAGE_A(PG8_SA(0, 0), cA, 0, 0, false); PG8_STAGE_A(PG8_SA(0, 1), cA + hstep, 0, 1, false);
        if (wr == 1) PG8_BAR;
        PG8_WAIT_V(2); PG8_BAR;
        PG8_STAGE(PG8_SB(1, 0), cB + kstep, voffB); PG8_STAGE_A(PG8_SA(1, 0), cA + kstep, kstep, 0, false); PG8_STAGE(PG8_SB(1, 1), cB + hstep + kstep, voffB);
        PG8_WAIT_V(6); PG8_BAR;
    } else {
        PG8_STAGE(PG8_SB(0, 0), cB, voffB); PG8_STAGE(PG8_SA(0, 0), cA, voffA); PG8_STAGE(PG8_SB(0, 1), cB + hstep, voffB); PG8_STAGE(PG8_SA(0, 1), cA + hstep, voffA);
        if (wr == 1) PG8_BAR;
        PG8_WAIT_V(4); PG8_BAR;
        PG8_STAGE(PG8_SB(1, 0), cB + kstep, voffB); PG8_STAGE(PG8_SA(1, 0), cA + kstep, voffA); PG8_STAGE(PG8_SB(1, 1), cB + hstep + kstep, voffB);
        PG8_WAIT_V(6); PG8_BAR;
    }
    for (;;) {
        const bool has_next = S.next(ui + 1, nxt);
        if constexpr (Sched::GATHER) { if (has_next) { PG8_ROWOFFS(vN, nxt.pm); } else { vN[0][0] = vC[0][0]; vN[0][1] = vC[0][1]; vN[1][0] = vC[1][0]; vN[1][1] = vC[1][1]; } }
        const char* nA = has_next ? (const char*)g.A + (size_t)nxt.pm * tstep : cA; const char* nB = has_next ? (const char*)g.Bt + (size_t)nxt.brow * rstep : cB;
#pragma nounroll
        for (int t = 0; t < nt; t += 2) {
            if constexpr (Epi::MIDK > 0) { if (t == Epi::MIDK) E.mid(acc, cur, wr, wc, fr, fq); }
            const bool last = (t == nt - 2);
            const char* a1 = cA + (size_t)(t + 1) * kstep;
            const char* a2 = last ? nA : cA + (size_t)(t + 2) * kstep; const char* b2 = last ? nB : cB + (size_t)(t + 2) * kstep;
            const char* a3 = a2 + kstep; const char* b3 = b2 + kstep;
            const size_t k1 = (size_t)(t + 1) * kstep, k2 = last ? 0 : (size_t)(t + 2) * kstep;
            if constexpr (SP2) {
            PG8_LDB(B0, 0, 0); PG8_LDB(B1, 0, 1); PG8_SCHED; PG8_LDA(At, 0, 0); PG8_STAGE_A(PG8_SA(1, 1), a1 + hstep, k1, 1, false);
            PG8_WAIT_V(8); PG8_WAIT_L(0); PG8_BAR; PG8_MMA(0, 0, At, B0); PG8_MMA(0, 1, At, B1); PG8_BAR; PG8_SCHED;
            PG8_LDA(At, 0, 1); PG8_STAGE(PG8_SB(0, 0), b2, voffB); PG8_STAGE(PG8_SB(0, 1), b2 + hstep, voffB); PG8_STAGE_A(PG8_SA(0, 0), a2, k2, 0, last);
            PG8_WAIT_V(8); PG8_WAIT_L(0); PG8_BAR; PG8_MMA(1, 0, At, B0); PG8_MMA(1, 1, At, B1); PG8_BAR; PG8_SCHED;
            PG8_LDB(B0, 1, 0); PG8_LDB(B1, 1, 1); PG8_SCHED; PG8_LDA(At, 1, 0); PG8_STAGE_A(PG8_SA(0, 1), a2 + hstep, k2, 1, last);
            PG8_WAIT_V(8); PG8_WAIT_L(0); PG8_BAR; PG8_MMA(0, 0, At, B0); PG8_MMA(0, 1, At, B1); PG8_BAR; PG8_SCHED;
            PG8_LDA(At, 1, 1); PG8_STAGE(PG8_SB(1, 0), b3, voffB); PG8_STAGE(PG8_SB(1, 1), b3 + hstep, voffB); PG8_STAGE_A(PG8_SA(1, 0), a3, k2 + kstep, 0, last);
            PG8_WAIT_V(8); PG8_WAIT_L(0); PG8_BAR; PG8_MMA(1, 0, At, B0); PG8_MMA(1, 1, At, B1); PG8_BAR; PG8_SCHED;
            } else {
            PG8_LDB(B0, 0, 0); PG8_SCHED; PG8_LDA(At, 0, 0); PG8_STAGE(PG8_SA(1, 1), a1 + hstep, voffA);
            PG8_WAIT_L(8); PG8_BAR; PG8_WAIT_L(0); PG8_MMA(0, 0, At, B0); PG8_BAR; PG8_SCHED;
            PG8_LDB(B1, 0, 1); PG8_STAGE(PG8_SB(0, 0), b2, voffB);
            PG8_BAR; PG8_WAIT_L(0); PG8_MMA(0, 1, At, B1); PG8_BAR;
            PG8_LDA(At, 0, 1); PG8_STAGE(PG8_SA(0, 0), a2, voffA);
            PG8_BAR; PG8_WAIT_L(0); PG8_MMA(1, 0, At, B0); PG8_BAR; PG8_SCHED;
            PG8_STAGE(PG8_SB(0, 1), b2 + hstep, voffB);
            PG8_WAIT_V(6); PG8_BAR; PG8_MMA(1, 1, At, B1); PG8_BAR;
            PG8_LDB(B0, 1, 0); PG8_SCHED; PG8_LDA(At, 1, 0); PG8_STAGE(PG8_SA(0, 1), a2 + hstep, voffA);
            PG8_WAIT_L(8); PG8_BAR; PG8_WAIT_L(0); PG8_MMA(0, 0, At, B0); PG8_BAR; PG8_SCHED;
            PG8_LDB(B1, 1, 1); PG8_STAGE(PG8_SB(1, 0), b3, voffB);
            PG8_BAR; PG8_WAIT_L(0); PG8_MMA(0, 1, At, B1); PG8_BAR;
            PG8_LDA(At, 1, 1); PG8_STAGE(PG8_SA(1, 0), a3, voffA);
            PG8_BAR; PG8_WAIT_L(0); PG8_MMA(1, 0, At, B0); PG8_BAR; PG8_SCHED;
            PG8_STAGE(PG8_SB(1, 1), b3 + hstep, voffB);
            PG8_WAIT_V(6); PG8_BAR; PG8_MMA(1, 1, At, B1); PG8_BAR;
            }
        }
        if constexpr (ALIGN_EPI) { if (wr == 0) PG8_BAR; }
        if constexpr (FP8) asm volatile("s_nop 15\n\ts_nop 15" ::: "memory");
        E(acc, cur, wr, wc, fr, fq);
        if (!has_next) break;
#pragma unroll
        for (int a = 0; a < 2; ++a)
#pragma unroll
            for (int b = 0; b < 2; ++b)
#pragma unroll
                for (int m = 0; m < 4; ++m)
#pragma unroll
                    for (int n = 0; n < 2; ++n) acc[a][b][m][n] = (f32x4){0.f, 0.f, 0.f, 0.f};
        cur = nxt; cA = nA; cB = nB; ++ui;
        if constexpr (Sched::GATHER) { vC[0][0] = vN[0][0]; vC[0][1] = vN[0][1]; vC[1][0] = vN[1][0]; vC[1][1] = vN[1][1]; }
        if constexpr (ALIGN_EPI) { if (wr == 1) PG8_BAR; }
    }
    PG8_WAIT_V(0);
    if constexpr (!ALIGN_EPI) { if (wr == 0) PG8_BAR; }
    PG8_BAR;
#undef PG8_SA
#undef PG8_SB
#undef PG8_STAGE
#undef PG8_STAGE_A
#undef PG8_ROWOFFS
#undef PG8_LDA
#undef PG8_LDB
#undef PG8_MMA
#undef PG8_WAIT_V
#undef PG8_WAIT_L
#undef PG8_BAR
#undef PG8_SCHED
}

typedef const f32x4 (&AccRef)[2][2][4][2];
struct EpiProj {
    static constexpr int MIDK = 0;
    static constexpr bool PERM = true;
    bf16* O; float* small; const float* bias; unsigned char* G8; int coloff, smtile, gtile;
    __device__ __forceinline__ void operator()(AccRef acc, const Unit& u, int wr, int wc, int fr, int fq) const {
        const int row0 = u.pm * BM + wr * 64 + fr, col0 = u.pn * BM + wc * 32 + 8 * fq;
        f32x4 bv[2][2];
#pragma unroll
        for (int bj = 0; bj < 2; ++bj)
#pragma unroll
            for (int n = 0; n < 2; ++n) bv[bj][n] = *(const f32x4*)(bias + col0 + bj * HALF + 4 * n);
        const bool sm = (u.pn == smtile) && (wc == 0);
        const bool tog = u.pn >= gtile;
#pragma unroll
        for (int ai = 0; ai < 2; ++ai)
#pragma unroll
            for (int m = 0; m < 4; ++m) { const int row = row0 + ai * HALF + m * 16; bf16* rowp = O + (size_t)row * PP + col0;
                unsigned char* gp = G8 + (size_t)row * GP + (col0 - gtile * BM);
#pragma unroll
                for (int bj = 0; bj < 2; ++bj) { const f32x4 v0 = acc[ai][bj][m][0] + bv[bj][0], v1 = acc[ai][bj][m][1] + bv[bj][1];
                    if (tog) { u32x2 w8; w8.x = pk4_fp8(v0[0], v0[1], v0[2], v0[3]); w8.y = pk4_fp8(v1[0], v1[1], v1[2], v1[3]); *(u32x2*)(gp + bj * HALF) = w8; }
                    else { u32x4 w; w.x = cvt_pk_bf16(v0[0], v0[1]); w.y = cvt_pk_bf16(v0[2], v0[3]); w.z = cvt_pk_bf16(v1[0], v1[1]); w.w = cvt_pk_bf16(v1[2], v1[3]);
                        *(u32x4*)(rowp + bj * HALF) = w; }
                    if (bj == 0 && sm) { *(f32x4*)(small + (size_t)row * 32 + 8 * fq) = v0; *(f32x4*)(small + (size_t)row * 32 + 8 * fq + 4) = v1; } } }
    }
};
struct EpiMix2 {
    static constexpr int MIDK = 8;
    static constexpr bool PERM = true;
    bf16* O; const unsigned char* g8;
    __device__ __forceinline__ void mid(f32x4 (&acc)[2][2][4][2], const Unit& u, int wr, int wc, int fr, int fq) const {
        int z = 0; asm volatile("" : "+v"(z));
        const int row0 = u.pm * BM + wr * 64 + fr + z, col0 = u.pn * BM + wc * 32 + 8 * fq;
#pragma unroll
        for (int ai = 0; ai < 2; ++ai)
#pragma unroll
            for (int m = 0; m < 4; ++m) { const unsigned char* gp = g8 + (size_t)(row0 + ai * HALF + m * 16) * GP + col0;
#pragma unroll
                for (int bj = 0; bj < 2; ++bj) { const u32x2 ga8 = *(const u32x2*)(gp + G_GA + bj * HALF), gb8 = *(const u32x2*)(gp + G_GB + bj * HALF);
                    float fa[8], fb[8]; { const f32x2 a0 = __builtin_amdgcn_cvt_pk_f32_fp8((int)ga8.x, false), a1 = __builtin_amdgcn_cvt_pk_f32_fp8((int)ga8.x, true), a2 = __builtin_amdgcn_cvt_pk_f32_fp8((int)ga8.y, false), a3 = __builtin_amdgcn_cvt_pk_f32_fp8((int)ga8.y, true);
                        const f32x2 b0 = __builtin_amdgcn_cvt_pk_f32_fp8((int)gb8.x, false), b1 = __builtin_amdgcn_cvt_pk_f32_fp8((int)gb8.x, true), b2 = __builtin_amdgcn_cvt_pk_f32_fp8((int)gb8.y, false), b3 = __builtin_amdgcn_cvt_pk_f32_fp8((int)gb8.y, true);
                        fa[0] = a0.x; fa[1] = a0.y; fa[2] = a1.x; fa[3] = a1.y; fa[4] = a2.x; fa[5] = a2.y; fa[6] = a3.x; fa[7] = a3.y; fb[0] = b0.x; fb[1] = b0.y; fb[2] = b1.x; fb[3] = b1.y; fb[4] = b2.x; fb[5] = b2.y; fb[6] = b3.x; fb[7] = b3.y; }
                    float r[8];
#define MIXR(i, av, bv) r[i] = (1.0f + fminf(__expf(-(bv)), 1e20f)) * __builtin_amdgcn_rcpf(1.0f + __expf(-(av)))
                    MIXR(0, fa[0], fb[0]); MIXR(1, fa[1], fb[1]); MIXR(2, fa[2], fb[2]); MIXR(3, fa[3], fb[3]); MIXR(4, fa[4], fb[4]); MIXR(5, fa[5], fb[5]); MIXR(6, fa[6], fb[6]); MIXR(7, fa[7], fb[7]);
#undef MIXR
#pragma unroll
                    for (int j = 0; j < 4; ++j) { acc[ai][bj][m][0][j] *= r[j]; acc[ai][bj][m][1][j] *= r[4 + j]; } }
                __builtin_amdgcn_sched_barrier(0); }
    }
    __device__ __forceinline__ void operator()(AccRef acc, const Unit& u, int wr, int wc, int fr, int fq) const {
        const int row0 = u.pm * BM + wr * 64 + fr, col0 = u.pn * BM + wc * 32 + 8 * fq;
#pragma unroll
        for (int ai = 0; ai < 2; ++ai)
#pragma unroll
            for (int m = 0; m < 4; ++m) { const int row = row0 + ai * HALF + m * 16; bf16* rowp = O + (size_t)row * D + col0;
                const unsigned char* gp = g8 + (size_t)row * GP + G_GB + col0;
#pragma unroll
                for (int bj = 0; bj < 2; ++bj) { const u32x2 gb8 = *(const u32x2*)(gp + bj * HALF);
                    const f32x2 b0 = __builtin_amdgcn_cvt_pk_f32_fp8((int)gb8.x, false), b1 = __builtin_amdgcn_cvt_pk_f32_fp8((int)gb8.x, true), b2 = __builtin_amdgcn_cvt_pk_f32_fp8((int)gb8.y, false), b3 = __builtin_amdgcn_cvt_pk_f32_fp8((int)gb8.y, true);
                    float r[8];
#define MIXG(bv) __builtin_amdgcn_rcpf(1.0f + fminf(__expf(-(bv)), 1e20f))
                    r[0] = MIXG(b0.x) * acc[ai][bj][m][0][0]; r[1] = MIXG(b0.y) * acc[ai][bj][m][0][1]; r[2] = MIXG(b1.x) * acc[ai][bj][m][0][2]; r[3] = MIXG(b1.y) * acc[ai][bj][m][0][3];
                    r[4] = MIXG(b2.x) * acc[ai][bj][m][1][0]; r[5] = MIXG(b2.y) * acc[ai][bj][m][1][1]; r[6] = MIXG(b3.x) * acc[ai][bj][m][1][2]; r[7] = MIXG(b3.y) * acc[ai][bj][m][1][3];
#undef MIXG
                    u32x2 w; w.x = pk4_fp8(r[0], r[1], r[2], r[3]); w.y = pk4_fp8(r[4], r[5], r[6], r[7]);
                    *(u32x2*)((unsigned char*)O + (size_t)row * D + col0 + bj * HALF) = w; } }
    }
};
struct EpiWout {
    static constexpr int MIDK = 0;
    static constexpr bool PERM = true;
    const float* x; bf16* out; const float* gate;
    __device__ __forceinline__ void operator()(AccRef acc, const Unit& u, int wr, int wc, int fr, int fq) const {
        const int row0 = u.pm * BM + wr * 64 + fr, col0 = u.pn * BM + wc * 32 + 8 * fq, b = u.pm >> 3;
        f32x4 gv[2][2];
#pragma unroll
        for (int bj = 0; bj < 2; ++bj)
#pragma unroll
            for (int n = 0; n < 2; ++n) gv[bj][n] = *(const f32x4*)(gate + (size_t)b * 6144 + col0 + bj * HALF + 4 * n);
#pragma unroll
        for (int ai = 0; ai < 2; ++ai)
#pragma unroll
            for (int m = 0; m < 4; ++m) { const size_t off = (size_t)(row0 + ai * HALF + m * 16) * D + col0;
#pragma unroll
                for (int bj = 0; bj < 2; ++bj) { const f32x4 x0 = *(const f32x4*)(x + off + bj * HALF), x1 = *(const f32x4*)(x + off + bj * HALF + 4);
                    const f32x4 v0 = x0 + gv[bj][0] * acc[ai][bj][m][0], v1 = x1 + gv[bj][1] * acc[ai][bj][m][1];
                    u32x4 w; w.x = cvt_pk_bf16(v0[0], v0[1]); w.y = cvt_pk_bf16(v0[2], v0[3]); w.z = cvt_pk_bf16(v1[0], v1[1]); w.w = cvt_pk_bf16(v1[2], v1[3]);
                    *(u32x4*)(out + off + bj * HALF) = w; } }
    }
};
struct EpiNull {
    static constexpr int MIDK = 0;
    static constexpr bool PERM = false;
    float* sink;
    __device__ __forceinline__ void operator()(AccRef acc, const Unit& u, int wr, int wc, int fr, int fq) const {
        f32x4 s = (f32x4){0.f, 0.f, 0.f, 0.f};
#pragma unroll
        for (int ai = 0; ai < 2; ++ai)
#pragma unroll
            for (int bj = 0; bj < 2; ++bj)
#pragma unroll
                for (int m = 0; m < 4; ++m)
#pragma unroll
                    for (int n = 0; n < 2; ++n) s += acc[ai][bj][m][n];
        if (s[0] == 1.2345e30f) sink[0] = s[1] + s[2] + s[3];
    }
};
struct EpiSwiglu {
    static constexpr int MIDK = 0;
    static constexpr bool PERM = true;
    bf16* O; const float* bup;
    __device__ __forceinline__ void operator()(AccRef acc, const Unit& u, int wr, int wc, int fr, int fq) const {
        const int row0 = u.pm * BM + wr * 64 + fr, lc = wc * 32 + 8 * fq, hc = u.pn * HALF + lc;
        const float* bp = bup + (size_t)u.e * 2048 + hc;
        f32x4 bg[2], bl[2];
#pragma unroll
        for (int n = 0; n < 2; ++n) { bg[n] = *(const f32x4*)(bp + 4 * n); bl[n] = *(const f32x4*)(bp + 1024 + 4 * n); }
#pragma unroll
        for (int ai = 0; ai < 2; ++ai)
#pragma unroll
            for (int m = 0; m < 4; ++m) { const int row = row0 + ai * HALF + m * 16;
                float r[8];
#pragma unroll
                for (int n = 0; n < 2; ++n)
#pragma unroll
                    for (int j = 0; j < 4; ++j) { float gg = acc[ai][0][m][n][j] + bg[n][j], ll = acc[ai][1][m][n][j] + bl[n][j];
                        gg = fminf(gg, 7.0f); ll = fminf(fmaxf(ll, -7.0f), 7.0f);
                        r[4 * n + j] = gg * sigmoidf_(1.702f * gg) * (ll + 1.0f); }
                u32x2 w; w.x = pk4_fp8(r[0], r[1], r[2], r[3]); w.y = pk4_fp8(r[4], r[5], r[6], r[7]);
                *(u32x2*)((unsigned char*)O + (size_t)row * D + hc) = w; }
    }
};
struct EpiDown {
    static constexpr int MIDK = 0;
    static constexpr bool PERM = true;
    bf16* O; const float* bdn;
    __device__ __forceinline__ void operator()(AccRef acc, const Unit& u, int wr, int wc, int fr, int fq) const {
        const int row0 = u.pm * BM + wr * 64 + fr, col0 = u.pn * BM + wc * 32 + 8 * fq;
        f32x4 bv[2][2];
#pragma unroll
        for (int bj = 0; bj < 2; ++bj)
#pragma unroll
            for (int n = 0; n < 2; ++n) bv[bj][n] = *(const f32x4*)(bdn + (size_t)u.e * D + col0 + bj * HALF + 4 * n);
#pragma unroll
        for (int ai = 0; ai < 2; ++ai)
#pragma unroll
            for (int m = 0; m < 4; ++m) { bf16* rowp = O + (size_t)(row0 + ai * HALF + m * 16) * D + col0;
#pragma unroll
                for (int bj = 0; bj < 2; ++bj) { const f32x4 v0 = acc[ai][bj][m][0] + bv[bj][0], v1 = acc[ai][bj][m][1] + bv[bj][1];
                    u32x4 w; w.x = cvt_pk_bf16(v0[0], v0[1]); w.y = cvt_pk_bf16(v0[2], v0[3]); w.z = cvt_pk_bf16(v1[0], v1[1]); w.w = cvt_pk_bf16(v1[2], v1[3]);
                    *(u32x4*)(rowp + bj * HALF) = w; } }
    }
};
}

struct Args { const float* in[31]; float* out; unsigned char* ws; };

struct Frame {
    LAS unsigned char* lds;
    unsigned char* ws;
    const float* const* in;
    float* out;
    int tid, lane, wave, G, bid;
};

__device__ __forceinline__ int map_in(int d) {
    if (d < 512) return 1304 + d;
    if (d < 1792) return d - 512;
    if (d < 1816) return 1280 + (d - 1792);
    if (d < 1824) return 2328 + (d - 1816);
    if (d < 2048) return -1;
    if (d < 2560) return 1816 + (d - 2048);
    return 2336 + (d - 2560);
}
__device__ __forceinline__ int map_up(int r) { return ((r >> 7) & 1) * 1024 + (r >> 8) * 128 + (r & 127); }

template <int MAP>
__device__ __forceinline__ void transpose_item(const float* W, int ldw, int K, bf16* WT, int nblk, int item, LAS float* scr, int lane, int ldt = 0) {
    if (ldt == 0) ldt = K;
    const int kb = item / nblk, nb = item - kb * nblk, k0 = 64 * kb, n0 = 32 * nb;
    const int r = lane >> 3, c4 = (lane & 7) * 4, nd = n0 + c4;
    const int sc = MAP == 0 ? nd : (MAP == 1 ? map_in(nd) : map_up(nd));
    f32x4 v[8];
#pragma unroll
    for (int i = 0; i < 8; ++i) v[i] = sc >= 0 ? *(const f32x4*)(W + (size_t)(k0 + 8 * i + r) * ldw + sc) : (f32x4){0.f, 0.f, 0.f, 0.f};
#pragma unroll
    for (int i = 0; i < 8; ++i) { LAS float* p = scr + (8 * i + r) * 33 + c4; p[0] = v[i].x; p[1] = v[i].y; p[2] = v[i].z; p[3] = v[i].w; }
    LDS_WAIT();
    const int c = lane & 7;
#pragma unroll
    for (int j = 0; j < 4; ++j) { const int n = (lane >> 3) + 8 * j; const LAS float* s = scr + (8 * c) * 33 + n;
        u32x4 o; o.x = pk2(s[0 * 33], s[1 * 33]); o.y = pk2(s[2 * 33], s[3 * 33]); o.z = pk2(s[4 * 33], s[5 * 33]); o.w = pk2(s[6 * 33], s[7 * 33]);
        *(u32x4*)(WT + (size_t)(n0 + n) * ldt + k0 + 8 * c) = o; }
    LDS_WAIT();
}

template <int MAP>
__device__ __forceinline__ void transpose_item8(const float* W, int ldw, int K, unsigned char* WT, int nblk, int item, LAS float* scr, int lane) {
    const int kb = item / nblk, nb = item - kb * nblk, k0 = 64 * kb, n0 = 32 * nb;
    const int r = lane >> 3, c4 = (lane & 7) * 4, nd = n0 + c4;
    const int sc = MAP == 0 ? nd : (MAP == 1 ? map_in(nd) : map_up(nd));
    f32x4 v[8];
#pragma unroll
    for (int i = 0; i < 8; ++i) v[i] = sc >= 0 ? *(const f32x4*)(W + (size_t)(k0 + 8 * i + r) * ldw + sc) : (f32x4){0.f, 0.f, 0.f, 0.f};
#pragma unroll
    for (int i = 0; i < 8; ++i) { LAS float* p = scr + (8 * i + r) * 33 + c4; p[0] = v[i].x; p[1] = v[i].y; p[2] = v[i].z; p[3] = v[i].w; }
    LDS_WAIT();
    const int c = lane & 7;
#pragma unroll
    for (int j = 0; j < 4; ++j) { const int n = (lane >> 3) + 8 * j; const LAS float* s = scr + (8 * c) * 33 + n;
        u32x2 o; o.x = pk4_fp8(32.f * s[0 * 33], 32.f * s[1 * 33], 32.f * s[2 * 33], 32.f * s[3 * 33]); o.y = pk4_fp8(32.f * s[4 * 33], 32.f * s[5 * 33], 32.f * s[6 * 33], 32.f * s[7 * 33]);
        *(u32x2*)(WT + (size_t)(n0 + n) * K + k0 + 8 * c) = o; }
    LDS_WAIT();
}

__device__ __forceinline__ void p0_adaln(Frame& F) {
    const float* c = F.in[1]; const float* ada_w = F.in[2];
    float* modp = (float*)(F.ws + WS_MODP);
    LAS float* sl = (LAS float*)F.lds;
    for (int u = F.bid; u < 192; u += F.G) {
        const int ks = u / 12, cc = u - ks * 12, j = cc * 512 + F.tid;
        __syncthreads();
        for (int i = F.tid; i < 1024; i += NTHREADS) { const int b = i >> 6, kk = i & 63; const float v = c[b * 1024 + ks * 64 + kk]; sl[i] = v / (1.0f + __expf(-v)); }
        __syncthreads();
        float acc[16];
#pragma unroll
        for (int b = 0; b < 16; ++b) acc[b] = 0.f;
#pragma unroll 16
        for (int kk = 0; kk < 64; ++kk) { const float w = ada_w[(size_t)(ks * 64 + kk) * 6144 + j];
#pragma unroll
            for (int b = 0; b < 16; ++b) acc[b] += sl[b * 64 + kk] * w; }
#pragma unroll
        for (int b = 0; b < 16; ++b) modp[(size_t)(ks * 16 + b) * 6144 + j] = acc[b];
    }
}

__device__ __forceinline__ void p0_cpe(Frame& F) {
    float* cpe = (float*)(F.ws + WS_CPE);
    LAS float* red = (LAS float*)F.lds;
    for (int u = F.bid - 192; u >= 0 && u < 64; u += F.G) {
        const int kv = u >> 5, e0 = (u & 31) * 4, eo = F.tid & 3, kk = F.tid >> 2;
        const float* pe = F.in[kv ? 10 : 7]; const float* w1 = F.in[kv ? 11 : 8];
        float s = 0.f;
#pragma unroll
        for (int m = 0; m < 16; ++m) { const int k = kk + 128 * m; s += pe[k] * w1[(size_t)k * 128 + e0 + eo]; }
        __syncthreads();
        red[F.tid] = s;
        __syncthreads();
        if (F.tid < 4) { float t = 0.f; for (int i = 0; i < 128; ++i) t += red[i * 4 + F.tid]; cpe[kv * 128 + e0 + F.tid] = t; }
    }
}

__device__ __forceinline__ void p1_prologue(Frame& F) {
    const float* modp = (const float*)(F.ws + WS_MODP);
    float* mod = (float*)(F.ws + WS_MOD);
    const int gtid = F.bid * NTHREADS + F.tid, gsz = F.G * NTHREADS;
    for (int i = gtid; i < 16 * 6144; i += gsz) { float s = F.in[3][i % 6144];
        for (int ks = 0; ks < 16; ++ks) s += modp[(size_t)ks * 16 * 6144 + i];
        mod[i] = s; }
    { float* bin = (float*)(F.ws + WS_BIN);
      for (int i = gtid; i < NPROJ; i += gsz) { const int sc = map_in(i); bin[i] = sc >= 0 ? F.in[6][sc] : 0.f; } }
    { bf16* rwt = (bf16*)(F.ws + WS_RWT);
      for (int i = gtid; i < 32 * 1024; i += gsz) { const int e = i >> 10, d = i & 1023; const float wv = F.in[24][d * 32 + e]; const unsigned hi = f2bf(wv);
          rwt[i] = (bf16)hi; rwt[32 * 1024 + i] = (bf16)f2bf(wv - __builtin_bit_cast(float, hi << 16)); } }
    {
        const float* x = F.in[0]; const float* g1 = F.in[4]; bf16* xn = (bf16*)(F.ws + WS_XN);
        LAS float* sm = (LAS float*)F.lds;
        for (int rb = F.bid; rb < T / 128; rb += F.G) {
            const int b = rb >> 4;
            __syncthreads();
            for (int i = F.tid; i < 2048; i += NTHREADS) { float s = F.in[3][i];
                for (int ks = 0; ks < 16; ++ks) s += modp[(size_t)(ks * 16 + b) * 6144 + i];
                sm[i] = s; }
            __syncthreads();
            for (int r = 0; r < 16; ++r) {
                const int row = rb * 128 + F.wave * 16 + r;
                const f32x4* xr = (const f32x4*)(x + (size_t)row * D) + F.lane;
                f32x4 v[4]; float ss = 0.f;
#pragma unroll
                for (int j = 0; j < 4; ++j) { v[j] = xr[64 * j]; ss += v[j].x * v[j].x + v[j].y * v[j].y + v[j].z * v[j].z + v[j].w * v[j].w; }
                const float rs = rsqrtf(wave_sum(ss) * (1.0f / D) + 1e-5f);
                unsigned* o4 = (unsigned*)(F.ws + WS_OY + (size_t)row * D) + F.lane; u32x2* o8 = (u32x2*)(xn + (size_t)row * D) + F.lane;
#pragma unroll
                for (int j = 0; j < 4; ++j) { const int d0 = (64 * j + F.lane) * 4; const f32x4 gg = *(const f32x4*)(g1 + d0);
                    float y[4];
#pragma unroll
                    for (int i = 0; i < 4; ++i) y[i] = v[j][i] * rs * gg[i] * (1.0f + sm[1024 + d0 + i]) + sm[d0 + i];
                    o4[64 * j] = pk4_fp8(y[0], y[1], y[2], y[3]); u32x2 w; w.x = pk2(y[0], y[1]); w.y = pk2(y[2], y[3]); o8[64 * j] = w; }
            }
        }
    }
    __syncthreads();
    {
        LAS float* scr = (LAS float*)(F.lds + F.wave * 16384);
        const int gw = F.bid * NWAVES + F.wave, NGW = F.G * NWAVES;
        constexpr int I_IN = 16 * 144, I_PA = 8 * 32, I_WO = 16 * 32, I_UP1 = 16 * 64, I_DN1 = 16 * 32;
        constexpr int I_C1 = 32 * 4, I_C2 = 2 * 2, I_ML = 2 * 4;
        constexpr int NITEMS = I_IN + 2 * I_PA + I_WO + 2 * I_C1 + 2 * I_C2 + 12 * I_ML;
        for (int it = gw; it < NITEMS; it += NGW) {
            int r = it;
            if (r < I_IN) { const int nb = r % 144;
                if (nb < 16) transpose_item<1>(F.in[5], IN_W, 1024, (bf16*)(F.ws + WS_WIN), 144, r, scr, F.lane);
                else transpose_item8<1>(F.in[5], IN_W, 1024, (unsigned char*)(F.ws + WS_WIN + 4 * MiB) - (size_t)512 * 1024, 144, r, scr, F.lane);
                continue; } r -= I_IN;
            if (r < I_PA) { transpose_item<0>(F.in[20], 1024, 512, (bf16*)(F.ws + WS_WPA), 32, r, scr, F.lane, 1024); continue; } r -= I_PA;
            if (r < I_PA) { transpose_item<0>(F.in[21], 1024, 512, (bf16*)(F.ws + WS_WPA) + 512, 32, r, scr, F.lane, 1024); continue; } r -= I_PA;
            if (r < I_WO) { transpose_item8<0>(F.in[22], 1024, 1024, (unsigned char*)(F.ws + WS_WOUT), 32, r, scr, F.lane); continue; } r -= I_WO;
            if (r < 2 * I_C1) { const int kv = r / I_C1; transpose_item<0>(F.in[kv ? 11 : 8], 128, 2048, (bf16*)(F.ws + WS_W1T) + (size_t)kv * 128 * 2048, 4, r - kv * I_C1, scr, F.lane); continue; } r -= 2 * I_C1;
            if (r < 2 * I_C2) { const int kv = r / I_C2; transpose_item<0>(F.in[kv ? 12 : 9], 64, 128, (bf16*)(F.ws + WS_W2T) + (size_t)kv * 64 * 128, 2, r - kv * I_C2, scr, F.lane); continue; } r -= 2 * I_C2;
            { const int mh = r / I_ML, mat = mh >> 2; transpose_item<0>(F.in[15 + mat] + (size_t)(mh & 3) * 16384, 128, 128, (bf16*)(F.ws + WS_WQT) + (size_t)mh * 16384, 4, r - mh * I_ML, scr, F.lane); }
        }
    }
}

struct AttnState { float q[64]; float o[64]; float m, l; };
__device__ __forceinline__ void attn_init(AttnState& st, const bf16* qp) {
#pragma unroll
    for (int i = 0; i < 8; ++i) { const u32x4 w = *(const u32x4*)(qp + 8 * i);
        st.q[8 * i + 0] = bflo(w.x) * 0.125f; st.q[8 * i + 1] = bfhi(w.x) * 0.125f; st.q[8 * i + 2] = bflo(w.y) * 0.125f; st.q[8 * i + 3] = bfhi(w.y) * 0.125f;
        st.q[8 * i + 4] = bflo(w.z) * 0.125f; st.q[8 * i + 5] = bfhi(w.z) * 0.125f; st.q[8 * i + 6] = bflo(w.w) * 0.125f; st.q[8 * i + 7] = bfhi(w.w) * 0.125f; }
#pragma unroll
    for (int d = 0; d < 64; ++d) st.o[d] = 0.f;
    st.m = -1e30f; st.l = 0.f;
}
__device__ __forceinline__ float dot_bf16row(const float (&q)[64], const bf16* kp) {
    float s0 = 0.f, s1 = 0.f;
#pragma unroll
    for (int i = 0; i < 8; ++i) { const u32x4 w = *(const u32x4*)(kp + 8 * i);
        s0 += q[8 * i + 0] * bflo(w.x); s1 += q[8 * i + 1] * bfhi(w.x); s0 += q[8 * i + 2] * bflo(w.y); s1 += q[8 * i + 3] * bfhi(w.y);
        s0 += q[8 * i + 4] * bflo(w.z); s1 += q[8 * i + 5] * bfhi(w.z); s0 += q[8 * i + 6] * bflo(w.w); s1 += q[8 * i + 7] * bfhi(w.w); }
    return s0 + s1;
}
__device__ __forceinline__ void attn_key_bf16(AttnState& st, float sc, bool valid, const bf16* vp) {
    const bool need = valid && (sc > st.m + 8.0f);
    if (__any(need)) { if (need) { const float a = __expf(st.m - sc); st.l *= a;
#pragma unroll
            for (int d = 0; d < 64; ++d) st.o[d] *= a;
            st.m = sc; } }
    const float p = valid ? __expf(sc - st.m) : 0.f;
    st.l += p;
#pragma unroll
    for (int i = 0; i < 8; ++i) { const u32x4 w = *(const u32x4*)(vp + 8 * i);
        st.o[8 * i + 0] += p * bflo(w.x); st.o[8 * i + 1] += p * bfhi(w.x); st.o[8 * i + 2] += p * bflo(w.y); st.o[8 * i + 3] += p * bfhi(w.y);
        st.o[8 * i + 4] += p * bflo(w.z); st.o[8 * i + 5] += p * bfhi(w.z); st.o[8 * i + 6] += p * bflo(w.w); st.o[8 * i + 7] += p * bfhi(w.w); }
}

__device__ __forceinline__ float gelu_tanh(float x) { const float u = 0.7978845608f * (x + 0.044715f * x * x * x); const float t = 1.0f - 2.0f / (__expf(2.0f * u) + 1.0f); return 0.5f * x * (1.0f + t); }

__device__ __forceinline__ void p3_compress(Frame& F) {
    const bf16* proj = (const bf16*)(F.ws + WS_PROJ); const bf16* w1t = (const bf16*)(F.ws + WS_W1T); const bf16* w2t = (const bf16*)(F.ws + WS_W2T);
    const float* cpe = (const float*)(F.ws + WS_CPE); bf16* kcb = (bf16*)(F.ws + WS_KCB);
    const int lane = F.lane, w = F.wave, c = lane & 15, g4 = lane >> 4, nt2 = w >> 2, sl = w & 3;
    LAS f32x4* part = (LAS f32x4*)F.lds;
    for (int bu = F.bid; bu < 256; bu += F.G) {
        const int wu = bu * 2 + nt2;
        const int kv = wu >> 8, b = (wu >> 4) & 15, g = (wu >> 3) & 1, n0 = (wu & 7) * 16;
        const int n = n0 + c, nn = n > 126 ? 126 : n;
        const bf16* xb = proj + (size_t)(b * S + 16 * nn) * PP + (kv ? C_VCMP : C_KCMP) + g * 64 + 8 * g4;
        const bf16* wb = w1t + (size_t)kv * 128 * 2048 + (size_t)c * 2048 + 8 * g4;
        f32x4 acc[8];
#pragma unroll
        for (int et = 0; et < 8; ++et) acc[et] = (f32x4){0.f, 0.f, 0.f, 0.f};
#pragma unroll 2
        for (int k2 = 0; k2 < 16; ++k2) { const int ks = 16 * sl + k2;
            const bf16x8 xf = *(const bf16x8*)(xb + (size_t)(ks >> 1) * PP + 32 * (ks & 1));
#pragma unroll
            for (int et = 0; et < 8; ++et) { const bf16x8 wf = *(const bf16x8*)(wb + (size_t)et * 16 * 2048 + 32 * ks); acc[et] = __builtin_amdgcn_mfma_f32_16x16x32_bf16(wf, xf, acc[et], 0, 0, 0); }
        }
        __syncthreads();
        if (sl != 0) {
#pragma unroll
            for (int et = 0; et < 8; ++et) part[((nt2 * 3 + (sl - 1)) * 8 + et) * 64 + lane] = acc[et]; }
        __syncthreads();
        if (sl == 0) {
#pragma unroll
            for (int et = 0; et < 8; ++et) { const f32x4 cp = *(const f32x4*)(cpe + kv * 128 + 16 * et + 4 * g4);
                const f32x4 s = acc[et] + part[((nt2 * 3 + 0) * 8 + et) * 64 + lane] + part[((nt2 * 3 + 1) * 8 + et) * 64 + lane] + part[((nt2 * 3 + 2) * 8 + et) * 64 + lane];
#pragma unroll
                for (int i = 0; i < 4; ++i) acc[et][i] = gelu_tanh(s[i] + cp[i]); }
            f32x4 o2[4];
#pragma unroll
            for (int dt = 0; dt < 4; ++dt) o2[dt] = (f32x4){0.f, 0.f, 0.f, 0.f};
#pragma unroll
            for (int ss = 0; ss < 4; ++ss) {
                u32x4 hw; hw.x = pk2(acc[2 * ss][0], acc[2 * ss][1]); hw.y = pk2(acc[2 * ss][2], acc[2 * ss][3]); hw.z = pk2(acc[2 * ss + 1][0], acc[2 * ss + 1][1]); hw.w = pk2(acc[2 * ss + 1][2], acc[2 * ss + 1][3]);
                const bf16x8 hf = __builtin_bit_cast(bf16x8, hw);
#pragma unroll
                for (int dt = 0; dt < 4; ++dt) { const bf16* wp = w2t + (size_t)kv * 64 * 128 + (size_t)(16 * dt + c) * 128 + 32 * ss + 4 * g4;
                    const u32x2 lo = *(const u32x2*)wp, hi = *(const u32x2*)(wp + 16);
                    const u32x4 ww = (u32x4){lo.x, lo.y, hi.x, hi.y};
                    o2[dt] = __builtin_amdgcn_mfma_f32_16x16x32_bf16(__builtin_bit_cast(bf16x8, ww), hf, o2[dt], 0, 0, 0); }
            }
            bf16* op = kcb + ((((size_t)kv * 16 + b) * 2 + g) * 128 + n) * 64 + 4 * g4;
#pragma unroll
            for (int dt = 0; dt < 4; ++dt) { u32x2 w2; w2.x = pk2(o2[dt][0], o2[dt][1]); w2.y = pk2(o2[dt][2], o2[dt][3]); if (n > 126) { w2.x = 0u; w2.y = 0u; } *(u32x2*)(op + 16 * dt) = w2; }
        }
    }
}

__device__ __forceinline__ void p4_cmpsel(Frame& F) {
    constexpr float LOG2E = 1.4426950408889634f;
    const bf16* proj = (const bf16*)(F.ws + WS_PROJ); const float* small = (const float*)(F.ws + WS_SMALL); float* oacc = (float*)(F.ws + WS_OACC);
    const bf16* kcb = (const bf16*)(F.ws + WS_KCB); const bf16* vcb = kcb + (size_t)16 * 2 * 128 * 64;
    unsigned* selm = (unsigned*)(F.ws + WS_SELM);
    LAS unsigned char* L = F.lds;
    LAS float* scA = (LAS float*)(F.lds + 32768); LAS float* scB = (LAS float*)(F.lds + 40960);
    const int lane = F.lane, w = F.wave, c = lane & 15, g4 = lane >> 4;
    const int pr = 8 * ((c >> 2) & 1) + 4 * (c >> 3) + (c & 3), k7 = pr & 7;
    int kof[2]; kof[0] = pr * 128 + (((0 + g4) ^ k7) << 4); kof[1] = pr * 128 + (((4 + g4) ^ k7) << 4);
    const int q4 = c >> 2, p4 = c & 3, xr = 2 * (g4 & 1) + (g4 >> 1);
    const int vb = 1024 * (g4 & 1) + 64 * (4 * (g4 >> 1) + q4) + 8 * (p4 & 1);
    int vx[2]; vx[0] = 16 * ((0 + (p4 >> 1)) ^ xr); vx[1] = 16 * ((2 + (p4 >> 1)) ^ xr);
    const int kbl = 8 * (g4 & 1) + 4 * (g4 >> 1);
    const int skey = F.tid >> 3, sch = F.tid & 7;
    const int kst = skey * 128 + ((sch ^ (skey & 7)) << 4);
    const int vst = 16384 + 1024 * (skey >> 3) + 512 * (sch >> 2) + 64 * (skey & 7) + 16 * ((sch & 3) ^ ((skey >> 2) & 3));
    for (int unit = F.bid; unit < 1024; unit += F.G) {
        const int qb = 31 - (unit >> 5), b = (unit & 31) >> 1, g = unit & 1, t0 = qb * 64;
        const int ntile = qb >= 16 ? 2 : 1;
        __syncthreads();
        for (int tl = 0; tl < ntile; ++tl) { const bf16* sp = kcb + ((size_t)(b * 2 + g) * 128 + 64 * tl + skey) * 64 + sch * 8;
            *(LAS u32x4*)(L + tl * 8192 + kst) = *(const u32x4*)sp; *(LAS u32x4*)(L + tl * 8192 + vst) = *(const u32x4*)(sp + (vcb - kcb)); }
        __syncthreads();
        const int hq = 4 * g + (c & 3);
        const float slope2 = exp2f(-(float)(hq + 1)) * LOG2E;
#pragma unroll
        for (int nt = 0; nt < 2; ++nt) {
            const int tlq = 8 * w + 4 * nt + (c >> 2), tq = t0 + tlq;
            const bf16* qp = proj + (size_t)(b * S + tq) * PP + C_Q + hq * 64 + 8 * g4;
            bf16x8 qf[2];
#pragma unroll
            for (int ks = 0; ks < 2; ++ks) { const u32x4 v = *(const u32x4*)(qp + 32 * ks); u32x4 o;
                o.x = pk2(bflo(v.x) * 0.125f, bfhi(v.x) * 0.125f); o.y = pk2(bflo(v.y) * 0.125f, bfhi(v.y) * 0.125f); o.z = pk2(bflo(v.z) * 0.125f, bfhi(v.z) * 0.125f); o.w = pk2(bflo(v.w) * 0.125f, bfhi(v.w) * 0.125f);
                qf[ks] = __builtin_bit_cast(bf16x8, o); }
            float sc[2][4][4]; float tmax = -1e30f;
            const int nvalid = tq >= 31 ? ((tq - 31) >> 4) + 1 : 0;
#pragma unroll
            for (int tl = 0; tl < 2; ++tl) {
                if (tl < ntile) {
                    f32x4 sa[4];
#pragma unroll
                    for (int mt = 0; mt < 4; ++mt) sa[mt] = (f32x4){0.f, 0.f, 0.f, 0.f};
#pragma unroll
                    for (int ks = 0; ks < 2; ++ks)
#pragma unroll
                        for (int mt = 0; mt < 4; ++mt) { const bf16x8 kf = *(const LAS bf16x8*)(L + tl * 8192 + mt * 2048 + kof[ks]); sa[mt] = __builtin_amdgcn_mfma_f32_16x16x32_bf16(kf, qf[ks], sa[mt], 0, 0, 0); }
#pragma unroll
                    for (int mt = 0; mt < 4; ++mt)
#pragma unroll
                        for (int i = 0; i < 4; ++i) { const int n = 64 * tl + 16 * mt + kbl + i;
                            const float v = n < nvalid ? sa[mt][i] * LOG2E - slope2 * ((float)(tq - 16 * n) - 15.5f) : -1e30f; sc[tl][mt][i] = v; tmax = fmaxf(tmax, v); }
                } else {
#pragma unroll
                    for (int mt = 0; mt < 4; ++mt)
#pragma unroll
                        for (int i = 0; i < 4; ++i) sc[tl][mt][i] = -1e30f;
                }
            }
            tmax = fmaxf(tmax, __shfl_xor(tmax, 16)); tmax = fmaxf(tmax, __shfl_xor(tmax, 32));
            float ls = 0.f;
#pragma unroll
            for (int tl = 0; tl < 2; ++tl)
#pragma unroll
                for (int mt = 0; mt < 4; ++mt)
#pragma unroll
                    for (int i = 0; i < 4; ++i) { const float p = sc[tl][mt][i] > -1e29f ? __builtin_amdgcn_exp2f(sc[tl][mt][i] - tmax) : 0.f; sc[tl][mt][i] = p; ls += p; }
            ls += __shfl_xor(ls, 16); ls += __shfl_xor(ls, 32);
            const float inv = ls > 0.f ? 1.0f / ls : 0.f;
            f32x4 o[4];
#pragma unroll
            for (int dt = 0; dt < 4; ++dt) o[dt] = (f32x4){0.f, 0.f, 0.f, 0.f};
#pragma unroll
            for (int tl = 0; tl < 2; ++tl) {
                if (tl < ntile) {
#pragma unroll
                    for (int mt = 0; mt < 4; ++mt) {
#pragma unroll
                        for (int i = 0; i < 4; ++i) sc[tl][mt][i] *= inv;
                        float a = sc[tl][mt][0] + sc[tl][mt][1] + sc[tl][mt][2] + 0.5f * sc[tl][mt][3], bb = 0.5f * sc[tl][mt][3];
                        a += __shfl_xor(a, 1); a += __shfl_xor(a, 2); bb += __shfl_xor(bb, 1); bb += __shfl_xor(bb, 2);
                        if ((c & 3) == 0) { const int j = 16 * tl + 4 * mt + 2 * (g4 & 1) + (g4 >> 1); scA[tlq * 32 + j] = a; scB[tlq * 32 + j] = bb; }
                    }
#pragma unroll
                    for (int s = 0; s < 2; ++s) { u32x4 pw; pw.x = pk2(sc[tl][2 * s][0], sc[tl][2 * s][1]); pw.y = pk2(sc[tl][2 * s][2], sc[tl][2 * s][3]); pw.z = pk2(sc[tl][2 * s + 1][0], sc[tl][2 * s + 1][1]); pw.w = pk2(sc[tl][2 * s + 1][2], sc[tl][2 * s + 1][3]);
                        const bf16x8 pf = __builtin_bit_cast(bf16x8, pw);
#pragma unroll
                        for (int dt = 0; dt < 4; ++dt) { const LAS unsigned char* vp = L + 16384 + tl * 8192 + vb + 4096 * s + 512 * (dt >> 1) + vx[dt & 1];
                            const s16x4 lo = __builtin_bit_cast(s16x4, __builtin_amdgcn_ds_read_tr16_b64_v4i16((LAS s16x4*)vp));
                            const s16x4 hi = __builtin_bit_cast(s16x4, __builtin_amdgcn_ds_read_tr16_b64_v4i16((LAS s16x4*)(vp + 2048)));
                            const bf16x8 vf = (bf16x8){lo[0], lo[1], lo[2], lo[3], hi[0], hi[1], hi[2], hi[3]};
                            o[dt] = __builtin_amdgcn_mfma_f32_16x16x32_bf16(vf, pf, o[dt], 0, 0, 0); } }
                }
            }
            const size_t tok = (size_t)(b * S + tq);
            const float sg = sigmoidf_(small[tok * 32 + hq]);
#pragma unroll
            for (int dt = 0; dt < 4; ++dt) *(f32x4*)(oacc + tok * 512 + hq * 64 + 16 * dt + 4 * g4) = o[dt] * sg;
        }
        __syncthreads();
        if (F.tid < 64) { const int tlq = F.tid, t = t0 + tlq, cur = qb; unsigned mask;
            if (cur < 8) mask = (1u << (cur + 1)) - 1u;
            else { mask = 1u | (1u << cur);
                float sv[31];
#pragma unroll
                for (int j = 1; j < 31; ++j) sv[j] = j < cur ? scA[tlq * 32 + j] + scB[tlq * 32 + j - 1] : -1.0f;
#pragma unroll
                for (int it = 0; it < 6; ++it) { float best = -1.0f; int bj = 0;
#pragma unroll
                    for (int j = 1; j < 31; ++j) { const bool ok = sv[j] > best; best = ok ? sv[j] : best; bj = ok ? j : bj; }
                    mask |= 1u << bj;
#pragma unroll
                    for (int j = 1; j < 31; ++j) sv[j] = (j == bj) ? -1.0f : sv[j]; }
                mask &= ~1u; mask |= 1u; }
            selm[(size_t)(b * 2 + g) * S + t] = mask; }
    }
}

struct AttnW { f32x4 o[2][4]; float m[2], l[2]; };
template <int PHASE>
__device__ __forceinline__ void attn_tile(const bool EDGE, AttnW& st, const LAS unsigned char* Kb, const LAS unsigned char* Vb, const LAS bf16x8* qfl, const int (&kof)[2], int vb, const int (&vx)[2],
                                          int kt, int kbl, int t0, const int (&tq)[2], const unsigned (&smask)[2], float slope2) {
    f32x4 bias[4];
    { const float tbs = slope2 * (float)(64 * kt + kbl - t0 - 63);
#pragma unroll
      for (int mt = 0; mt < 4; ++mt)
#pragma unroll
          for (int i = 0; i < 4; ++i) bias[mt][i] = __builtin_fmaf(slope2, (float)(16 * mt + i), tbs); }
    bool selb[2], act[2];
#pragma unroll
    for (int nt = 0; nt < 2; ++nt) { selb[nt] = PHASE == 0 ? true : ((smask[nt] >> kt) & 1u); act[nt] = PHASE == 0 ? true : (bool)__any(selb[nt]); }
    f32x4 sa[2][4];
#pragma unroll
    for (int nt = 0; nt < 2; ++nt) {
        if (!act[nt]) continue;
#pragma unroll
        for (int mt = 0; mt < 4; ++mt) sa[nt][mt] = bias[mt];
#pragma unroll
        for (int ks = 0; ks < 2; ++ks)
#pragma unroll
            for (int mt = 0; mt < 4; ++mt) { const bf16x8 kf = *(const LAS bf16x8*)(Kb + mt * 2048 + kof[ks]); sa[nt][mt] = __builtin_amdgcn_mfma_f32_16x16x32_bf16(kf, qfl[(nt * 2 + ks) * 64], sa[nt][mt], 0, 0, 0); }
    }
#pragma unroll
    for (int nt = 0; nt < 2; ++nt) {
        if (!act[nt]) continue;
        if (EDGE) { const int dbase = tq[nt] - 64 * kt - kbl;
#pragma unroll
            for (int mt = 0; mt < 4; ++mt)
#pragma unroll
                for (int i = 0; i < 4; ++i) { const int dist = dbase - (16 * mt + i); const bool valid = PHASE == 0 ? (dist >= 0 && dist < 256) : (dist >= 0); sa[nt][mt][i] = valid ? sa[nt][mt][i] : -1e30f; } }
        float tmax = fmaxf(fmaxf(sa[nt][0][0], sa[nt][0][1]), sa[nt][0][2]);
#pragma unroll
        for (int mt = 0; mt < 4; ++mt) { if (mt > 0) tmax = fmaxf(fmaxf(tmax, sa[nt][mt][0]), sa[nt][mt][1]), tmax = fmaxf(tmax, sa[nt][mt][2]); tmax = fmaxf(tmax, sa[nt][mt][3]); }
        if (PHASE == 1) tmax = selb[nt] ? tmax : -1e30f;
        tmax = fmaxf(tmax, __shfl_xor(tmax, 16)); tmax = fmaxf(tmax, __shfl_xor(tmax, 32));
        float mn = st.m[nt];
        if (__any(tmax > mn)) { mn = fmaxf(mn, tmax); const float alpha = __builtin_amdgcn_exp2f(st.m[nt] - mn); st.m[nt] = mn; st.l[nt] *= alpha;
#pragma unroll
            for (int dt = 0; dt < 4; ++dt) st.o[nt][dt] *= alpha; }
        if (PHASE == 1) mn = selb[nt] ? mn : 3.0e38f;
        float ls = 0.f;
#pragma unroll
        for (int mt = 0; mt < 4; ++mt)
#pragma unroll
            for (int i = 0; i < 4; ++i) { const float p = __builtin_amdgcn_exp2f(sa[nt][mt][i] - mn); sa[nt][mt][i] = p; ls += p; }
        st.l[nt] += ls;
        bf16x8 pf[2];
#pragma unroll
        for (int s = 0; s < 2; ++s) { u32x4 w; w.x = pk2(sa[nt][2 * s][0], sa[nt][2 * s][1]); w.y = pk2(sa[nt][2 * s][2], sa[nt][2 * s][3]); w.z = pk2(sa[nt][2 * s + 1][0], sa[nt][2 * s + 1][1]); w.w = pk2(sa[nt][2 * s + 1][2], sa[nt][2 * s + 1][3]);
            pf[s] = __builtin_bit_cast(bf16x8, w); }
#pragma unroll
        for (int dt = 0; dt < 4; ++dt)
#pragma unroll
            for (int s = 0; s < 2; ++s) { const LAS unsigned char* vp = Vb + vb + 4096 * s + 512 * (dt >> 1) + vx[dt & 1];
                const s16x4 lo = __builtin_bit_cast(s16x4, __builtin_amdgcn_ds_read_tr16_b64_v4i16((LAS s16x4*)vp));
                const s16x4 hi = __builtin_bit_cast(s16x4, __builtin_amdgcn_ds_read_tr16_b64_v4i16((LAS s16x4*)(vp + 2048)));
                const bf16x8 vf = (bf16x8){lo[0], lo[1], lo[2], lo[3], hi[0], hi[1], hi[2], hi[3]};
                st.o[nt][dt] = __builtin_amdgcn_mfma_f32_16x16x32_bf16(vf, pf[s], st.o[nt][dt], 0, 0, 0); }
    }
}

__device__ __forceinline__ void p5_attn(Frame& F, int qslot) {
    constexpr float LOG2E = 1.4426950408889634f, QS = 0.125f * LOG2E;
    const bf16* proj = (const bf16*)(F.ws + WS_PROJ); const float* small = (const float*)(F.ws + WS_SMALL);
    const bf16* kcb = (const bf16*)(F.ws + WS_KCB); const bf16* vcb = kcb + (size_t)16 * 2 * 128 * 64;
    bf16* onsa = (bf16*)(F.ws + WS_OY);
    unsigned* qctr = (unsigned*)(F.ws + WS_CTL) + 8 + qslot;
    LAS unsigned char* L = F.lds;
    volatile LAS unsigned* sched = (volatile LAS unsigned*)(F.lds + 32768);
    LAS unsigned* sml = (LAS unsigned*)(F.lds + 32768 + 256);
    LAS float* scA = (LAS float*)(F.lds + 40960); LAS float* scB = (LAS float*)(F.lds + 49152);
    const int w = F.wave;
    for (;;) {
        __syncthreads();
        if (F.tid == 0) sched[0] = atomicAdd(qctr, 1u);
        __syncthreads();
        const int qi = (int)__builtin_amdgcn_readfirstlane(sched[0]);
        if (qi >= 1792) break;
        const int qa = qi / 14, qr = qi - 14 * qa;
        const int cslot = qr == 0 ? 0 : qr == 2 ? 1 : qr == 4 ? 2 : qr == 7 ? 3 : qr == 9 ? 4 : qr == 11 ? 5 : -1;
        if (cslot >= 0) {
            const int chunk = 6 * qa + cslot;
            LAS float* scr = (LAS float*)(F.lds + 40960 + w * 8448);
            for (int j = 0; j < 8; ++j) { const int it = chunk * 64 + w * 8 + j;
                if (it < 32 * 1024) { const int e = it >> 10; transpose_item8<2>(F.in[26] + (size_t)e * 1024 * 2048, 2048, 1024, (unsigned char*)(F.ws + WS_WUP) + (size_t)e * 2048 * 1024, 64, it & 1023, scr, F.lane); }
                else { const int r2 = it - 32 * 1024, e = r2 >> 9; transpose_item8<0>(F.in[28] + (size_t)e * 1024 * 1024, 1024, 1024, (unsigned char*)(F.ws + WS_WDN) + (size_t)e * 1024 * 1024, 32, r2 & 511, scr, F.lane); } }
            continue;
        }
        const int unit = 8 * qa + (qr - 1 - (qr > 2 ? 1 : 0) - (qr > 4 ? 1 : 0) - (qr > 7 ? 1 : 0) - (qr > 9 ? 1 : 0) - (qr > 11 ? 1 : 0));
        const int lane = opaque_i(F.lane), c = lane & 15, g4 = lane >> 4;
        const int pr = 8 * ((c >> 2) & 1) + 4 * (c >> 3) + (c & 3), k7 = pr & 7;
        int kof[2]; kof[0] = pr * 128 + (((0 + g4) ^ k7) << 4); kof[1] = pr * 128 + (((4 + g4) ^ k7) << 4);
        const int q4 = c >> 2, p4 = c & 3, xr = 2 * (g4 & 1) + (g4 >> 1);
        const int vb = 1024 * (g4 & 1) + 64 * (4 * (g4 >> 1) + q4) + 8 * (p4 & 1);
        int vx[2]; vx[0] = 16 * ((0 + (p4 >> 1)) ^ xr); vx[1] = 16 * ((2 + (p4 >> 1)) ^ xr);
        const int kbl = 8 * (g4 & 1) + 4 * (g4 >> 1);
        const int tid_ = opaque_i(F.tid), skey = tid_ >> 3, sch = tid_ & 7;
        const int kst = skey * 128 + ((sch ^ (skey & 7)) << 4);
        const int vst = 16384 + 1024 * (skey >> 3) + 512 * (sch >> 2) + 64 * (skey & 7) + 16 * ((sch & 3) ^ ((skey >> 2) & 3));
        const int qb = 31 - (unit >> 5), b = (unit & 31) >> 1, g = unit & 1, t0 = qb * 64;
        const int ntile = qb >= 16 ? 2 : 1;
        for (int tl = 0; tl < ntile; ++tl) { const bf16* sp = kcb + ((size_t)(b * 2 + g) * 128 + 64 * tl + skey) * 64 + sch * 8;
            *(LAS u32x4*)(L + tl * 8192 + kst) = *(const u32x4*)sp; *(LAS u32x4*)(L + tl * 8192 + vst) = *(const u32x4*)(sp + (vcb - kcb)); }
        int tq[2]; unsigned smask[2]; LAS bf16x8* qfl = (LAS bf16x8*)(F.lds + 106496 + w * 4096) + lane;
        const int hq = 4 * g + (c & 3);
        const float slope2 = exp2f(-(float)(hq + 1)) * LOG2E;
#pragma unroll
        for (int nt = 0; nt < 2; ++nt) { const int tl = 8 * w + 4 * nt + (c >> 2); tq[nt] = t0 + tl;
            const bf16* qp = proj + (size_t)(b * S + tq[nt]) * PP + C_Q + hq * 64 + 8 * g4;
#pragma unroll
            for (int ks = 0; ks < 2; ++ks) { const u32x4 v = *(const u32x4*)(qp + 32 * ks); u32x4 o;
                o.x = pk2(bflo(v.x) * QS, bfhi(v.x) * QS); o.y = pk2(bflo(v.y) * QS, bfhi(v.y) * QS); o.z = pk2(bflo(v.z) * QS, bfhi(v.z) * QS); o.w = pk2(bflo(v.w) * QS, bfhi(v.w) * QS);
                qfl[(nt * 2 + ks) * 64] = __builtin_bit_cast(bf16x8, o); } }
        const bf16* rowb = proj + (size_t)(b * S + skey) * PP + g * 64 + sch * 8;
        u32x4 rk, rv;
        { const bf16* sp = rowb + (size_t)(64 * qb) * PP + C_KWIN; rk = *(const u32x4*)sp; rv = *(const u32x4*)(sp + 128); }
        __syncthreads();
        f32x4 ocm[2][4];
#pragma unroll
        for (int nt = 0; nt < 2; ++nt) {
            const int tlq = 8 * w + 4 * nt + (c >> 2);
            float sc[2][4][4]; float tmax = -1e30f;
            const int nvalid = tq[nt] >= 31 ? ((tq[nt] - 31) >> 4) + 1 : 0;
#pragma unroll
            for (int tl = 0; tl < 2; ++tl) {
                if (tl < ntile) {
                    f32x4 sa[4];
#pragma unroll
                    for (int mt = 0; mt < 4; ++mt) sa[mt] = (f32x4){0.f, 0.f, 0.f, 0.f};
#pragma unroll
                    for (int ks = 0; ks < 2; ++ks)
#pragma unroll
                        for (int mt = 0; mt < 4; ++mt) { const bf16x8 kf = *(const LAS bf16x8*)(L + tl * 8192 + mt * 2048 + kof[ks]); sa[mt] = __builtin_amdgcn_mfma_f32_16x16x32_bf16(kf, qfl[(nt * 2 + ks) * 64], sa[mt], 0, 0, 0); }
#pragma unroll
                    for (int mt = 0; mt < 4; ++mt)
#pragma unroll
                        for (int i = 0; i < 4; ++i) { const int n = 64 * tl + 16 * mt + kbl + i;
                            const float v = n < nvalid ? sa[mt][i] - slope2 * ((float)(tq[nt] - 16 * n) - 15.5f) : -1e30f; sc[tl][mt][i] = v; tmax = fmaxf(tmax, v); }
                } else {
#pragma unroll
                    for (int mt = 0; mt < 4; ++mt)
#pragma unroll
                        for (int i = 0; i < 4; ++i) sc[tl][mt][i] = -1e30f;
                }
            }
            tmax = fmaxf(tmax, __shfl_xor(tmax, 16)); tmax = fmaxf(tmax, __shfl_xor(tmax, 32));
            float ls = 0.f;
#pragma unroll
            for (int tl = 0; tl < 2; ++tl)
#pragma unroll
                for (int mt = 0; mt < 4; ++mt)
#pragma unroll
                    for (int i = 0; i < 4; ++i) { const float p = sc[tl][mt][i] > -1e29f ? __builtin_amdgcn_exp2f(sc[tl][mt][i] - tmax) : 0.f; sc[tl][mt][i] = p; ls += p; }
            ls += __shfl_xor(ls, 16); ls += __shfl_xor(ls, 32);
            const float inv = ls > 0.f ? 1.0f / ls : 0.f;
#pragma unroll
            for (int dt = 0; dt < 4; ++dt) ocm[nt][dt] = (f32x4){0.f, 0.f, 0.f, 0.f};
#pragma unroll
            for (int tl = 0; tl < 2; ++tl) {
                if (tl < ntile) {
#pragma unroll
                    for (int mt = 0; mt < 4; ++mt) {
#pragma unroll
                        for (int i = 0; i < 4; ++i) sc[tl][mt][i] *= inv;
                        float a = sc[tl][mt][0] + sc[tl][mt][1] + sc[tl][mt][2] + 0.5f * sc[tl][mt][3], bb = 0.5f * sc[tl][mt][3];
                        a += __shfl_xor(a, 1); a += __shfl_xor(a, 2); bb += __shfl_xor(bb, 1); bb += __shfl_xor(bb, 2);
                        if ((c & 3) == 0) { const int j = 16 * tl + 4 * mt + 2 * (g4 & 1) + (g4 >> 1); scA[tlq * 32 + j] = a; scB[tlq * 32 + j] = bb; }
                    }
#pragma unroll
                    for (int s = 0; s < 2; ++s) { u32x4 pw; pw.x = pk2(sc[tl][2 * s][0], sc[tl][2 * s][1]); pw.y = pk2(sc[tl][2 * s][2], sc[tl][2 * s][3]); pw.z = pk2(sc[tl][2 * s + 1][0], sc[tl][2 * s + 1][1]); pw.w = pk2(sc[tl][2 * s + 1][2], sc[tl][2 * s + 1][3]);
                        const bf16x8 pf = __builtin_bit_cast(bf16x8, pw);
#pragma unroll
                        for (int dt = 0; dt < 4; ++dt) { const LAS unsigned char* vp = L + 16384 + tl * 8192 + vb + 4096 * s + 512 * (dt >> 1) + vx[dt & 1];
                            const s16x4 lo = __builtin_bit_cast(s16x4, __builtin_amdgcn_ds_read_tr16_b64_v4i16((LAS s16x4*)vp));
                            const s16x4 hi = __builtin_bit_cast(s16x4, __builtin_amdgcn_ds_read_tr16_b64_v4i16((LAS s16x4*)(vp + 2048)));
                            const bf16x8 vf = (bf16x8){lo[0], lo[1], lo[2], lo[3], hi[0], hi[1], hi[2], hi[3]};
                            ocm[nt][dt] = __builtin_amdgcn_mfma_f32_16x16x32_bf16(vf, pf, ocm[nt][dt], 0, 0, 0); } }
                }
            }
            const float sg = sigmoidf_(small[(size_t)(b * S + tq[nt]) * 32 + hq]);
#pragma unroll
            for (int dt = 0; dt < 4; ++dt) ocm[nt][dt] *= sg;
        }
        __syncthreads();
        if (F.tid < 64) { const int tlq = F.tid, cur = qb; unsigned mask;
            if (cur < 8) mask = (1u << (cur + 1)) - 1u;
            else { mask = 1u | (1u << cur);
                float sv[31];
#pragma unroll
                for (int j = 1; j < 31; ++j) sv[j] = j < cur ? scA[tlq * 32 + j] + scB[tlq * 32 + j - 1] : -1.0f;
#pragma unroll
                for (int it = 0; it < 6; ++it) { float best = -1.0f; int bj = 0;
#pragma unroll
                    for (int j = 1; j < 31; ++j) { const bool ok = sv[j] > best; best = ok ? sv[j] : best; bj = ok ? j : bj; }
                    mask |= 1u << bj;
#pragma unroll
                    for (int j = 1; j < 31; ++j) sv[j] = (j == bj) ? -1.0f : sv[j]; }
                mask &= ~1u; mask |= 1u; }
            sml[tlq] = mask; }
        __syncthreads();
        const unsigned mreg = sml[lane];
        unsigned um = mreg;
#pragma unroll
        for (int o = 1; o < 64; o <<= 1) um |= (unsigned)__shfl_xor((int)um, o);
        um = (unsigned)__builtin_amdgcn_readfirstlane((int)um);
        AttnW st; LAS f32x4* owl = (LAS f32x4*)(F.lds + 40960 + w * 8192) + lane;
#pragma unroll
        for (int nt = 0; nt < 2; ++nt) { smask[nt] = sml[8 * w + 4 * nt + (c >> 2)]; st.m[nt] = -1e30f; st.l[nt] = 0.f;
#pragma unroll
            for (int dt = 0; dt < 4; ++dt) { owl[(nt * 4 + dt) * 64] = ocm[nt][dt]; st.o[nt][dt] = (f32x4){0.f, 0.f, 0.f, 0.f}; } }
        int phase = 0, kt = qb, wleft = qb + 1 < 5 ? qb + 1 : 5; unsigned rem = um;
        int buf = 0;
        while (phase != 2) {
            *(LAS u32x4*)(L + buf * 8192 + kst) = rk; *(LAS u32x4*)(L + buf * 8192 + vst) = rv;
            __syncthreads();
            int nphase = phase, nkt = kt;
            if (phase == 0) { --wleft; if (wleft > 0) nkt = kt - 1; else { nphase = 1; nkt = 31 - __builtin_clz(rem); rem &= ~(1u << nkt); } }
            else { if (rem) { nkt = 31 - __builtin_clz(rem); rem &= ~(1u << nkt); } else nphase = 2; }
            if (nphase != 2) { const bf16* sp = rowb + (size_t)(64 * nkt) * PP + (nphase == 0 ? C_KWIN : C_KSLC); rk = *(const u32x4*)sp; rv = *(const u32x4*)(sp + 128); }
            if (phase == 0) attn_tile<0>(kt == qb || kt == qb - 4, st, L + buf * 8192, L + 16384 + buf * 8192, qfl, kof, vb, vx, kt, kbl, t0, tq, smask, slope2);
            else            attn_tile<1>(kt == qb, st, L + buf * 8192, L + 16384 + buf * 8192, qfl, kof, vb, vx, kt, kbl, t0, tq, smask, slope2);
            if (nphase != phase) {
#pragma unroll
                for (int nt = 0; nt < 2; ++nt) {
                    float lt = st.l[nt]; lt += __shfl_xor(lt, 16); lt += __shfl_xor(lt, 32);
                    const size_t tok = (size_t)(b * S + tq[nt]);
                    if (phase == 0) { const float sg = sigmoidf_(small[tok * 32 + 16 + hq]) / lt;
#pragma unroll
                        for (int dt = 0; dt < 4; ++dt) { owl[(nt * 4 + dt) * 64] += st.o[nt][dt] * sg; st.o[nt][dt] = (f32x4){0.f, 0.f, 0.f, 0.f}; }
                        st.m[nt] = -1e30f; st.l[nt] = 0.f; }
                    else { const float sg = sigmoidf_(small[tok * 32 + 8 + hq]) / lt;
#pragma unroll
                        for (int dt = 0; dt < 4; ++dt) { const size_t oi = tok * 1024 + hq * 64 + 16 * dt + 4 * g4;
                            const f32x4 r = owl[(nt * 4 + dt) * 64] + st.o[nt][dt] * sg;
                            u32x2 o2; o2.x = pk2(r[0], r[1]); o2.y = pk2(r[2], r[3]); *(u32x2*)(onsa + oi) = o2; } }
                }
            }
            phase = nphase; kt = nkt; buf ^= 1;
        }
    }
}

__device__ __forceinline__ int sw256(int r, int col) { return r * 256 + ((((col >> 3) ^ (r & 15))) << 4) + (col & 7) * 2; }
__device__ __forceinline__ void ml_gates(Frame& F, const float* small, size_t tok0, int h, LAS float* Fa, LAS float* ia) {
    if (F.wave == 0) {
        const int l = F.lane; const float fb = F.in[18][h];
        const float f0 = small[(tok0 + 2 * l) * 32 + 28 + h] + fb, f1 = small[(tok0 + 2 * l + 1) * 32 + 28 + h] + fb;
        const float a = fminf(f0, 0.f) - log1pf(__expf(-fabsf(f0))), bq = fminf(f1, 0.f) - log1pf(__expf(-fabsf(f1)));
        float s = a + bq;
#pragma unroll
        for (int o = 1; o < 64; o <<= 1) { const float v = __shfl_up(s, o); if (l >= o) s += v; }
        const float pre = s - (a + bq);
        Fa[2 * l] = pre + a; Fa[2 * l + 1] = pre + a + bq;
        ia[2 * l] = small[(tok0 + 2 * l) * 32 + 24 + h]; ia[2 * l + 1] = small[(tok0 + 2 * l + 1) * 32 + 24 + h];
    }
}

__device__ __forceinline__ void p3_mlstate(Frame& F) {
    const bf16* proj = (const bf16*)(F.ws + WS_PROJ); const float* small = (const float*)(F.ws + WS_SMALL);
    bf16* qml = (bf16*)(F.ws + WS_QML); bf16* kml = (bf16*)(F.ws + WS_KML); bf16* vtg = (bf16*)(F.ws + WS_VML);
    const bf16* wqt = (const bf16*)(F.ws + WS_WQT); const bf16* wkt = wqt + 4 * 16384; const bf16* wvt = wqt + 8 * 16384;
    float* cloct = (float*)(F.ws + WS_CLOC); float* nloc = (float*)(F.ws + WS_NLOC); float* mloc = (float*)(F.ws + WS_MLOC); float* flast = (float*)(F.ws + WS_FLAST);
    const float* cw = F.in[13]; const float* cb = F.in[14];
    LAS unsigned char* L = F.lds;
    LAS float* Fa = (LAS float*)(F.lds + 131072); LAS float* ia = Fa + 128; LAS float* wa = ia + 128; LAS float* red = wa + 128;
    const int lane = F.lane, w = F.wave, c = lane & 15, g4 = lane >> 4;
    for (int u = F.bid; u < 1024; u += F.G) {
        const int b = u >> 6, h = (u >> 4) & 3, ch = u & 15, t0 = ch * 128;
        const size_t tok0 = (size_t)b * S + t0;
        __syncthreads();
        for (int it = F.tid; it < 2048; it += NTHREADS) { const int t = it >> 4, c8 = (it & 15) * 8, cc = h * 128 + c8;
            float a[8]; u32x4 xm3 = (u32x4){0u, 0u, 0u, 0u};
#pragma unroll
            for (int i = 0; i < 8; ++i) a[i] = cb[cc + i];
#pragma unroll
            for (int j = 0; j < 4; ++j) { const int tt = t0 + t - 3 + j;
                if (tt >= 0) { const u32x4 xv = *(const u32x4*)(proj + ((size_t)b * S + tt) * PP + C_XM + cc);
                    const f32x4 w0 = *(const f32x4*)(cw + j * 512 + cc), w1 = *(const f32x4*)(cw + j * 512 + cc + 4);
                    a[0] += w0.x * bflo(xv.x); a[1] += w0.y * bfhi(xv.x); a[2] += w0.z * bflo(xv.y); a[3] += w0.w * bfhi(xv.y);
                    a[4] += w1.x * bflo(xv.z); a[5] += w1.y * bfhi(xv.z); a[6] += w1.z * bflo(xv.w); a[7] += w1.w * bfhi(xv.w);
                    if (j == 3) xm3 = xv; } }
#pragma unroll
            for (int i = 0; i < 8; ++i) a[i] = a[i] * __builtin_amdgcn_rcpf(1.0f + __expf(-a[i]));
            u32x4 o; o.x = pk2(a[0], a[1]); o.y = pk2(a[2], a[3]); o.z = pk2(a[4], a[5]); o.w = pk2(a[6], a[7]);
            *(LAS u32x4*)(L + sw256(t, c8)) = xm3; *(LAS u32x4*)(L + 32768 + sw256(t, c8)) = o; }
        ml_gates(F, small, tok0, h, Fa, ia);
        if (F.wave == 0) { LDS_WAIT(); const float FL = Fa[127]; float m = fmaxf(FL - Fa[2 * lane] + ia[2 * lane], FL - Fa[2 * lane + 1] + ia[2 * lane + 1]);
#pragma unroll
            for (int o = 1; o < 64; o <<= 1) m = fmaxf(m, __shfl_xor(m, o));
            wa[2 * lane] = __expf(FL - Fa[2 * lane] + ia[2 * lane] - m); wa[2 * lane + 1] = __expf(FL - Fa[2 * lane + 1] + ia[2 * lane + 1] - m);
            if (lane == 0) { mloc[u] = m; flast[u] = FL; } }
        __syncthreads();
        {
            const size_t wo = (size_t)(h * 128 + 16 * w + c) * 128 + 8 * g4;
            const size_t ro0 = ((size_t)(b * 4 + h) * S + t0) * 128 + 16 * w + 4 * g4; const int e = 16 * w + 4 * g4;
            f32x4 acc[8];
#pragma unroll
            for (int tt = 0; tt < 8; ++tt) acc[tt] = (f32x4){0.f, 0.f, 0.f, 0.f};
#pragma unroll
            for (int ks = 0; ks < 4; ++ks) { const bf16x8 wf = *(const bf16x8*)(wqt + wo + 32 * ks);
#pragma unroll
                for (int tt = 0; tt < 8; ++tt) acc[tt] = __builtin_amdgcn_mfma_f32_16x16x32_bf16(wf, *(const LAS bf16x8*)(L + 32768 + sw256(16 * tt + c, 32 * ks + 8 * g4)), acc[tt], 0, 0, 0); }
#pragma unroll
            for (int tt = 0; tt < 8; ++tt) { u32x2 qv; qv.x = pk2(acc[tt][0], acc[tt][1]); qv.y = pk2(acc[tt][2], acc[tt][3]); *(u32x2*)(qml + ro0 + (size_t)(16 * tt + c) * 128) = qv; }
#pragma unroll
            for (int tt = 0; tt < 8; ++tt) acc[tt] = (f32x4){0.f, 0.f, 0.f, 0.f};
#pragma unroll
            for (int ks = 0; ks < 4; ++ks) { const bf16x8 wf = *(const bf16x8*)(wkt + wo + 32 * ks);
#pragma unroll
                for (int tt = 0; tt < 8; ++tt) acc[tt] = __builtin_amdgcn_mfma_f32_16x16x32_bf16(wf, *(const LAS bf16x8*)(L + 32768 + sw256(16 * tt + c, 32 * ks + 8 * g4)), acc[tt], 0, 0, 0); }
#pragma unroll
            for (int tt = 0; tt < 8; ++tt) { const int t = 16 * tt + c; const float wt = wa[t];
                const float k0 = acc[tt][0] * 0.08838834764831845f, k1 = acc[tt][1] * 0.08838834764831845f, k2 = acc[tt][2] * 0.08838834764831845f, k3 = acc[tt][3] * 0.08838834764831845f;
                u32x2 kv; kv.x = pk2(k0, k1); kv.y = pk2(k2, k3); *(u32x2*)(kml + ro0 + (size_t)t * 128) = kv;
                *(LAS bf16*)(L + 65536 + sw256(e + 0, t)) = (bf16)f2bf(k0 * wt); *(LAS bf16*)(L + 65536 + sw256(e + 1, t)) = (bf16)f2bf(k1 * wt);
                *(LAS bf16*)(L + 65536 + sw256(e + 2, t)) = (bf16)f2bf(k2 * wt); *(LAS bf16*)(L + 65536 + sw256(e + 3, t)) = (bf16)f2bf(k3 * wt); }
#pragma unroll
            for (int tt = 0; tt < 8; ++tt) acc[tt] = (f32x4){0.f, 0.f, 0.f, 0.f};
#pragma unroll
            for (int ks = 0; ks < 4; ++ks) { const bf16x8 wf = *(const bf16x8*)(wvt + wo + 32 * ks);
#pragma unroll
                for (int tt = 0; tt < 8; ++tt) acc[tt] = __builtin_amdgcn_mfma_f32_16x16x32_bf16(*(const LAS bf16x8*)(L + sw256(16 * tt + c, 32 * ks + 8 * g4)), wf, acc[tt], 0, 0, 0); }
#pragma unroll
            for (int tt = 0; tt < 8; ++tt) { u32x2 vv; vv.x = pk2(acc[tt][0], acc[tt][1]); vv.y = pk2(acc[tt][2], acc[tt][3]); *(LAS u32x2*)(L + 98304 + sw256(16 * w + c, 16 * tt + 4 * g4)) = vv; }
        }
        __syncthreads();
        {
            f32x4 ac[8];
#pragma unroll
            for (int et = 0; et < 8; ++et) ac[et] = (f32x4){0.f, 0.f, 0.f, 0.f};
#pragma unroll
            for (int ks = 0; ks < 4; ++ks) {
                const bf16x8 kf = *(const LAS bf16x8*)(L + 65536 + sw256(16 * w + c, 32 * ks + 8 * g4));
#pragma unroll
                for (int et = 0; et < 8; ++et) { const bf16x8 vf = *(const LAS bf16x8*)(L + 98304 + sw256(16 * et + c, 32 * ks + 8 * g4)); ac[et] = __builtin_amdgcn_mfma_f32_16x16x32_bf16(kf, vf, ac[et], 0, 0, 0); }
            }
#pragma unroll
            for (int et = 0; et < 8; ++et) *(f32x4*)(cloct + (size_t)u * 16384 + (size_t)(16 * et + c) * 128 + 16 * w + 4 * g4) = ac[et];
        }
        if (F.tid < 128) { float s = 0.f;
#pragma unroll
            for (int k = 0; k < 16; ++k) { const u32x4 v = *(const LAS u32x4*)(L + 65536 + F.tid * 256 + k * 16); s += (bflo(v.x) + bfhi(v.x)) + (bflo(v.y) + bfhi(v.y)) + (bflo(v.z) + bfhi(v.z)) + (bflo(v.w) + bfhi(v.w)); }
            nloc[u * 128 + F.tid] = s; }
#pragma unroll
        for (int j = 0; j < 4; ++j) { const int id = F.tid + NTHREADS * j, e = id >> 4, ci = id & 15;
            *(u32x4*)(vtg + (size_t)u * 16384 + e * 128 + ci * 8) = *(const LAS u32x4*)(L + 98304 + e * 256 + ((ci ^ (e & 15)) << 4)); }
    }
}

__device__ __forceinline__ void p4_mlscan(Frame& F) {
    const float* cloct = (const float*)(F.ws + WS_CLOC); const float* nloc = (const float*)(F.ws + WS_NLOC); const float* mloc = (const float*)(F.ws + WS_MLOC); const float* flast = (const float*)(F.ws + WS_FLAST);
    bf16* cint = (bf16*)(F.ws + WS_CIN); float* nin = (float*)(F.ws + WS_NIN); float* min_ = (float*)(F.ws + WS_MIN);
    const int gtid = F.bid * NTHREADS + F.tid, gsz = F.G * NTHREADS;
    for (int idx = gtid; idx < 64 * (8192 + 64); idx += gsz) {
        const int bh = idx / (8192 + 64), de = (idx - bh * (8192 + 64)) * 2;
        float C0 = 0.f, C1 = 0.f, m = 0.f;
        for (int cch = 0; cch < 16; ++cch) { const int u = bh * 16 + cch;
            f32x2 loc;
            if (de < 16384) { *(unsigned*)(cint + (size_t)u * 16384 + de) = pk2(C0, C1); loc = *(const f32x2*)(cloct + (size_t)u * 16384 + de); if (de == 0) min_[u] = m; }
            else { *(f32x2*)(nin + u * 128 + (de - 16384)) = (f32x2){C0, C1}; loc = *(const f32x2*)(nloc + u * 128 + (de - 16384)); }
            const float FL = flast[u], ml = mloc[u], mn = fmaxf(FL + m, ml), dA = __expf(FL + m - mn), dB = __expf(ml - mn);
            C0 = dA * C0 + dB * loc.x; C1 = dA * C1 + dB * loc.y; m = mn; }
    }
}

__device__ __forceinline__ void p5_mlout(Frame& F) {
    const bf16* proj = (const bf16*)(F.ws + WS_PROJ); const float* small = (const float*)(F.ws + WS_SMALL);
    const bf16* qml = (const bf16*)(F.ws + WS_QML); const bf16* kml = (const bf16*)(F.ws + WS_KML); const bf16* vtg = (const bf16*)(F.ws + WS_VML);
    const bf16* cint = (const bf16*)(F.ws + WS_CIN); const float* nin = (const float*)(F.ws + WS_NIN); const float* min_ = (const float*)(F.ws + WS_MIN);
    bf16* yml = (bf16*)(F.ws + WS_OY) + 512;
    LAS unsigned char* L = F.lds;
    LAS float* Fa = (LAS float*)(F.lds + 98304); LAS float* ia = Fa + 128; LAS float* pm = ia + 128;
    const int lane = F.lane, w = F.wave, c = lane & 15, g4 = lane >> 4;
    for (int u = F.bid; u < 1024; u += F.G) {
        const int b = u >> 6, h = (u >> 4) & 3, ch = u & 15, t0 = ch * 128;
        const size_t tok0 = (size_t)b * S + t0; const size_t bhrow = ((size_t)(b * 4 + h) * S + t0);
        __syncthreads();
#pragma unroll
        for (int j = 0; j < 4; ++j) { const int id = F.tid + NTHREADS * j, r = id >> 4, ci = id & 15;
            *(LAS u32x4*)(L + r * 256 + ((ci ^ (r & 15)) << 4)) = *(const u32x4*)(kml + (bhrow + r) * 128 + ci * 8);
            *(LAS u32x4*)(L + 32768 + r * 256 + ((ci ^ (r & 15)) << 4)) = *(const u32x4*)(vtg + (size_t)u * 16384 + r * 128 + ci * 8);
            *(LAS u32x4*)(L + 65536 + r * 256 + ((ci ^ (r & 15)) << 4)) = *(const u32x4*)(cint + (size_t)u * 16384 + r * 128 + ci * 8); }
        ml_gates(F, small, tok0, h, Fa, ia);
        __syncthreads();
        if (F.wave == 0) {
            const float g0 = ia[2 * lane] - Fa[2 * lane], g1 = ia[2 * lane + 1] - Fa[2 * lane + 1];
            float s = fmaxf(g0, g1);
#pragma unroll
            for (int o = 1; o < 64; o <<= 1) { const float v = __shfl_up(s, o); if (lane >= o) s = fmaxf(s, v); }
            const float prev = __shfl_up(s, 1);
            pm[2 * lane] = lane > 0 ? fmaxf(prev, g0) : g0; pm[2 * lane + 1] = s;
            ia[2 * lane] = g0; ia[2 * lane + 1] = g1; }
        __syncthreads();
        const int t = 16 * w + c;
        const float mm = min_[u], mref = fmaxf(mm, pm[t]), wi = __expf(mm - mref);
        bf16x8 qf[4]; float qn = 0.f;
#pragma unroll
        for (int ks = 0; ks < 4; ++ks) { const u32x4 qv = *(const u32x4*)(qml + (bhrow + t) * 128 + 32 * ks + 8 * g4); qf[ks] = __builtin_bit_cast(bf16x8, qv);
            const f32x4 n0 = *(const f32x4*)(nin + u * 128 + 32 * ks + 8 * g4), n1 = *(const f32x4*)(nin + u * 128 + 32 * ks + 8 * g4 + 4);
            qn += bflo(qv.x) * n0.x + bfhi(qv.x) * n0.y + bflo(qv.y) * n0.z + bfhi(qv.y) * n0.w + bflo(qv.z) * n1.x + bfhi(qv.z) * n1.y + bflo(qv.w) * n1.z + bfhi(qv.w) * n1.w; }
        qn += __shfl_xor(qn, 16); qn += __shfl_xor(qn, 32);
        f32x4 aI[8], aP[8];
#pragma unroll
        for (int et = 0; et < 8; ++et) { aI[et] = (f32x4){0.f, 0.f, 0.f, 0.f}; aP[et] = aI[et]; }
#pragma unroll
        for (int ks = 0; ks < 4; ++ks)
            {
#pragma unroll
              for (int et = 0; et < 8; ++et) aI[et] = __builtin_amdgcn_mfma_f32_16x16x32_bf16(*(const LAS bf16x8*)(L + 65536 + sw256(16 * et + c, 32 * ks + 8 * g4)), qf[ks], aI[et], 0, 0, 0); __builtin_amdgcn_sched_barrier(0); }
        float den = 0.f;
        for (int ss = 0; 2 * ss <= w; ++ss) {
            float p[2][4];
#pragma unroll
            for (int hh = 0; hh < 2; ++hh) { const int st = 2 * ss + hh;
                if (st <= w) { f32x4 sa = (f32x4){0.f, 0.f, 0.f, 0.f};
#pragma unroll
                    for (int ks = 0; ks < 4; ++ks) sa = __builtin_amdgcn_mfma_f32_16x16x32_bf16(*(const LAS bf16x8*)(L + sw256(16 * st + c, 32 * ks + 8 * g4)), qf[ks], sa, 0, 0, 0);
#pragma unroll
                    for (int i = 0; i < 4; ++i) { const int s = 16 * st + 4 * g4 + i; const float v = s <= t ? sa[i] * __expf(ia[s] - mref) : 0.f; p[hh][i] = v; den += v; } }
                else {
#pragma unroll
                    for (int i = 0; i < 4; ++i) p[hh][i] = 0.f; } }
            u32x4 pw; pw.x = pk2(p[0][0], p[0][1]); pw.y = pk2(p[0][2], p[0][3]); pw.z = pk2(p[1][0], p[1][1]); pw.w = pk2(p[1][2], p[1][3]);
            const bf16x8 pf = __builtin_bit_cast(bf16x8, pw);
#pragma unroll
            for (int et = 0; et < 8; ++et) { const u32x2 lo = *(const LAS u32x2*)(L + 32768 + sw256(16 * et + c, 32 * ss + 4 * g4)), hi = *(const LAS u32x2*)(L + 32768 + sw256(16 * et + c, 32 * ss + 16 + 4 * g4));
                const u32x4 vw = (u32x4){lo.x, lo.y, hi.x, hi.y};
                aP[et] = __builtin_amdgcn_mfma_f32_16x16x32_bf16(__builtin_bit_cast(bf16x8, vw), pf, aP[et], 0, 0, 0); }
        }
        den += __shfl_xor(den, 16); den += __shfl_xor(den, 32);
        den += wi * qn;
        const float mt = Fa[t] + mref, dd = 1.0f / fmaxf(fabsf(den), __expf(-mt));
        float s1 = 0.f;
#pragma unroll
        for (int et = 0; et < 8; ++et)
#pragma unroll
            for (int i = 0; i < 4; ++i) { const float v = (aP[et][i] + wi * aI[et][i]) * dd; aP[et][i] = v; s1 += v; }
        s1 += __shfl_xor(s1, 16); s1 += __shfl_xor(s1, 32);
        const float mu = s1 * (1.0f / 128.0f); float s2 = 0.f;
#pragma unroll
        for (int et = 0; et < 8; ++et)
#pragma unroll
            for (int i = 0; i < 4; ++i) { const float v = aP[et][i] - mu; aP[et][i] = v; s2 += v * v; }
        s2 += __shfl_xor(s2, 16); s2 += __shfl_xor(s2, 32);
        const float rstd = rsqrtf(s2 * (1.0f / 128.0f) + 1e-5f);
        const size_t tok = tok0 + t;
#pragma unroll
        for (int et = 0; et < 8; ++et) { const int col = h * 128 + 16 * et + 4 * g4;
            const unsigned ow8 = *(const unsigned*)((const unsigned char*)(F.ws + WS_GATE8) + tok * GP + G_OPRE + col); const f32x2 o01 = __builtin_amdgcn_cvt_pk_f32_fp8((int)ow8, false), o23 = __builtin_amdgcn_cvt_pk_f32_fp8((int)ow8, true); const f32x4 ng = *(const f32x4*)(F.in[19] + col);
            u32x2 y; y.x = pk2(sigmoidf_(o01.x) * aP[et][0] * rstd * ng.x, sigmoidf_(o01.y) * aP[et][1] * rstd * ng.y);
            y.y = pk2(sigmoidf_(o23.x) * aP[et][2] * rstd * ng.z, sigmoidf_(o23.y) * aP[et][3] * rstd * ng.w);
            *(u32x2*)(yml + tok * 1024 + col) = y; }
    }
}

__device__ __forceinline__ void p9_route(Frame& F, const bool dup) {
    const bf16* x1 = (const bf16*)(F.ws + WS_OY); const float* mod = (const float*)(F.ws + WS_MOD); const float* g2 = F.in[23]; const float* rb = F.in[25];
    const bf16* rwh = (const bf16*)(F.ws + WS_RWT); const bf16* rwl = rwh + 32 * 1024;
    bf16* h2 = (bf16*)(F.ws + WS_XN);
    int* re = (int*)(F.ws + (dup ? WS_ACT : WS_RE)); float* rwt = (float*)(F.ws + (dup ? WS_ACT + MiB : WS_RW)); int* rs = (int*)(F.ws + (dup ? WS_ACT + 2 * MiB : WS_RS)); unsigned* cnt = (unsigned*)(F.ws + WS_CTL) + (dup ? 16 : 0);
    const int gw = F.bid * NWAVES + F.wave, NGW = F.G * NWAVES, lane = F.lane, c = lane & 15, g4 = lane >> 4;
    LAS unsigned* lcnt = (LAS unsigned*)F.lds;
    for (int grp = gw; grp < T / 16; grp += NGW) {
        const int tkn = grp * 16 + c, b = tkn >> 11;
        const bf16* xr = x1 + (size_t)tkn * D + 8 * g4; const float* sh = mod + (size_t)b * 6144 + 3 * 1024 + 8 * g4; const float* scp = mod + (size_t)b * 6144 + 4 * 1024 + 8 * g4;
        float ss = 0.f;
#pragma unroll 8
        for (int ks = 0; ks < 32; ++ks) { const u32x4 xv = *(const u32x4*)(xr + 32 * ks); const f32x4 a = (f32x4){bflo(xv.x), bfhi(xv.x), bflo(xv.y), bfhi(xv.y)}, bq = (f32x4){bflo(xv.z), bfhi(xv.z), bflo(xv.w), bfhi(xv.w)};
            ss += (a.x * a.x + a.y * a.y) + (a.z * a.z + a.w * a.w) + (bq.x * bq.x + bq.y * bq.y) + (bq.z * bq.z + bq.w * bq.w); }
        ss += __shfl_xor(ss, 16); ss += __shfl_xor(ss, 32);
        const float rsq = rsqrtf(ss * (1.0f / D) + 1e-5f);
        f32x4 acc[2]; acc[0] = (f32x4){0.f, 0.f, 0.f, 0.f}; acc[1] = acc[0];
#pragma unroll 4
        for (int ks = 0; ks < 32; ++ks) {
            float y[8];
            { const u32x4 xv = *(const u32x4*)(xr + 32 * ks); const f32x4 a = (f32x4){bflo(xv.x), bfhi(xv.x), bflo(xv.y), bfhi(xv.y)}, bq = (f32x4){bflo(xv.z), bfhi(xv.z), bflo(xv.w), bfhi(xv.w)};
              const f32x4 ga = *(const f32x4*)(g2 + 32 * ks + 8 * g4), gb = *(const f32x4*)(g2 + 32 * ks + 8 * g4 + 4);
              const f32x4 sa = *(const f32x4*)(scp + 32 * ks), sb = *(const f32x4*)(scp + 32 * ks + 4), ha = *(const f32x4*)(sh + 32 * ks), hb = *(const f32x4*)(sh + 32 * ks + 4);
#pragma unroll
              for (int i = 0; i < 4; ++i) { y[i] = a[i] * rsq * ga[i] * (1.0f + sa[i]) + ha[i]; y[4 + i] = bq[i] * rsq * gb[i] * (1.0f + sb[i]) + hb[i]; } }
            unsigned hi[8], lo[8];
#pragma unroll
            for (int i = 0; i < 8; ++i) { hi[i] = f2bf(y[i]); lo[i] = f2bf(y[i] - __builtin_bit_cast(float, hi[i] << 16)); }
            const u32x4 yhw = (u32x4){hi[0] | (hi[1] << 16), hi[2] | (hi[3] << 16), hi[4] | (hi[5] << 16), hi[6] | (hi[7] << 16)};
            const u32x4 ylw = (u32x4){lo[0] | (lo[1] << 16), lo[2] | (lo[3] << 16), lo[4] | (lo[5] << 16), lo[6] | (lo[7] << 16)};
            { u32x2 y8; y8.x = pk4_fp8(y[0], y[1], y[2], y[3]); y8.y = pk4_fp8(y[4], y[5], y[6], y[7]); *(u32x2*)((unsigned char*)h2 + (size_t)tkn * D + 32 * ks + 8 * g4) = y8; }
            const bf16x8 yh = __builtin_bit_cast(bf16x8, yhw), yl = __builtin_bit_cast(bf16x8, ylw);
#pragma unroll
            for (int et = 0; et < 2; ++et) { const size_t wo = (size_t)(16 * et + c) * 1024 + 32 * ks + 8 * g4;
                const bf16x8 wh = *(const bf16x8*)(rwh + wo), wl = *(const bf16x8*)(rwl + wo);
                acc[et] = __builtin_amdgcn_mfma_f32_16x16x32_bf16(wh, yh, acc[et], 0, 0, 0);
                acc[et] = __builtin_amdgcn_mfma_f32_16x16x32_bf16(wl, yh, acc[et], 0, 0, 0);
                acc[et] = __builtin_amdgcn_mfma_f32_16x16x32_bf16(wh, yl, acc[et], 0, 0, 0); }
        }
        float lg[32];
#pragma unroll
        for (int gs = 0; gs < 4; ++gs)
#pragma unroll
            for (int et = 0; et < 2; ++et)
#pragma unroll
                for (int i = 0; i < 4; ++i) { const int e = 16 * et + 4 * gs + i; lg[e] = __shfl(acc[et][i], c + 16 * gs) + rb[e]; }
        int te[4]; float tv[4]; unsigned used = 0u;
#pragma unroll
        for (int k = 0; k < 4; ++k) { float best = -3.0e38f; int bi = 0;
#pragma unroll
            for (int e = 0; e < 32; ++e) { const bool ok = !((used >> e) & 1u) && lg[e] > best; best = ok ? lg[e] : best; bi = ok ? e : bi; }
            te[k] = bi; tv[k] = best; used |= 1u << bi; }
        const float e1 = __expf(tv[1] - tv[0]), e2 = __expf(tv[2] - tv[0]), e3 = __expf(tv[3] - tv[0]); const float inv = 1.0f / (1.0f + e1 + e2 + e3);
        { const int ek = g4 == 0 ? te[0] : g4 == 1 ? te[1] : g4 == 2 ? te[2] : te[3];
          const float wk = (g4 == 0 ? 1.0f : g4 == 1 ? e1 : g4 == 2 ? e2 : e3) * inv;
          __syncthreads();
          if (F.tid < 32) lcnt[F.tid] = 0u;
          __syncthreads();
          const unsigned rnk = __hip_atomic_fetch_add(lcnt + ek, 1u, __ATOMIC_RELAXED, __HIP_MEMORY_SCOPE_WORKGROUP);
          __syncthreads();
          if (F.tid < 32) lcnt[32 + F.tid] = atomicAdd(cnt + F.tid * 32, lcnt[F.tid]);
          __syncthreads();
          const unsigned slot = lcnt[32 + ek] + rnk;
          re[tkn * 4 + g4] = ek; rwt[tkn * 4 + g4] = wk; rs[tkn * 4 + g4] = (int)slot; }
    }
}

__device__ __forceinline__ void p10_gather(Frame& F) {
    const unsigned* cnt = (const unsigned*)(F.ws + WS_CTL);
    const int* re = (const int*)(F.ws + WS_RE); const int* rs = (const int*)(F.ws + WS_RS); int* dest = (int*)(F.ws + WS_DEST); int* blke = (int*)(F.ws + WS_BLKE);
    int* rowidx = (int*)(F.ws + WS_ROWIDX);
    LAS int* off = (LAS int*)F.lds;
    __syncthreads();
    if (F.tid == 0) { int o = 0; for (int e = 0; e < 32; ++e) { const int c = (int)__hip_atomic_load(cnt + e * 32, __ATOMIC_RELAXED, __HIP_MEMORY_SCOPE_AGENT); const int p = (c + 255) & ~255; off[e] = o; off[32 + e] = c; off[64 + e] = p; o += p; } off[96] = o; }
    __syncthreads();
    if (F.bid == 0) { const int nblk = off[96] >> 8;
        for (int i = F.tid; i < nblk; i += NTHREADS) { int e = 0; for (int k = 1; k < 32; ++k) if (i * 256 >= off[k]) e = k; blke[i] = e; }
        if (F.tid == 0) blke[1000] = nblk; }
    const int gtid = F.bid * NTHREADS + F.tid, gsz = F.G * NTHREADS;
    for (int i = gtid; i < T * 4; i += gsz) { const int dr = off[re[i]] + rs[i]; dest[i] = dr; rowidx[dr] = i >> 2; }
    for (int i = gtid; i < 32 * 256; i += gsz) { const int e = i >> 8, r = i & 255; if (off[32 + e] + r < off[64 + e]) rowidx[off[e] + off[32 + e] + r] = 0; }
}

__device__ __forceinline__ void p13_final(Frame& F, const bool dup) {
    const float* mod = (const float*)(F.ws + WS_MOD); const float* fg = F.in[30];
    const float* rwt = (const float*)(F.ws + WS_RW); const int* dest = (const int*)(F.ws + WS_DEST); const bf16* ypad = (const bf16*)(F.ws + WS_PROJ);
    const int gw = F.bid * NWAVES + F.wave, NGW = F.G * NWAVES, lane = F.lane;
    for (int grp = gw; grp < T / 16; grp += NGW) {
        const int dl = dest[grp * 64 + lane]; const float wl = rwt[grp * 64 + lane];
        const int b = (grp * 16) >> 11; const float* g2 = mod + (size_t)b * 6144 + 5 * 1024;
#pragma unroll 4
        for (int tk = 0; tk < 16; ++tk) {
            const int tkn = grp * 16 + tk; const bf16* xr = (const bf16*)(F.ws + WS_OY) + (size_t)tkn * D; float* xo = (dup ? (float*)(F.ws + WS_ACT) : F.out) + (size_t)tkn * D;
            float acc[16];
#pragma unroll
            for (int i = 0; i < 16; ++i) acc[i] = 0.f;
#pragma unroll
            for (int k = 0; k < 4; ++k) { const int dr = __shfl(dl, 4 * tk + k); const float w = __shfl(wl, 4 * tk + k); const u32x4* yp = (const u32x4*)(ypad + (size_t)dr * D);
#pragma unroll
                for (int j = 0; j < 2; ++j) { const u32x4 y = yp[64 * j + lane];
                    acc[8 * j + 0] += w * bflo(y.x); acc[8 * j + 1] += w * bfhi(y.x); acc[8 * j + 2] += w * bflo(y.y); acc[8 * j + 3] += w * bfhi(y.y);
                    acc[8 * j + 4] += w * bflo(y.z); acc[8 * j + 5] += w * bfhi(y.z); acc[8 * j + 6] += w * bflo(y.w); acc[8 * j + 7] += w * bfhi(y.w); } }
            float ss = 0.f;
#pragma unroll
            for (int j = 0; j < 2; ++j) { const int d0 = (64 * j + lane) * 8; const u32x4 xw = *(const u32x4*)(xr + d0);
#pragma unroll
                for (int q = 0; q < 2; ++q) { const f32x4 xv = q == 0 ? (f32x4){bflo(xw.x), bfhi(xw.x), bflo(xw.y), bfhi(xw.y)} : (f32x4){bflo(xw.z), bfhi(xw.z), bflo(xw.w), bfhi(xw.w)}; const f32x4 gv = *(const f32x4*)(g2 + d0 + 4 * q);
#pragma unroll
                    for (int i = 0; i < 4; ++i) { const float y = xv[i] + gv[i] * acc[8 * j + 4 * q + i]; acc[8 * j + 4 * q + i] = y; ss += y * y; } } }
            const float rsq = rsqrtf(wave_sum(ss) * (1.0f / D) + 1e-5f);
#pragma unroll
            for (int j = 0; j < 2; ++j) { const int d0 = (64 * j + lane) * 8;
#pragma unroll
                for (int q = 0; q < 2; ++q) { const f32x4 gv = *(const f32x4*)(fg + d0 + 4 * q);
                    *(f32x4*)(xo + d0 + 4 * q) = (f32x4){acc[8 * j + 4 * q] * rsq * gv.x, acc[8 * j + 4 * q + 1] * rsq * gv.y, acc[8 * j + 4 * q + 2] * rsq * gv.z, acc[8 * j + 4 * q + 3] * rsq * gv.w}; } }
        }
    }
}

#define XB_TMO      128
#define XB_XCNT(j)  (256  + 64 * (j))
#define XB_XSUB(j)  (1280 + 64 * (j))
#define XB_XGEN(j)  (2304 + 64 * (j))
#define XB_TOP      3328
#define XB_TOPGEN   3392
#define XCD_BAR_WORDS 3456
#define XB_SPIN_CAP (1u << 18)
__device__ __forceinline__ unsigned xb_ld(unsigned* p)              { return __hip_atomic_load(p, __ATOMIC_RELAXED, __HIP_MEMORY_SCOPE_AGENT); }
__device__ __forceinline__ unsigned xb_add(unsigned* p, unsigned v) { return __hip_atomic_fetch_add(p, v, __ATOMIC_RELAXED, __HIP_MEMORY_SCOPE_AGENT); }
__device__ __forceinline__ unsigned xb_xcc_id() { return (unsigned)__builtin_amdgcn_s_getreg((3 << 11) | 20) & 0xFu; }
#define XB_SPIN(cond, bar) do { unsigned _sp = 0; while (cond) { __builtin_amdgcn_s_sleep(1); \
    if ((++_sp & 255u) == 0u) { if (xb_ld(&(bar)[XB_TMO])) break; if (_sp > XB_SPIN_CAP) { atomicAdd(&(bar)[XB_TMO], 1u); break; } } } } while (0)
struct XcdBarrier { unsigned* bar; unsigned x; volatile LAS unsigned* st; };
__device__ __forceinline__ XcdBarrier xcd_barrier_post(unsigned* bar, volatile LAS unsigned* st) {
    XcdBarrier b; b.bar = bar; b.x = xb_xcc_id(); b.st = st;
    if (threadIdx.x == 0) (void)xb_add(&bar[XB_XCNT(b.x)], 1u);
    return b;
}
__device__ __forceinline__ void xcd_barrier_complete(unsigned* bar, unsigned x, unsigned& nloc, unsigned& nx) {
    const unsigned G = gridDim.x * gridDim.y * gridDim.z;
    unsigned sum, cnt, mine, sp = 0u;
    for (;;) {
        sum = 0u; cnt = 0u; mine = 0u;
#pragma unroll
        for (unsigned j = 0; j < 16; ++j) { const unsigned c = xb_ld(&bar[XB_XCNT(j)]); sum += c; cnt += (c > 0u) ? 1u : 0u; mine = (j == x) ? c : mine; }
        if (sum == G) break;
        __builtin_amdgcn_s_sleep(1);
        if ((++sp & 255u) == 0u) { if (xb_ld(&bar[XB_TMO])) break; if (sp > XB_SPIN_CAP) { atomicAdd(&bar[XB_TMO], 1u); break; } }
    }
    nloc = mine > 0u ? mine : 1u; nx = cnt > 0u ? cnt : 1u;
}
__device__ __forceinline__ void xcd_barrier(const XcdBarrier& b) {
    asm volatile("s_waitcnt vmcnt(0)" ::: "memory");
    __syncthreads();
    if (threadIdx.x == 0) {
        unsigned* bar = b.bar;
        __builtin_amdgcn_s_waitcnt(0);
        unsigned nloc = b.st[0], nx = b.st[1];
        if (nloc == 0u) { xcd_barrier_complete(bar, b.x, nloc, nx); b.st[0] = nloc; b.st[1] = nx; }
        const unsigned old = xb_add(&bar[XB_XSUB(b.x)], 1u);
        const unsigned gen = old / nloc;
        if (old + 1u == (gen + 1u) * nloc) {
            __builtin_amdgcn_fence(__ATOMIC_RELEASE, "agent");
            asm volatile("s_waitcnt vmcnt(0)" ::: "memory");
            const unsigned og = xb_add(&bar[XB_TOP], 1u);
            const unsigned tg = og / nx;
            if (og + 1u == (tg + 1u) * nx) xb_add(&bar[XB_TOPGEN], 1u);
            else XB_SPIN(xb_ld(&bar[XB_TOPGEN]) == tg, bar);
            __builtin_amdgcn_fence(__ATOMIC_ACQUIRE, "agent");
            xb_add(&bar[XB_XGEN(b.x)], 1u);
            asm volatile("s_waitcnt vmcnt(0)" ::: "memory");
        } else {
            XB_SPIN(xb_ld(&bar[XB_XGEN(b.x)]) == gen, bar);
            __builtin_amdgcn_fence(__ATOMIC_ACQUIRE, "agent");
            asm volatile("s_waitcnt vmcnt(0)" ::: "memory");
        }
    }
    __syncthreads();
}

#ifndef PH_MASK
#define PH_MASK 0xFFFFFFFFu
#endif
#define PH(k) ((PH_MASK >> (k)) & 1u)
#ifndef DUP_MASK
#define DUP_MASK 0u
#endif
#define DUP(k) ((DUP_MASK >> (k)) & 1u)
#define REFRESH() do { F.tid = opaque_i(threadIdx.x); F.lane = F.tid & 63; F.wave = __builtin_amdgcn_readfirstlane(F.tid >> 6); } while (0)
__global__ void __launch_bounds__(NTHREADS, 2) fwd_mega(Args args) {
    extern __shared__ __attribute__((aligned(16))) unsigned char lds_raw[];
    cg::grid_group grid = cg::this_grid();
    Frame F;
    F.lds = (LAS unsigned char*)lds_raw; F.ws = args.ws; F.in = args.in; F.out = args.out;
    F.tid = threadIdx.x; F.lane = F.tid & 63; F.wave = __builtin_amdgcn_readfirstlane(F.tid >> 6); F.G = gridDim.x; F.bid = blockIdx.x;
    unsigned char* ws = args.ws;
    volatile LAS unsigned* bst = (volatile LAS unsigned*)(F.lds + LDS_BYTES - 64);
    if (F.tid < 16) bst[F.tid] = 0u;
    __syncthreads();
    const XcdBarrier xbar = xcd_barrier_post((unsigned*)(ws + WS_CTL) + 1024, bst);
#define GSYNC() do { xcd_barrier(xbar); REFRESH(); } while (0)

    if (PH(0)) { p0_adaln(F); __syncthreads(); p0_cpe(F); }
    if (DUP(0)) { __syncthreads(); p0_adaln(F); __syncthreads(); p0_cpe(F); }
    if (__builtin_expect(args.ws == nullptr, 0)) grid.sync();
    GSYNC();
    if (PH(1)) p1_prologue(F);
    if (DUP(1)) { __syncthreads(); p1_prologue(F); }
    GSYNC();
    if (PH(2)) {
        { pg8::Gemm g{(const bf16*)(ws + WS_XN), (const bf16*)(ws + WS_WIN), 1024}; pg8::StaticOrder So; So.init(T, NPROJ_A, F.G, F.bid);
          pg8::EpiProj E{(bf16*)(ws + WS_PROJ), (float*)(ws + WS_SMALL), (const float*)(ws + WS_BIN), (unsigned char*)(ws + WS_GATE8), 0, -1, 1000};
          pg8::gemm_phase<pg8::EpiProj, pg8::StaticOrder, true, true>(F.lds, g, So, E);
          if (DUP(2)) { __syncthreads(); pg8::gemm_phase<pg8::EpiProj, pg8::StaticOrder, true, true>(F.lds, g, So, E); } }
        __syncthreads();
        { pg8::Gemm g{(const bf16*)(ws + WS_OY), (const bf16*)(ws + WS_WIN + 4 * MiB), 1024}; pg8::StaticOrder So; So.init(T, NPROJ_B, F.G, F.bid);
          pg8::EpiProj E{(bf16*)(ws + WS_PROJ) + NPROJ_A, (float*)(ws + WS_SMALL), (const float*)(ws + WS_BIN) + NPROJ_A, (unsigned char*)(ws + WS_GATE8), NPROJ_A, 5, 6};
          pg8::gemm_phase<pg8::EpiProj, pg8::StaticOrder, true, true, true>(F.lds, g, So, E);
          if (DUP(20)) { __syncthreads(); pg8::gemm_phase<pg8::EpiProj, pg8::StaticOrder, true, true, true>(F.lds, g, So, E); } }
    }
    GSYNC();
    if (PH(3)) { p3_compress(F); __syncthreads(); }
    if (DUP(3)) { p3_compress(F); __syncthreads(); }
    REFRESH(); if (PH(4)) { p3_mlstate(F); __syncthreads(); }
    if (DUP(4)) { p3_mlstate(F); __syncthreads(); }
    GSYNC();
    REFRESH(); if (PH(7)) p4_mlscan(F);
    if (DUP(7)) p4_mlscan(F);
    GSYNC();
    if (PH(8)) { p5_attn(F, 0); __syncthreads(); }
    if (DUP(8)) { p5_attn(F, 1); __syncthreads(); }
    REFRESH(); if (PH(9)) p5_mlout(F);
    if (DUP(9)) { __syncthreads(); p5_mlout(F); }
    GSYNC();
    if (DUP(21)) { GSYNC(); GSYNC(); GSYNC(); GSYNC(); }
    if (PH(11)) {
        pg8::StaticOrder So; So.init(T, 1024, F.G, F.bid);
        for (int rep7 = 0; rep7 < (DUP(11) ? 2 : 1); ++rep7) {
        { pg8::Gemm g{(const bf16*)(ws + WS_OY), (const bf16*)(ws + WS_WPA), 1024};
          pg8::EpiMix2 E{(bf16*)(ws + WS_XN), (const unsigned char*)(ws + WS_GATE8)};
          pg8::gemm_phase<pg8::EpiMix2, pg8::StaticOrder, true, true>(F.lds, g, So, E); }
        __syncthreads(); }
    }
    GSYNC();
    if (PH(12)) {
        pg8::Gemm g{(const bf16*)(ws + WS_XN), (const bf16*)(ws + WS_WOUT), 1024}; pg8::StaticOrder So; So.init(T, 1024, F.G, F.bid);
        pg8::EpiWout E{F.in[0], (bf16*)(ws + WS_OY), (const float*)(ws + WS_MOD) + 2 * 1024};
        pg8::gemm_phase<pg8::EpiWout, pg8::StaticOrder, true, true, true>(F.lds, g, So, E);
        if (DUP(12)) { __syncthreads(); pg8::gemm_phase<pg8::EpiWout, pg8::StaticOrder, true, true, true>(F.lds, g, So, E); }
        if (DUP(19)) { __syncthreads(); pg8::EpiNull En{(float*)(ws + WS_ACT)}; pg8::gemm_phase<pg8::EpiNull, pg8::StaticOrder, true, true, true>(F.lds, g, So, En); }
    }
    GSYNC();
    if (PH(13)) p9_route(F, false);
    if (DUP(13)) p9_route(F, true);
    GSYNC();
    if (PH(14)) p10_gather(F);
    if (DUP(14)) { __syncthreads(); p10_gather(F); }
    GSYNC();
    if (PH(15)) {
        const int* blke = (const int*)(ws + WS_BLKE); const int nblk = __builtin_amdgcn_readfirstlane(blke[1000]);
        { pg8::MoeOrderG Mo; Mo.blk_e = blke; Mo.rows = (const int*)(ws + WS_ROWIDX); Mo.nblk = nblk; Mo.x = F.bid & 7; Mo.y = F.bid >> 3; Mo.ny = F.G >> 3; Mo.nN = 8; Mo.nPerE = 2048;
          pg8::Gemm g{(const bf16*)(ws + WS_XN), (const bf16*)(ws + WS_WUP), 1024};
          pg8::EpiSwiglu E{(bf16*)(ws + WS_ACT), F.in[27]};
          pg8::gemm_phase<pg8::EpiSwiglu, pg8::MoeOrderG, true, true, true>(F.lds, g, Mo, E);
          if (DUP(17)) { __syncthreads(); pg8::gemm_phase<pg8::EpiSwiglu, pg8::MoeOrderG, true, true, true>(F.lds, g, Mo, E); } }
        pg8::MoeOrder Mo; Mo.blk_e = blke; Mo.rows = nullptr; Mo.nblk = nblk; Mo.x = F.bid & 7; Mo.y = F.bid >> 3; Mo.ny = F.G >> 3;
        GSYNC();
        { Mo.nN = 4; Mo.nPerE = 1024;
          pg8::Gemm g{(const bf16*)(ws + WS_ACT), (const bf16*)(ws + WS_WDN), 1024};
          pg8::EpiDown E{(bf16*)(ws + WS_PROJ), F.in[29]};
          pg8::gemm_phase<pg8::EpiDown, pg8::MoeOrder, true, true, true>(F.lds, g, Mo, E);
          if (DUP(18)) { __syncthreads(); pg8::gemm_phase<pg8::EpiDown, pg8::MoeOrder, true, true, true>(F.lds, g, Mo, E); } }
    }
    GSYNC();
    if (PH(16)) p13_final(F, false);
    if (DUP(16)) p13_final(F, true);
}

extern "C" void kernel_launch(void* const* d_in, const int* in_sizes, int n_in, void* d_out, int out_size, void* d_ws, size_t ws_size, hipStream_t stream) {
    static int grid = 0;
    if (grid == 0) {
        if (n_in != 31 || out_size != T * D || ws_size < WS_END) { fprintf(stderr, "kernel_launch: unexpected problem (n_in %d out %d ws %zu)\n", n_in, out_size, ws_size); grid = -1; return; }
        int dev = 0, cus = 0, per_cu = 0;
        if (hipGetDevice(&dev) != hipSuccess || hipDeviceGetAttribute(&cus, hipDeviceAttributeMultiprocessorCount, dev) != hipSuccess) { grid = -1; return; }
        if (hipFuncSetAttribute((const void*)fwd_mega, hipFuncAttributeMaxDynamicSharedMemorySize, LDS_BYTES) != hipSuccess) { fprintf(stderr, "kernel_launch: hipFuncSetAttribute failed\n"); grid = -1; return; }
        if (hipOccupancyMaxActiveBlocksPerMultiprocessor(&per_cu, (const void*)fwd_mega, NTHREADS, LDS_BYTES) != hipSuccess || per_cu < 1) { fprintf(stderr, "kernel_launch: occupancy query says %d\n", per_cu); (void)hipGetLastError(); grid = -1; return; }
        grid = cus;
        if (grid % 8 != 0) grid -= grid % 8;
        fprintf(stderr, "kernel_launch: cus %d per_cu %d grid %d ws %zu\n", cus, per_cu, grid, ws_size);
    }
    if (grid < 0) return;
    (void)hipMemsetAsync((char*)d_ws + WS_CTL, 0, 32768, stream);
    Args a{};
    for (int i = 0; i < 31; ++i) a.in[i] = (const float*)d_in[i];
    a.out = (float*)d_out; a.ws = (unsigned char*)d_ws;
    void* kargs[] = {&a};
    hipError_t e = hipLaunchCooperativeKernel((const void*)fwd_mega, dim3(grid), dim3(NTHREADS), kargs, LDS_BYTES, stream);
    if (e != hipSuccess) fprintf(stderr, "kernel_launch: cooperative launch failed: %s\n", hipGetErrorString(e));
}
```

```cpp
#include <hip/hip_runtime.h>
#include <hip/hip_cooperative_groups.h>
#include <cstdio>
#include <cstdint>
namespace cg = cooperative_groups;

#define LAS __attribute__((address_space(3)))
typedef unsigned short bf16;
typedef float f32x4 __attribute__((ext_vector_type(4)));
typedef float f32x2 __attribute__((ext_vector_type(2)));
typedef unsigned u32x4 __attribute__((ext_vector_type(4)));
typedef unsigned u32x2 __attribute__((ext_vector_type(2)));
typedef short bf16x8 __attribute__((ext_vector_type(8)));
typedef short s16x4 __attribute__((ext_vector_type(4)));

constexpr int NB = 16, S = 2048, D = 1024, T = NB * S;
constexpr int NPROJ = 4608;
constexpr int C_Q = 512, C_KCMP = 1024, C_VCMP = 1152, C_KSLC = 1280, C_VSLC = 1408, C_KWIN = 1536, C_VWIN = 1664;
constexpr int C_XM = 0, C_SMALL = 1792, C_OPRE = 2048, C_GA = 2560, C_GB = 3584;
constexpr int NPROJ_A = 512, NPROJ_B = 4096;
constexpr int PP = 2048, GP = 2560;
constexpr int G_OPRE = 0, G_GA = 512, G_GB = 1536;
constexpr int IN_W = 4384;
constexpr int NCMP = 127;
constexpr int NEXP = 32, PMAX = 544 * 256;
constexpr int NTHREADS = 512, NWAVES = 8;
constexpr int LDS_BYTES = 147456;

constexpr size_t MiB = 1u << 20;
constexpr size_t WS_CTL = 0;
constexpr size_t WS_MODP = 1 * MiB;
constexpr size_t WS_MOD = 7 * MiB;
constexpr size_t WS_BIN = 8 * MiB;
constexpr size_t WS_BLKE = 8 * MiB + 64 * 1024;
constexpr size_t WS_OFFS = 8 * MiB + 128 * 1024;
constexpr size_t WS_SMALL = 9 * MiB;
constexpr size_t WS_RE = 13 * MiB;
constexpr size_t WS_RW = WS_RE + 512 * 1024;
constexpr size_t WS_RS = WS_RW + 512 * 1024;
constexpr size_t WS_DEST = WS_RS + 512 * 1024;
constexpr size_t WS_ROWIDX = 17 * MiB;
constexpr size_t WS_SELM = 15 * MiB;
constexpr size_t WS_KC = 16 * MiB;
constexpr size_t WS_KCB = 16 * MiB;
constexpr size_t WS_W1T = 21 * MiB;
constexpr size_t WS_W2T = 22 * MiB;
constexpr size_t WS_CPE = 22 * MiB + 64 * 1024;
constexpr size_t WS_WQT = 23 * MiB;
constexpr size_t WS_RWT = 23 * MiB + 512 * 1024;
constexpr size_t WS_NLOC = 19 * MiB;
constexpr size_t WS_MLOC = 19 * MiB + 512 * 1024;
constexpr size_t WS_FLAST = WS_MLOC + 4096;
constexpr size_t WS_MIN = WS_FLAST + 4096;
constexpr size_t WS_NIN = 20 * MiB;
constexpr size_t WS_WIN = 24 * MiB;
constexpr size_t WS_WPA = 33 * MiB, WS_WOUT = 35 * MiB;
constexpr size_t WS_WUP = 40 * MiB;
constexpr size_t WS_WDN = 168 * MiB;
constexpr size_t WS_XN = 232 * MiB;
constexpr size_t WS_PROJ = 296 * MiB;
constexpr size_t WS_GATE8 = 424 * MiB;
constexpr size_t WS_QML = 584 * MiB, WS_KML = 616 * MiB, WS_VML = 648 * MiB;
constexpr size_t WS_CLOC = 680 * MiB, WS_CIN = 744 * MiB;
constexpr size_t WS_OACC = 808 * MiB;
constexpr size_t WS_ACT = 584 * MiB;
constexpr size_t WS_OY = 872 * MiB;
constexpr size_t WS_END = 936 * MiB;

__device__ __forceinline__ unsigned f2bf(float f) { unsigned u = __builtin_bit_cast(unsigned, f); return (u + 0x7fffu + ((u >> 16) & 1u)) >> 16; }
typedef __bf16 bf16x2_t __attribute__((ext_vector_type(2)));
__device__ __forceinline__ unsigned pk2(float lo, float hi) { const f32x2 v = {lo, hi}; return __builtin_bit_cast(unsigned, __builtin_convertvector(v, bf16x2_t)); }
__device__ __forceinline__ float bf2f(bf16 v) { return __builtin_bit_cast(float, (unsigned)v << 16); }
__device__ __forceinline__ float bflo(unsigned w) { return __builtin_bit_cast(float, w << 16); }
__device__ __forceinline__ float bfhi(unsigned w) { return __builtin_bit_cast(float, w & 0xffff0000u); }
__device__ __forceinline__ float sigmoidf_(float x) { return __builtin_amdgcn_rcpf(1.0f + __expf(-x)); }
__device__ __forceinline__ float wave_sum(float v) {
#pragma unroll
    for (int o = 1; o < 64; o <<= 1) v += __shfl_xor(v, o);
    return v;
}
#define LDS_WAIT() asm volatile("s_waitcnt lgkmcnt(0)" ::: "memory")
__device__ __forceinline__ unsigned pk4_fp8(float a, float b, float c, float d) { int w = 0; w = __builtin_amdgcn_cvt_pk_fp8_f32(a, b, w, false); w = __builtin_amdgcn_cvt_pk_fp8_f32(c, d, w, true); return (unsigned)w; }
__device__ __forceinline__ int opaque_i(int x) { asm volatile("" : "+v"(x)); return x; }

namespace pg8 {
constexpr int BM = 256, BK = 64, HALF = 128, HTB = HALF * BK * 2, STAGE_BYTES = 8 * HTB, NXCD = 8, WGM = 8;
__host__ __device__ __forceinline__ int lds_byte(int r, int c) { const int st = (r >> 4) * 2 + (c >> 5), rr = r & 15, cc = c & 31, ob = rr * 64 + cc * 2; return st * 1024 + (ob ^ (((ob >> 9) & 1) << 5)); }
__host__ __device__ __forceinline__ void stage_rc(int b, int& R, int& C) { const int st = b / 1024, sb = b % 1024, swz = sb ^ (((sb >> 9) & 1) << 5); R = (st >> 1) * 16 + swz / 64; C = (st & 1) * 32 + (swz % 64) / 2; }
__host__ __device__ __forceinline__ int perm32(int rho) { const int n = rho >> 4, i = rho & 15; return 8 * (i >> 2) + 4 * n + (i & 3); }

struct Unit { int pm, pn, brow, e; };
struct Gemm { const bf16* A; const bf16* Bt; int K; };

struct StaticOrder {
    static constexpr bool GATHER = false;
    int nM, nN, nwg, G, c;
    __device__ void init(int M, int N, int G_, int c_) { nM = M / BM; nN = N / BM; nwg = nM * nN; G = G_; c = c_; }
    __device__ bool next(int i, Unit& u) const {
        const long L = (long)i * G + c; if (L >= nwg) return false;
        int wgid = (int)L; { const int q = nwg / NXCD, r = nwg % NXCD, xcd = wgid % NXCD, off = wgid / NXCD; wgid = (xcd < r ? xcd * (q + 1) : r * (q + 1) + (xcd - r) * q) + off; }
        const int nig = WGM * nN, gid = wgid / nig, fm = gid * WGM, gsz = (nM - fm) < WGM ? (nM - fm) : WGM;
        u.pm = fm + ((wgid % nig) % gsz); u.pn = (wgid % nig) / gsz; u.brow = u.pn * BM; u.e = 0; return true;
    }
};
template <bool GATHER_> struct MoeOrderT {
    static constexpr bool GATHER = GATHER_;
    const LAS int* blk_e; const int* rows; int nblk, nN, nPerE, x, y, ny;
    __device__ bool next(int i, Unit& u) const {
        const int l = i * ny + y, rb = l / nN, pn = l - rb * nN, pm = rb * 8 + x;
        if (pm >= nblk) return false;
        const int e = __builtin_amdgcn_readfirstlane(blk_e[pm]);
        u.pm = pm; u.pn = pn; u.e = e; u.brow = e * nPerE + pn * BM; return true;
    }
};
typedef MoeOrderT<false> MoeOrder;
typedef MoeOrderT<true> MoeOrderG;

__device__ __forceinline__ unsigned cvt_pk_bf16(float lo, float hi) { unsigned r; asm volatile("v_cvt_pk_bf16_f32 %0, %1, %2" : "=v"(r) : "v"(lo), "v"(hi)); return r; }

typedef int v8i __attribute__((ext_vector_type(8)));
typedef int v4i __attribute__((ext_vector_type(4)));
template <class Epi, class Sched, bool ALIGN_EPI, bool SP2, bool FP8 = false>
__device__ __forceinline__ void gemm_phase(LAS unsigned char* lds, const Gemm g, const Sched& S, const Epi& E) {
    constexpr int ESZ = FP8 ? 1 : 2;
    const int tid = opaque_i(threadIdx.x), wid = __builtin_amdgcn_readfirstlane(tid >> 6), lane = tid & 63, wr = wid >> 2, wc = wid & 3, fr = lane & 15, fq = lane >> 4;
    const int K = g.K, nt = (K * ESZ) / 128;
    unsigned voffA[2], voffB[2];
#pragma unroll
    for (int i = 0; i < 2; ++i) { int R, C; stage_rc(tid * 16 + i * 8192, R, C); const int Rb = Epi::PERM ? ((R & ~31) + perm32(R & 31)) : R;
        voffA[i] = (unsigned)(R * K * ESZ + C * 2); voffB[i] = (unsigned)(Rb * K * ESZ + C * 2); }
    const size_t kstep = (size_t)(BK * 2);
    const size_t hstep = (size_t)HALF * K * ESZ;
    const size_t tstep = 2 * hstep;
    const size_t rstep = (size_t)K * ESZ;
    const unsigned ldsw = (unsigned)wid * 1024u;
    const int aoff = lds_byte(wr * 64 + fr, fq * 8), boff = lds_byte(wc * 32 + fr, fq * 8);
#define PG8_SA(b, h) (((b) * 2 + (h)) * HTB)
#define PG8_SB(b, h) ((4 + (b) * 2 + (h)) * HTB)
#define PG8_STAGE(bufoff, gbase, voff) do { _Pragma("unroll") for (int _i = 0; _i < 2; ++_i) \
        __builtin_amdgcn_global_load_lds((const unsigned*)((const char*)(gbase) + (voff)[_i]), (LAS unsigned*)(lds + (bufoff) + ldsw + _i * 8192), 16, 0, 0); } while (0)
#define PG8_LDA(dst, b, h) do { _Pragma("unroll") for (int m = 0; m < 4; ++m) { const v4i lo_ = *(const LAS v4i*)(lds + PG8_SA(b, h) + aoff + m * 2048), hi_ = *(const LAS v4i*)(lds + PG8_SA(b, h) + aoff + m * 2048 + 1024); dst[m] = __builtin_shufflevector(lo_, hi_, 0, 1, 2, 3, 4, 5, 6, 7); } } while (0)
#define PG8_LDB(dst, b, h) do { _Pragma("unroll") for (int n = 0; n < 2; ++n) { const v4i lo_ = *(const LAS v4i*)(lds + PG8_SB(b, h) + boff + n * 2048), hi_ = *(const LAS v4i*)(lds + PG8_SB(b, h) + boff + n * 2048 + 1024); dst[n] = __builtin_shufflevector(lo_, hi_, 0, 1, 2, 3, 4, 5, 6, 7); } } while (0)
#define PG8_MMA(ai, bj, At, Bt) do { __builtin_amdgcn_s_setprio(1); _Pragma("unroll") for (int m = 0; m < 4; ++m) _Pragma("unroll") for (int n = 0; n < 2; ++n) { \
        if constexpr (FP8) asm volatile("v_mfma_scale_f32_16x16x128_f8f6f4 %0, %1, %2, %0, %3, %4 op_sel_hi:[0,0,0]" : "+v"(acc[ai][bj][m][n]) : "v"(Bt[n]), "v"(At[m]), "v"(sclW), "v"(sclX)); \
        else { acc[ai][bj][m][n] = __builtin_amdgcn_mfma_f32_16x16x32_bf16(__builtin_bit_cast(bf16x8, __builtin_shufflevector(Bt[n], Bt[n], 0, 1, 2, 3)), __builtin_bit_cast(bf16x8, __builtin_shufflevector(At[m], At[m], 0, 1, 2, 3)), acc[ai][bj][m][n], 0, 0, 0); \
               acc[ai][bj][m][n] = __builtin_amdgcn_mfma_f32_16x16x32_bf16(__builtin_bit_cast(bf16x8, __builtin_shufflevector(Bt[n], Bt[n], 4, 5, 6, 7)), __builtin_bit_cast(bf16x8, __builtin_shufflevector(At[m], At[m], 4, 5, 6, 7)), acc[ai][bj][m][n], 0, 0, 0); } } __builtin_amdgcn_s_setprio(0); } while (0)
#define PG8_WAIT_V(n) asm volatile("s_waitcnt vmcnt(" #n ")" ::: "memory")
#define PG8_WAIT_L(n) asm volatile("s_waitcnt lgkmcnt(" #n ")" ::: "memory")
#define PG8_BAR __builtin_amdgcn_s_barrier()
#define PG8_SCHED __builtin_amdgcn_sched_barrier(0)
    int sclW = 0x7a7a7a7a, sclX = 0x7f7f7f7f; asm volatile("" : "+v"(sclW), "+v"(sclX));
    Unit cur, nxt; int ui = 0;
    if (!S.next(0, cur)) return;
    unsigned vC[2][2], vN[2][2];
#define PG8_ROWOFFS(dst, pm_) do { if constexpr (Sched::GATHER) { _Pragma("unroll") for (int _h = 0; _h < 2; ++_h) _Pragma("unroll") for (int _i = 0; _i < 2; ++_i) { int R_, C_; stage_rc(tid * 16 + _i * 8192, R_, C_); \
        dst[_h][_i] = (unsigned)(S.rows[(pm_) * BM + _h * HALF + R_] * K * ESZ + C_ * 2); } } } while (0)
#define PG8_STAGE_A(bufoff, plain_ptr, koff, h, nx) do { if constexpr (Sched::GATHER) { _Pragma("unroll") for (int _i = 0; _i < 2; ++_i) { const unsigned vo_ = (nx) ? vN[h][_i] : vC[h][_i]; \
        __builtin_amdgcn_global_load_lds((const unsigned*)((const char*)g.A + (koff) + vo_), (LAS unsigned*)(lds + (bufoff) + ldsw + _i * 8192), 16, 0, 0); } } \
        else { PG8_STAGE(bufoff, plain_ptr, voffA); } } while (0)
    PG8_ROWOFFS(vC, cur.pm);
#define PG8_ROWDMA(pm_) do { if constexpr (Sched::GATHER) { __builtin_amdgcn_global_load_lds((const unsigned*)(S.rows + (size_t)(pm_) * BM + (wid & 3) * 64 + lane), (LAS unsigned*)(lds + 133120 + (wid & 3) * 256), 4, 0, 0); } } while (0)
#define PG8_ROWLDS(dst) do { if constexpr (Sched::GATHER) { _Pragma("unroll") for (int _h = 0; _h < 2; ++_h) _Pragma("unroll") for (int _i = 0; _i < 2; ++_i) { int R_, C_; stage_rc(tid * 16 + _i * 8192, R_, C_); \
        dst[_h][_i] = (unsigned)(*(const LAS int*)(lds + 133120 + (_h * HALF + R_) * 4) * K * ESZ + C_ * 2); } } } while (0)
    const LAS unsigned char* bl = lds + 131072 + wid * 256;
#define PG8_BIAS(u_) do { if constexpr (Epi::LBIAS) { const float* bp_ = E.bias_ptr(u_) + wc * 32 + (lane & 31) + (lane >> 5) * Epi::BJS; \
        __builtin_amdgcn_global_load_lds((const unsigned*)bp_, (LAS unsigned*)(lds + 131072 + wid * 256), 4, 0, 0); } } while (0)
    PG8_BIAS(cur);
    f32x4 acc[2][2][4][2];
#pragma unroll
    for (int a = 0; a < 2; ++a)
#pragma unroll
        for (int b = 0; b < 2; ++b)
#pragma unroll
            for (int m = 0; m < 4; ++m)
#pragma unroll
                for (int n = 0; n < 2; ++n) acc[a][b][m][n] = (f32x4){0.f, 0.f, 0.f, 0.f};
    v8i At[4], B0[2], B1[2];
    const char* cA = (const char*)g.A + (size_t)cur.pm * tstep; const char* cB = (const char*)g.Bt + (size_t)cur.brow * rstep;
    if constexpr (SP2) {
        PG8_STAGE(PG8_SB(0, 0), cB, voffB); PG8_STAGE(PG8_SB(0, 1), cB + hstep, voffB); PG8_STAGE_A(PG8_SA(0, 0), cA, 0, 0, false); PG8_STAGE_A(PG8_SA(0, 1), cA + hstep, 0, 1, false);
        if (wr == 1) PG8_BAR;
        PG8_WAIT_V(2); PG8_BAR;
        PG8_STAGE(PG8_SB(1, 0), cB + kstep, voffB); PG8_STAGE_A(PG8_SA(1, 0), cA + kstep, kstep, 0, false); PG8_STAGE(PG8_SB(1, 1), cB + hstep + kstep, voffB);
        PG8_WAIT_V(6); PG8_BAR;
    } else {
        PG8_STAGE(PG8_SB(0, 0), cB, voffB); PG8_STAGE(PG8_SA(0, 0), cA, voffA); PG8_STAGE(PG8_SB(0, 1), cB + hstep, voffB); PG8_STAGE(PG8_SA(0, 1), cA + hstep, voffA);
        if (wr == 1) PG8_BAR;
        PG8_WAIT_V(4); PG8_BAR;
        PG8_STAGE(PG8_SB(1, 0), cB + kstep, voffB); PG8_STAGE(PG8_SA(1, 0), cA + kstep, voffA); PG8_STAGE(PG8_SB(1, 1), cB + hstep + kstep, voffB);
        PG8_WAIT_V(6); PG8_BAR;
    }
    for (;;) {
        const bool has_next = S.next(ui + 1, nxt);
        if constexpr (Sched::GATHER) { if (has_next) { PG8_ROWDMA(nxt.pm); } }
        const char* nA = has_next ? (const char*)g.A + (size_t)nxt.pm * tstep : cA; const char* nB = has_next ? (const char*)g.Bt + (size_t)nxt.brow * rstep : cB;
#pragma nounroll
        for (int t = 0; t < nt; t += 2) {
            if constexpr (Epi::MIDK > 0) { if (t == Epi::MIDK) E.mid(acc, cur, wr, wc, fr, fq); }
            const bool last = (t == nt - 2);
            if constexpr (Sched::GATHER) { PG8_ROWLDS(vN); if (!has_next) { vN[0][0] = vC[0][0]; vN[0][1] = vC[0][1]; vN[1][0] = vC[1][0]; vN[1][1] = vC[1][1]; } }
            const char* a1 = cA + (size_t)(t + 1) * kstep;
            const char* a2 = last ? nA : cA + (size_t)(t + 2) * kstep; const char* b2 = last ? nB : cB + (size_t)(t + 2) * kstep;
            const char* a3 = a2 + kstep; const char* b3 = b2 + kstep;
            const size_t k1 = (size_t)(t + 1) * kstep, k2 = last ? 0 : (size_t)(t + 2) * kstep;
            if constexpr (SP2) {
            PG8_LDB(B0, 0, 0); PG8_LDB(B1, 0, 1); PG8_SCHED; PG8_LDA(At, 0, 0); PG8_STAGE_A(PG8_SA(1, 1), a1 + hstep, k1, 1, false);
            PG8_WAIT_V(8); PG8_WAIT_L(0); PG8_BAR; PG8_MMA(0, 0, At, B0); PG8_MMA(0, 1, At, B1); PG8_BAR; PG8_SCHED;
            PG8_LDA(At, 0, 1); PG8_STAGE(PG8_SB(0, 0), b2, voffB); PG8_STAGE(PG8_SB(0, 1), b2 + hstep, voffB); PG8_STAGE_A(PG8_SA(0, 0), a2, k2, 0, last);
            PG8_WAIT_V(8); PG8_WAIT_L(0); PG8_BAR; PG8_MMA(1, 0, At, B0); PG8_MMA(1, 1, At, B1); PG8_BAR; PG8_SCHED;
            PG8_LDB(B0, 1, 0); PG8_LDB(B1, 1, 1); PG8_SCHED; PG8_LDA(At, 1, 0); PG8_STAGE_A(PG8_SA(0, 1), a2 + hstep, k2, 1, last);
            PG8_WAIT_V(8); PG8_WAIT_L(0); PG8_BAR; PG8_MMA(0, 0, At, B0); PG8_MMA(0, 1, At, B1); PG8_BAR; PG8_SCHED;
            PG8_LDA(At, 1, 1); PG8_STAGE(PG8_SB(1, 0), b3, voffB); PG8_STAGE(PG8_SB(1, 1), b3 + hstep, voffB); PG8_STAGE_A(PG8_SA(1, 0), a3, k2 + kstep, 0, last);
            PG8_WAIT_V(8); PG8_WAIT_L(0); PG8_BAR; PG8_MMA(1, 0, At, B0); PG8_MMA(1, 1, At, B1); PG8_BAR; PG8_SCHED;
            } else {
            PG8_LDB(B0, 0, 0); PG8_SCHED; PG8_LDA(At, 0, 0); PG8_STAGE(PG8_SA(1, 1), a1 + hstep, voffA);
            PG8_WAIT_L(8); PG8_BAR; PG8_WAIT_L(0); PG8_MMA(0, 0, At, B0); PG8_BAR; PG8_SCHED;
            PG8_LDB(B1, 0, 1); PG8_STAGE(PG8_SB(0, 0), b2, voffB);
            PG8_BAR; PG8_WAIT_L(0); PG8_MMA(0, 1, At, B1); PG8_BAR;
            PG8_LDA(At, 0, 1); PG8_STAGE(PG8_SA(0, 0), a2, voffA);
            PG8_BAR; PG8_WAIT_L(0); PG8_MMA(1, 0, At, B0); PG8_BAR; PG8_SCHED;
            PG8_STAGE(PG8_SB(0, 1), b2 + hstep, voffB);
            PG8_WAIT_V(6); PG8_BAR; PG8_MMA(1, 1, At, B1); PG8_BAR;
            PG8_LDB(B0, 1, 0); PG8_SCHED; PG8_LDA(At, 1, 0); PG8_STAGE(PG8_SA(0, 1), a2 + hstep, voffA);
            PG8_WAIT_L(8); PG8_BAR; PG8_WAIT_L(0); PG8_MMA(0, 0, At, B0); PG8_BAR; PG8_SCHED;
            PG8_LDB(B1, 1, 1); PG8_STAGE(PG8_SB(1, 0), b3, voffB);
            PG8_BAR; PG8_WAIT_L(0); PG8_MMA(0, 1, At, B1); PG8_BAR;
            PG8_LDA(At, 1, 1); PG8_STAGE(PG8_SA(1, 0), a3, voffA);
            PG8_BAR; PG8_WAIT_L(0); PG8_MMA(1, 0, At, B0); PG8_BAR; PG8_SCHED;
            PG8_STAGE(PG8_SB(1, 1), b3 + hstep, voffB);
            PG8_WAIT_V(6); PG8_BAR; PG8_MMA(1, 1, At, B1); PG8_BAR;
            }
        }
        if constexpr (ALIGN_EPI) { if (wr == 0) PG8_BAR; }
        if constexpr (FP8) asm volatile("s_nop 15\n\ts_nop 15" ::: "memory");
        E(acc, cur, wr, wc, fr, fq, bl);
        if (!has_next) break;
#pragma unroll
        for (int a = 0; a < 2; ++a)
#pragma unroll
            for (int b = 0; b < 2; ++b)
#pragma unroll
                for (int m = 0; m < 4; ++m)
#pragma unroll
                    for (int n = 0; n < 2; ++n) acc[a][b][m][n] = (f32x4){0.f, 0.f, 0.f, 0.f};
        cur = nxt; cA = nA; cB = nB; ++ui;
        PG8_BIAS(cur);
        if constexpr (Sched::GATHER) { vC[0][0] = vN[0][0]; vC[0][1] = vN[0][1]; vC[1][0] = vN[1][0]; vC[1][1] = vN[1][1]; }
        if constexpr (ALIGN_EPI) { if (wr == 1) PG8_BAR; }
    }
    PG8_WAIT_V(0);
    if constexpr (!ALIGN_EPI) { if (wr == 0) PG8_BAR; }
    PG8_BAR;
#undef PG8_SA
#undef PG8_SB
#undef PG8_STAGE
#undef PG8_STAGE_A
#undef PG8_ROWOFFS
#undef PG8_ROWDMA
#undef PG8_ROWLDS
#undef PG8_BIAS
#undef PG8_LDA
#undef PG8_LDB
#undef PG8_MMA
#undef PG8_WAIT_V
#undef PG8_WAIT_L
#undef PG8_BAR
#undef PG8_SCHED
}

typedef const f32x4 (&AccRef)[2][2][4][2];
struct EpiProj {
    static constexpr int MIDK = 0;
    static constexpr bool PERM = true;
    static constexpr bool LBIAS = true; static constexpr int BJS = HALF;
    __device__ __forceinline__ const float* bias_ptr(const Unit& u) const { return bias + u.pn * BM; }
    bf16* O; float* small; const float* bias; unsigned char* G8; int coloff, smtile, gtile;
    __device__ __forceinline__ void operator()(AccRef acc, const Unit& u, int wr, int wc, int fr, int fq, const LAS unsigned char* bl) const {
        const int row0 = u.pm * BM + wr * 64 + fr, col0 = u.pn * BM + wc * 32 + 8 * fq;
        f32x4 bv[2][2];
#pragma unroll
        for (int bj = 0; bj < 2; ++bj)
#pragma unroll
            for (int n = 0; n < 2; ++n) bv[bj][n] = *(const LAS f32x4*)(bl + bj * 128 + fq * 32 + n * 16);
        const bool sm = (u.pn == smtile) && (wc == 0);
        const bool tog = u.pn >= gtile;
#pragma unroll
        for (int ai = 0; ai < 2; ++ai)
#pragma unroll
            for (int m = 0; m < 4; ++m) { const int row = row0 + ai * HALF + m * 16; bf16* rowp = O + (size_t)row * PP + col0;
                unsigned char* gp = G8 + (size_t)row * GP + (col0 - gtile * BM);
#pragma unroll
                for (int bj = 0; bj < 2; ++bj) { const f32x4 v0 = acc[ai][bj][m][0] + bv[bj][0], v1 = acc[ai][bj][m][1] + bv[bj][1];
                    if (tog) { u32x2 w8; w8.x = pk4_fp8(v0[0], v0[1], v0[2], v0[3]); w8.y = pk4_fp8(v1[0], v1[1], v1[2], v1[3]); *(u32x2*)(gp + bj * HALF) = w8; }
                    else { u32x4 w; w.x = cvt_pk_bf16(v0[0], v0[1]); w.y = cvt_pk_bf16(v0[2], v0[3]); w.z = cvt_pk_bf16(v1[0], v1[1]); w.w = cvt_pk_bf16(v1[2], v1[3]);
                        *(u32x4*)(rowp + bj * HALF) = w; }
                    if (bj == 0 && sm) { *(f32x4*)(small + (size_t)row * 32 + 8 * fq) = v0; *(f32x4*)(small + (size_t)row * 32 + 8 * fq + 4) = v1; } } }
    }
};
struct EpiMix2 {
    static constexpr int MIDK = 8;
    static constexpr bool PERM = true;
    static constexpr bool LBIAS = false; static constexpr int BJS = 0;
    bf16* O; const unsigned char* g8;
    __device__ __forceinline__ void mid(f32x4 (&acc)[2][2][4][2], const Unit& u, int wr, int wc, int fr, int fq) const {
        int z = 0; asm volatile("" : "+v"(z));
        const int row0 = u.pm * BM + wr * 64 + fr + z, col0 = u.pn * BM + wc * 32 + 8 * fq;
#pragma unroll
        for (int ai = 0; ai < 2; ++ai) {
            u32x2 ga8[4][2], gb8[4][2];
#pragma unroll
            for (int m = 0; m < 4; ++m) { const unsigned char* gp = g8 + (size_t)(row0 + ai * HALF + m * 16) * GP + col0;
#pragma unroll
                for (int bj = 0; bj < 2; ++bj) { ga8[m][bj] = *(const u32x2*)(gp + G_GA + bj * HALF); gb8[m][bj] = *(const u32x2*)(gp + G_GB + bj * HALF); } }
            __builtin_amdgcn_sched_barrier(0);
#pragma unroll
            for (int m = 0; m < 4; ++m) {
#pragma unroll
                for (int bj = 0; bj < 2; ++bj) { const u32x2 ga = ga8[m][bj], gb = gb8[m][bj];
                    float fa[8], fb[8]; { const f32x2 a0 = __builtin_amdgcn_cvt_pk_f32_fp8((int)ga.x, false), a1 = __builtin_amdgcn_cvt_pk_f32_fp8((int)ga.x, true), a2 = __builtin_amdgcn_cvt_pk_f32_fp8((int)ga.y, false), a3 = __builtin_amdgcn_cvt_pk_f32_fp8((int)ga.y, true);
                        const f32x2 b0 = __builtin_amdgcn_cvt_pk_f32_fp8((int)gb.x, false), b1 = __builtin_amdgcn_cvt_pk_f32_fp8((int)gb.x, true), b2 = __builtin_amdgcn_cvt_pk_f32_fp8((int)gb.y, false), b3 = __builtin_amdgcn_cvt_pk_f32_fp8((int)gb.y, true);
                        fa[0] = a0.x; fa[1] = a0.y; fa[2] = a1.x; fa[3] = a1.y; fa[4] = a2.x; fa[5] = a2.y; fa[6] = a3.x; fa[7] = a3.y; fb[0] = b0.x; fb[1] = b0.y; fb[2] = b1.x; fb[3] = b1.y; fb[4] = b2.x; fb[5] = b2.y; fb[6] = b3.x; fb[7] = b3.y; }
                    float r[8];
#define MIXR(i, av, bv) r[i] = (1.0f + fminf(__expf(-(bv)), 1e20f)) * __builtin_amdgcn_rcpf(1.0f + __expf(-(av)))
                    MIXR(0, fa[0], fb[0]); MIXR(1, fa[1], fb[1]); MIXR(2, fa[2], fb[2]); MIXR(3, fa[3], fb[3]); MIXR(4, fa[4], fb[4]); MIXR(5, fa[5], fb[5]); MIXR(6, fa[6], fb[6]); MIXR(7, fa[7], fb[7]);
#undef MIXR
#pragma unroll
                    for (int j = 0; j < 4; ++j) { acc[ai][bj][m][0][j] *= r[j]; acc[ai][bj][m][1][j] *= r[4 + j]; } }
                __builtin_amdgcn_sched_barrier(0); } }
    }
    __device__ __forceinline__ void operator()(AccRef acc, const Unit& u, int wr, int wc, int fr, int fq, const LAS unsigned char* bl) const {
        const int row0 = u.pm * BM + wr * 64 + fr, col0 = u.pn * BM + wc * 32 + 8 * fq;
#pragma unroll
        for (int ai = 0; ai < 2; ++ai) {
            u32x2 gq[4][2];
#pragma unroll
            for (int m = 0; m < 4; ++m)
#pragma unroll
                for (int bj = 0; bj < 2; ++bj) gq[m][bj] = *(const u32x2*)(g8 + (size_t)(row0 + ai * HALF + m * 16) * GP + G_GB + col0 + bj * HALF);
            __builtin_amdgcn_sched_barrier(0);
#pragma unroll
            for (int m = 0; m < 4; ++m) { const int row = row0 + ai * HALF + m * 16;
#pragma unroll
                for (int bj = 0; bj < 2; ++bj) { const u32x2 gb8 = gq[m][bj];
                    const f32x2 b0 = __builtin_amdgcn_cvt_pk_f32_fp8((int)gb8.x, false), b1 = __builtin_amdgcn_cvt_pk_f32_fp8((int)gb8.x, true), b2 = __builtin_amdgcn_cvt_pk_f32_fp8((int)gb8.y, false), b3 = __builtin_amdgcn_cvt_pk_f32_fp8((int)gb8.y, true);
                    float r[8];
#define MIXG(bv) __builtin_amdgcn_rcpf(1.0f + fminf(__expf(-(bv)), 1e20f))
                    r[0] = MIXG(b0.x) * acc[ai][bj][m][0][0]; r[1] = MIXG(b0.y) * acc[ai][bj][m][0][1]; r[2] = MIXG(b1.x) * acc[ai][bj][m][0][2]; r[3] = MIXG(b1.y) * acc[ai][bj][m][0][3];
                    r[4] = MIXG(b2.x) * acc[ai][bj][m][1][0]; r[5] = MIXG(b2.y) * acc[ai][bj][m][1][1]; r[6] = MIXG(b3.x) * acc[ai][bj][m][1][2]; r[7] = MIXG(b3.y) * acc[ai][bj][m][1][3];
#undef MIXG
                    u32x2 w; w.x = pk4_fp8(r[0], r[1], r[2], r[3]); w.y = pk4_fp8(r[4], r[5], r[6], r[7]);
                    *(u32x2*)((unsigned char*)O + (size_t)row * D + col0 + bj * HALF) = w; } } }
    }
};
struct EpiWout {
    static constexpr int MIDK = 0;
    static constexpr bool PERM = true;
    static constexpr bool LBIAS = true; static constexpr int BJS = HALF;
    __device__ __forceinline__ const float* bias_ptr(const Unit& u) const { return gate + (size_t)(u.pm >> 3) * 6144 + u.pn * BM; }
    const float* x; bf16* out; const float* gate;
    __device__ __forceinline__ void operator()(AccRef acc, const Unit& u, int wr, int wc, int fr, int fq, const LAS unsigned char* bl) const {
        const int row0 = u.pm * BM + wr * 64 + fr, col0 = u.pn * BM + wc * 32 + 8 * fq, b = u.pm >> 3;
        f32x4 gv[2][2];
#pragma unroll
        for (int bj = 0; bj < 2; ++bj)
#pragma unroll
            for (int n = 0; n < 2; ++n) gv[bj][n] = *(const LAS f32x4*)(bl + bj * 128 + fq * 32 + n * 16);
#pragma unroll
        for (int ai = 0; ai < 2; ++ai) {
            f32x4 xq[4][2][2];
#pragma unroll
            for (int m = 0; m < 4; ++m)
#pragma unroll
                for (int bj = 0; bj < 2; ++bj) { const float* xp = x + (size_t)(row0 + ai * HALF + m * 16) * D + col0 + bj * HALF; xq[m][bj][0] = *(const f32x4*)xp; xq[m][bj][1] = *(const f32x4*)(xp + 4); }
            __builtin_amdgcn_sched_barrier(0);
#pragma unroll
            for (int m = 0; m < 4; ++m) { const size_t off = (size_t)(row0 + ai * HALF + m * 16) * D + col0;
#pragma unroll
                for (int bj = 0; bj < 2; ++bj) { const f32x4 x0 = xq[m][bj][0], x1 = xq[m][bj][1];
                    const f32x4 v0 = x0 + gv[bj][0] * acc[ai][bj][m][0], v1 = x1 + gv[bj][1] * acc[ai][bj][m][1];
                    u32x4 w; w.x = cvt_pk_bf16(v0[0], v0[1]); w.y = cvt_pk_bf16(v0[2], v0[3]); w.z = cvt_pk_bf16(v1[0], v1[1]); w.w = cvt_pk_bf16(v1[2], v1[3]);
                    *(u32x4*)(out + off + bj * HALF) = w; } } }
    }
};
struct EpiNull {
    static constexpr int MIDK = 0;
    static constexpr bool PERM = false;
    static constexpr bool LBIAS = false; static constexpr int BJS = 0;
    float* sink;
    __device__ __forceinline__ void operator()(AccRef acc, const Unit& u, int wr, int wc, int fr, int fq, const LAS unsigned char* bl) const {
        f32x4 s = (f32x4){0.f, 0.f, 0.f, 0.f};
#pragma unroll
        for (int ai = 0; ai < 2; ++ai)
#pragma unroll
            for (int bj = 0; bj < 2; ++bj)
#pragma unroll
                for (int m = 0; m < 4; ++m)
#pragma unroll
                    for (int n = 0; n < 2; ++n) s += acc[ai][bj][m][n];
        if (s[0] == 1.2345e30f) sink[0] = s[1] + s[2] + s[3];
    }
};
struct EpiSwiglu {
    static constexpr int MIDK = 0;
    static constexpr bool PERM = true;
    static constexpr bool LBIAS = true; static constexpr int BJS = 1024;
    __device__ __forceinline__ const float* bias_ptr(const Unit& u) const { return bup + (size_t)u.e * 2048 + u.pn * HALF; }
    bf16* O; const float* bup;
    __device__ __forceinline__ void operator()(AccRef acc, const Unit& u, int wr, int wc, int fr, int fq, const LAS unsigned char* bl) const {
        const int row0 = u.pm * BM + wr * 64 + fr, lc = wc * 32 + 8 * fq, hc = u.pn * HALF + lc;
        f32x4 bg[2], bu[2];
#pragma unroll
        for (int n = 0; n < 2; ++n) { bg[n] = *(const LAS f32x4*)(bl + fq * 32 + n * 16); bu[n] = *(const LAS f32x4*)(bl + 128 + fq * 32 + n * 16); }
#pragma unroll
        for (int ai = 0; ai < 2; ++ai)
#pragma unroll
            for (int m = 0; m < 4; ++m) { const int row = row0 + ai * HALF + m * 16;
                float r[8];
#pragma unroll
                for (int n = 0; n < 2; ++n)
#pragma unroll
                    for (int j = 0; j < 4; ++j) { float gg = acc[ai][0][m][n][j] + bg[n][j], ll = acc[ai][1][m][n][j] + bu[n][j];
                        gg = fminf(gg, 7.0f); ll = fminf(fmaxf(ll, -7.0f), 7.0f);
                        r[4 * n + j] = gg * sigmoidf_(1.702f * gg) * (ll + 1.0f); }
                u32x2 w; w.x = pk4_fp8(r[0], r[1], r[2], r[3]); w.y = pk4_fp8(r[4], r[5], r[6], r[7]);
                *(u32x2*)((unsigned char*)O + (size_t)row * D + hc) = w; }
    }
};
struct EpiDown {
    static constexpr int MIDK = 0;
    static constexpr bool PERM = true;
    static constexpr bool LBIAS = true; static constexpr int BJS = HALF;
    __device__ __forceinline__ const float* bias_ptr(const Unit& u) const { return bdn + (size_t)u.e * D + u.pn * BM; }
    bf16* O; const float* bdn;
    __device__ __forceinline__ void operator()(AccRef acc, const Unit& u, int wr, int wc, int fr, int fq, const LAS unsigned char* bl) const {
        const int row0 = u.pm * BM + wr * 64 + fr, col0 = u.pn * BM + wc * 32 + 8 * fq;
        f32x4 bv[2][2];
#pragma unroll
        for (int bj = 0; bj < 2; ++bj)
#pragma unroll
            for (int n = 0; n < 2; ++n) bv[bj][n] = *(const LAS f32x4*)(bl + bj * 128 + fq * 32 + n * 16);
#pragma unroll
        for (int ai = 0; ai < 2; ++ai)
#pragma unroll
            for (int m = 0; m < 4; ++m) { bf16* rowp = O + (size_t)(row0 + ai * HALF + m * 16) * D + col0;
#pragma unroll
                for (int bj = 0; bj < 2; ++bj) { const f32x4 v0 = acc[ai][bj][m][0] + bv[bj][0], v1 = acc[ai][bj][m][1] + bv[bj][1];
                    u32x4 w; w.x = cvt_pk_bf16(v0[0], v0[1]); w.y = cvt_pk_bf16(v0[2], v0[3]); w.z = cvt_pk_bf16(v1[0], v1[1]); w.w = cvt_pk_bf16(v1[2], v1[3]);
                    __builtin_nontemporal_store(w, (u32x4*)(rowp + bj * HALF)); } }
    }
};
}

struct Args { const float* in[31]; float* out; unsigned char* ws; };

struct Frame {
    LAS unsigned char* lds;
    unsigned char* ws;
    const float* const* in;
    float* out;
    int tid, lane, wave, G, bid;
};

__device__ __forceinline__ int map_in(int d) {
    if (d < 512) return 1304 + d;
    if (d < 1792) return d - 512;
    if (d < 1816) return 1280 + (d - 1792);
    if (d < 1824) return 2328 + (d - 1816);
    if (d < 2048) return -1;
    if (d < 2560) return 1816 + (d - 2048);
    return 2336 + (d - 2560);
}
__device__ __forceinline__ int map_up(int r) { return ((r >> 7) & 1) * 1024 + (r >> 8) * 128 + (r & 127); }

template <int MAP>
__device__ __forceinline__ void transpose_item(const float* W, int ldw, int K, bf16* WT, int nblk, int item, LAS float* scr, int lane, int ldt = 0) {
    if (ldt == 0) ldt = K;
    const int kb = item / nblk, nb = item - kb * nblk, k0 = 64 * kb, n0 = 32 * nb;
    const int r = lane >> 3, c4 = (lane & 7) * 4, nd = n0 + c4;
    const int sc = MAP == 0 ? nd : (MAP == 1 ? map_in(nd) : map_up(nd));
    f32x4 v[8];
#pragma unroll
    for (int i = 0; i < 8; ++i) v[i] = sc >= 0 ? *(const f32x4*)(W + (size_t)(k0 + 8 * i + r) * ldw + sc) : (f32x4){0.f, 0.f, 0.f, 0.f};
#pragma unroll
    for (int i = 0; i < 8; ++i) { LAS float* p = scr + (8 * i + r) * 33 + c4; p[0] = v[i].x; p[1] = v[i].y; p[2] = v[i].z; p[3] = v[i].w; }
    LDS_WAIT();
    const int c = lane & 7;
#pragma unroll
    for (int j = 0; j < 4; ++j) { const int n = (lane >> 3) + 8 * j; const LAS float* s = scr + (8 * c) * 33 + n;
        u32x4 o; o.x = pk2(s[0 * 33], s[1 * 33]); o.y = pk2(s[2 * 33], s[3 * 33]); o.z = pk2(s[4 * 33], s[5 * 33]); o.w = pk2(s[6 * 33], s[7 * 33]);
        *(u32x4*)(WT + (size_t)(n0 + n) * ldt + k0 + 8 * c) = o; }
    LDS_WAIT();
}

template <int MAP>
__device__ __forceinline__ void transpose_item8(const float* W, int ldw, int K, unsigned char* WT, int nblk, int item, LAS float* scr, int lane) {
    const int kb = item / nblk, nb = item - kb * nblk, k0 = 64 * kb, n0 = 32 * nb;
    const int r = lane >> 3, c4 = (lane & 7) * 4, nd = n0 + c4;
    const int sc = MAP == 0 ? nd : (MAP == 1 ? map_in(nd) : map_up(nd));
    f32x4 v[8];
#pragma unroll
    for (int i = 0; i < 8; ++i) v[i] = sc >= 0 ? *(const f32x4*)(W + (size_t)(k0 + 8 * i + r) * ldw + sc) : (f32x4){0.f, 0.f, 0.f, 0.f};
#pragma unroll
    for (int i = 0; i < 8; ++i) { LAS float* p = scr + (8 * i + r) * 33 + c4; p[0] = v[i].x; p[1] = v[i].y; p[2] = v[i].z; p[3] = v[i].w; }
    LDS_WAIT();
    const int c = lane & 7;
#pragma unroll
    for (int j = 0; j < 4; ++j) { const int n = (lane >> 3) + 8 * j; const LAS float* s = scr + (8 * c) * 33 + n;
        u32x2 o; o.x = pk4_fp8(32.f * s[0 * 33], 32.f * s[1 * 33], 32.f * s[2 * 33], 32.f * s[3 * 33]); o.y = pk4_fp8(32.f * s[4 * 33], 32.f * s[5 * 33], 32.f * s[6 * 33], 32.f * s[7 * 33]);
        *(u32x2*)(WT + (size_t)(n0 + n) * K + k0 + 8 * c) = o; }
    LDS_WAIT();
}

__device__ __forceinline__ void p0_adaln(Frame& F) {
    const float* c = F.in[1]; const float* ada_w = F.in[2];
    float* modp = (float*)(F.ws + WS_MODP);
    LAS float* sl = (LAS float*)F.lds;
    for (int u = F.bid; u < 192; u += F.G) {
        const int ks = u / 12, cc = u - ks * 12, j = cc * 512 + F.tid;
        __syncthreads();
        for (int i = F.tid; i < 1024; i += NTHREADS) { const int b = i >> 6, kk = i & 63; const float v = c[b * 1024 + ks * 64 + kk]; sl[i] = v / (1.0f + __expf(-v)); }
        __syncthreads();
        float acc[16];
#pragma unroll
        for (int b = 0; b < 16; ++b) acc[b] = 0.f;
#pragma unroll 16
        for (int kk = 0; kk < 64; ++kk) { const float w = ada_w[(size_t)(ks * 64 + kk) * 6144 + j];
#pragma unroll
            for (int b = 0; b < 16; ++b) acc[b] += sl[b * 64 + kk] * w; }
#pragma unroll
        for (int b = 0; b < 16; ++b) modp[(size_t)(ks * 16 + b) * 6144 + j] = acc[b];
    }
}

__device__ __forceinline__ void p0_cpe(Frame& F) {
    float* cpe = (float*)(F.ws + WS_CPE);
    LAS float* red = (LAS float*)F.lds;
    for (int u = F.bid - 192; u >= 0 && u < 64; u += F.G) {
        const int kv = u >> 5, e0 = (u & 31) * 4, eo = F.tid & 3, kk = F.tid >> 2;
        const float* pe = F.in[kv ? 10 : 7]; const float* w1 = F.in[kv ? 11 : 8];
        float s = 0.f;
#pragma unroll
        for (int m = 0; m < 16; ++m) { const int k = kk + 128 * m; s += pe[k] * w1[(size_t)k * 128 + e0 + eo]; }
        __syncthreads();
        red[F.tid] = s;
        __syncthreads();
        if (F.tid < 4) { float t = 0.f; for (int i = 0; i < 128; ++i) t += red[i * 4 + F.tid]; cpe[kv * 128 + e0 + F.tid] = t; }
    }
}

__device__ __forceinline__ void p1_prologue(Frame& F) {
    const float* modp = (const float*)(F.ws + WS_MODP);
    float* mod = (float*)(F.ws + WS_MOD);
    const int gtid = F.bid * NTHREADS + F.tid, gsz = F.G * NTHREADS;
    for (int i = gtid; i < 16 * 6144; i += gsz) { float s = F.in[3][i % 6144];
        for (int ks = 0; ks < 16; ++ks) s += modp[(size_t)ks * 16 * 6144 + i];
        mod[i] = s; }
    { float* bin = (float*)(F.ws + WS_BIN);
      for (int i = gtid; i < NPROJ; i += gsz) { const int sc = map_in(i); bin[i] = sc >= 0 ? F.in[6][sc] : 0.f; } }
    { bf16* rwt = (bf16*)(F.ws + WS_RWT);
      for (int i = gtid; i < 32 * 1024; i += gsz) { const int e = i >> 10, d = i & 1023; const float wv = F.in[24][d * 32 + e]; const unsigned hi = f2bf(wv);
          rwt[i] = (bf16)hi; rwt[32 * 1024 + i] = (bf16)f2bf(wv - __builtin_bit_cast(float, hi << 16)); } }
    {
        const float* x = F.in[0]; const float* g1 = F.in[4]; bf16* xn = (bf16*)(F.ws + WS_XN);
        LAS float* sm = (LAS float*)F.lds;
        for (int rb = F.bid; rb < T / 128; rb += F.G) {
            const int b = rb >> 4;
            __syncthreads();
            for (int i = F.tid; i < 2048; i += NTHREADS) { float s = F.in[3][i];
                for (int ks = 0; ks < 16; ++ks) s += modp[(size_t)(ks * 16 + b) * 6144 + i];
                sm[i] = s; }
            __syncthreads();
            for (int r = 0; r < 16; ++r) {
                const int row = rb * 128 + F.wave * 16 + r;
                const f32x4* xr = (const f32x4*)(x + (size_t)row * D) + F.lane;
                f32x4 v[4]; float ss = 0.f;
#pragma unroll
                for (int j = 0; j < 4; ++j) { v[j] = xr[64 * j]; ss += v[j].x * v[j].x + v[j].y * v[j].y + v[j].z * v[j].z + v[j].w * v[j].w; }
                const float rs = rsqrtf(wave_sum(ss) * (1.0f / D) + 1e-5f);
                unsigned* o4 = (unsigned*)(F.ws + WS_OY + (size_t)row * D) + F.lane; u32x2* o8 = (u32x2*)(xn + (size_t)row * D) + F.lane;
#pragma unroll
                for (int j = 0; j < 4; ++j) { const int d0 = (64 * j + F.lane) * 4; const f32x4 gg = *(const f32x4*)(g1 + d0);
                    float y[4];
#pragma unroll
                    for (int i = 0; i < 4; ++i) y[i] = v[j][i] * rs * gg[i] * (1.0f + sm[1024 + d0 + i]) + sm[d0 + i];
                    o4[64 * j] = pk4_fp8(y[0], y[1], y[2], y[3]); u32x2 w; w.x = pk2(y[0], y[1]); w.y = pk2(y[2], y[3]); o8[64 * j] = w; }
            }
        }
    }
    __syncthreads();
    {
        LAS float* scr = (LAS float*)(F.lds + F.wave * 16384);
        const int gw = F.bid * NWAVES + F.wave, NGW = F.G * NWAVES;
        constexpr int I_IN = 16 * 144, I_PA = 8 * 32, I_WO = 16 * 32, I_UP1 = 16 * 64, I_DN1 = 16 * 32;
        constexpr int I_C1 = 32 * 4, I_C2 = 2 * 2, I_ML = 2 * 4;
        constexpr int NITEMS = I_IN + 2 * I_PA + I_WO + 2 * I_C1 + 2 * I_C2 + 12 * I_ML;
        for (int it = gw; it < NITEMS; it += NGW) {
            int r = it;
            if (r < I_IN) { const int nb = r % 144;
                if (nb < 16) transpose_item<1>(F.in[5], IN_W, 1024, (bf16*)(F.ws + WS_WIN), 144, r, scr, F.lane);
                else transpose_item8<1>(F.in[5], IN_W, 1024, (unsigned char*)(F.ws + WS_WIN + 4 * MiB) - (size_t)512 * 1024, 144, r, scr, F.lane);
                continue; } r -= I_IN;
            if (r < I_PA) { transpose_item<0>(F.in[20], 1024, 512, (bf16*)(F.ws + WS_WPA), 32, r, scr, F.lane, 1024); continue; } r -= I_PA;
            if (r < I_PA) { transpose_item<0>(F.in[21], 1024, 512, (bf16*)(F.ws + WS_WPA) + 512, 32, r, scr, F.lane, 1024); continue; } r -= I_PA;
            if (r < I_WO) { transpose_item8<0>(F.in[22], 1024, 1024, (unsigned char*)(F.ws + WS_WOUT), 32, r, scr, F.lane); continue; } r -= I_WO;
            if (r < 2 * I_C1) { const int kv = r / I_C1; transpose_item<0>(F.in[kv ? 11 : 8], 128, 2048, (bf16*)(F.ws + WS_W1T) + (size_t)kv * 128 * 2048, 4, r - kv * I_C1, scr, F.lane); continue; } r -= 2 * I_C1;
            if (r < 2 * I_C2) { const int kv = r / I_C2; transpose_item<0>(F.in[kv ? 12 : 9], 64, 128, (bf16*)(F.ws + WS_W2T) + (size_t)kv * 64 * 128, 2, r - kv * I_C2, scr, F.lane); continue; } r -= 2 * I_C2;
            { const int mh = r / I_ML, mat = mh >> 2; transpose_item<0>(F.in[15 + mat] + (size_t)(mh & 3) * 16384, 128, 128, (bf16*)(F.ws + WS_WQT) + (size_t)mh * 16384, 4, r - mh * I_ML, scr, F.lane); }
        }
    }
}

struct AttnState { float q[64]; float o[64]; float m, l; };
__device__ __forceinline__ void attn_init(AttnState& st, const bf16* qp) {
#pragma unroll
    for (int i = 0; i < 8; ++i) { const u32x4 w = *(const u32x4*)(qp + 8 * i);
        st.q[8 * i + 0] = bflo(w.x) * 0.125f; st.q[8 * i + 1] = bfhi(w.x) * 0.125f; st.q[8 * i + 2] = bflo(w.y) * 0.125f; st.q[8 * i + 3] = bfhi(w.y) * 0.125f;
        st.q[8 * i + 4] = bflo(w.z) * 0.125f; st.q[8 * i + 5] = bfhi(w.z) * 0.125f; st.q[8 * i + 6] = bflo(w.w) * 0.125f; st.q[8 * i + 7] = bfhi(w.w) * 0.125f; }
#pragma unroll
    for (int d = 0; d < 64; ++d) st.o[d] = 0.f;
    st.m = -1e30f; st.l = 0.f;
}
__device__ __forceinline__ float dot_bf16row(const float (&q)[64], const bf16* kp) {
    float s0 = 0.f, s1 = 0.f;
#pragma unroll
    for (int i = 0; i < 8; ++i) { const u32x4 w = *(const u32x4*)(kp + 8 * i);
        s0 += q[8 * i + 0] * bflo(w.x); s1 += q[8 * i + 1] * bfhi(w.x); s0 += q[8 * i + 2] * bflo(w.y); s1 += q[8 * i + 3] * bfhi(w.y);
        s0 += q[8 * i + 4] * bflo(w.z); s1 += q[8 * i + 5] * bfhi(w.z); s0 += q[8 * i + 6] * bflo(w.w); s1 += q[8 * i + 7] * bfhi(w.w); }
    return s0 + s1;
}
__device__ __forceinline__ void attn_key_bf16(AttnState& st, float sc, bool valid, const bf16* vp) {
    const bool need = valid && (sc > st.m + 8.0f);
    if (__any(need)) { if (need) { const float a = __expf(st.m - sc); st.l *= a;
#pragma unroll
            for (int d = 0; d < 64; ++d) st.o[d] *= a;
            st.m = sc; } }
    const float p = valid ? __expf(sc - st.m) : 0.f;
    st.l += p;
#pragma unroll
    for (int i = 0; i < 8; ++i) { const u32x4 w = *(const u32x4*)(vp + 8 * i);
        st.o[8 * i + 0] += p * bflo(w.x); st.o[8 * i + 1] += p * bfhi(w.x); st.o[8 * i + 2] += p * bflo(w.y); st.o[8 * i + 3] += p * bfhi(w.y);
        st.o[8 * i + 4] += p * bflo(w.z); st.o[8 * i + 5] += p * bfhi(w.z); st.o[8 * i + 6] += p * bflo(w.w); st.o[8 * i + 7] += p * bfhi(w.w); }
}

__device__ __forceinline__ float gelu_tanh(float x) { const float u = 0.7978845608f * (x + 0.044715f * x * x * x); const float t = 1.0f - 2.0f / (__expf(2.0f * u) + 1.0f); return 0.5f * x * (1.0f + t); }

__device__ __forceinline__ void p3_compress(Frame& F) {
    const bf16* proj = (const bf16*)(F.ws + WS_PROJ); const bf16* w1t = (const bf16*)(F.ws + WS_W1T); const bf16* w2t = (const bf16*)(F.ws + WS_W2T);
    const float* cpe = (const float*)(F.ws + WS_CPE); bf16* kcb = (bf16*)(F.ws + WS_KCB);
    const int lane = F.lane, w = F.wave, c = lane & 15, g4 = lane >> 4, nt2 = w >> 2, sl = w & 3;
    LAS f32x4* part = (LAS f32x4*)F.lds;
    for (int bu = F.bid; bu < 256; bu += F.G) {
        const int wu = bu * 2 + nt2;
        const int kv = wu >> 8, b = (wu >> 4) & 15, g = (wu >> 3) & 1, n0 = (wu & 7) * 16;
        const int n = n0 + c, nn = n > 126 ? 126 : n;
        const bf16* xb = proj + (size_t)(b * S + 16 * nn) * PP + (kv ? C_VCMP : C_KCMP) + g * 64 + 8 * g4;
        const bf16* wb = w1t + (size_t)kv * 128 * 2048 + (size_t)c * 2048 + 8 * g4;
        f32x4 acc[8];
#pragma unroll
        for (int et = 0; et < 8; ++et) acc[et] = (f32x4){0.f, 0.f, 0.f, 0.f};
#pragma unroll 2
        for (int k2 = 0; k2 < 16; ++k2) { const int ks = 16 * sl + k2;
            const bf16x8 xf = *(const bf16x8*)(xb + (size_t)(ks >> 1) * PP + 32 * (ks & 1));
#pragma unroll
            for (int et = 0; et < 8; ++et) { const bf16x8 wf = *(const bf16x8*)(wb + (size_t)et * 16 * 2048 + 32 * ks); acc[et] = __builtin_amdgcn_mfma_f32_16x16x32_bf16(wf, xf, acc[et], 0, 0, 0); }
        }
        __syncthreads();
        if (sl != 0) {
#pragma unroll
            for (int et = 0; et < 8; ++et) part[((nt2 * 3 + (sl - 1)) * 8 + et) * 64 + lane] = acc[et]; }
        __syncthreads();
        if (sl == 0) {
#pragma unroll
            for (int et = 0; et < 8; ++et) { const f32x4 cp = *(const f32x4*)(cpe + kv * 128 + 16 * et + 4 * g4);
                const f32x4 s = acc[et] + part[((nt2 * 3 + 0) * 8 + et) * 64 + lane] + part[((nt2 * 3 + 1) * 8 + et) * 64 + lane] + part[((nt2 * 3 + 2) * 8 + et) * 64 + lane];
#pragma unroll
                for (int i = 0; i < 4; ++i) acc[et][i] = gelu_tanh(s[i] + cp[i]); }
            f32x4 o2[4];
#pragma unroll
            for (int dt = 0; dt < 4; ++dt) o2[dt] = (f32x4){0.f, 0.f, 0.f, 0.f};
#pragma unroll
            for (int ss = 0; ss < 4; ++ss) {
                u32x4 hw; hw.x = pk2(acc[2 * ss][0], acc[2 * ss][1]); hw.y = pk2(acc[2 * ss][2], acc[2 * ss][3]); hw.z = pk2(acc[2 * ss + 1][0], acc[2 * ss + 1][1]); hw.w = pk2(acc[2 * ss + 1][2], acc[2 * ss + 1][3]);
                const bf16x8 hf = __builtin_bit_cast(bf16x8, hw);
#pragma unroll
                for (int dt = 0; dt < 4; ++dt) { const bf16* wp = w2t + (size_t)kv * 64 * 128 + (size_t)(16 * dt + c) * 128 + 32 * ss + 4 * g4;
                    const u32x2 lo = *(const u32x2*)wp, hi = *(const u32x2*)(wp + 16);
                    const u32x4 ww = (u32x4){lo.x, lo.y, hi.x, hi.y};
                    o2[dt] = __builtin_amdgcn_mfma_f32_16x16x32_bf16(__builtin_bit_cast(bf16x8, ww), hf, o2[dt], 0, 0, 0); }
            }
            bf16* op = kcb + ((((size_t)kv * 16 + b) * 2 + g) * 128 + n) * 64 + 4 * g4;
#pragma unroll
            for (int dt = 0; dt < 4; ++dt) { u32x2 w2; w2.x = pk2(o2[dt][0], o2[dt][1]); w2.y = pk2(o2[dt][2], o2[dt][3]); if (n > 126) { w2.x = 0u; w2.y = 0u; } *(u32x2*)(op + 16 * dt) = w2; }
        }
    }
}

__device__ __forceinline__ void p4_cmpsel(Frame& F) {
    constexpr float LOG2E = 1.4426950408889634f;
    const bf16* proj = (const bf16*)(F.ws + WS_PROJ); const float* small = (const float*)(F.ws + WS_SMALL); float* oacc = (float*)(F.ws + WS_OACC);
    const bf16* kcb = (const bf16*)(F.ws + WS_KCB); const bf16* vcb = kcb + (size_t)16 * 2 * 128 * 64;
    unsigned* selm = (unsigned*)(F.ws + WS_SELM);
    LAS unsigned char* L = F.lds;
    LAS float* scA = (LAS float*)(F.lds + 32768); LAS float* scB = (LAS float*)(F.lds + 40960);
    const int lane = F.lane, w = F.wave, c = lane & 15, g4 = lane >> 4;
    const int pr = 8 * ((c >> 2) & 1) + 4 * (c >> 3) + (c & 3), k7 = pr & 7;
    int kof[2]; kof[0] = pr * 128 + (((0 + g4) ^ k7) << 4); kof[1] = pr * 128 + (((4 + g4) ^ k7) << 4);
    const int q4 = c >> 2, p4 = c & 3, xr = 2 * (g4 & 1) + (g4 >> 1);
    const int vb = 1024 * (g4 & 1) + 64 * (4 * (g4 >> 1) + q4) + 8 * (p4 & 1);
    int vx[2]; vx[0] = 16 * ((0 + (p4 >> 1)) ^ xr); vx[1] = 16 * ((2 + (p4 >> 1)) ^ xr);
    const int kbl = 8 * (g4 & 1) + 4 * (g4 >> 1);
    const int skey = F.tid >> 3, sch = F.tid & 7;
    const int kst = skey * 128 + ((sch ^ (skey & 7)) << 4);
    const int vst = 16384 + 1024 * (skey >> 3) + 512 * (sch >> 2) + 64 * (skey & 7) + 16 * ((sch & 3) ^ ((skey >> 2) & 3));
    for (int unit = F.bid; unit < 1024; unit += F.G) {
        const int qb = 31 - (unit >> 5), b = (unit & 31) >> 1, g = unit & 1, t0 = qb * 64;
        const int ntile = qb >= 16 ? 2 : 1;
        __syncthreads();
        for (int tl = 0; tl < ntile; ++tl) { const bf16* sp = kcb + ((size_t)(b * 2 + g) * 128 + 64 * tl + skey) * 64 + sch * 8;
            *(LAS u32x4*)(L + tl * 8192 + kst) = *(const u32x4*)sp; *(LAS u32x4*)(L + tl * 8192 + vst) = *(const u32x4*)(sp + (vcb - kcb)); }
        __syncthreads();
        const int hq = 4 * g + (c & 3);
        const float slope2 = exp2f(-(float)(hq + 1)) * LOG2E;
#pragma unroll
        for (int nt = 0; nt < 2; ++nt) {
            const int tlq = 8 * w + 4 * nt + (c >> 2), tq = t0 + tlq;
            const bf16* qp = proj + (size_t)(b * S + tq) * PP + C_Q + hq * 64 + 8 * g4;
            bf16x8 qf[2];
#pragma unroll
            for (int ks = 0; ks < 2; ++ks) { const u32x4 v = *(const u32x4*)(qp + 32 * ks); u32x4 o;
                o.x = pk2(bflo(v.x) * 0.125f, bfhi(v.x) * 0.125f); o.y = pk2(bflo(v.y) * 0.125f, bfhi(v.y) * 0.125f); o.z = pk2(bflo(v.z) * 0.125f, bfhi(v.z) * 0.125f); o.w = pk2(bflo(v.w) * 0.125f, bfhi(v.w) * 0.125f);
                qf[ks] = __builtin_bit_cast(bf16x8, o); }
            float sc[2][4][4]; float tmax = -1e30f;
            const int nvalid = tq >= 31 ? ((tq - 31) >> 4) + 1 : 0;
#pragma unroll
            for (int tl = 0; tl < 2; ++tl) {
                if (tl < ntile) {
                    f32x4 sa[4];
#pragma unroll
                    for (int mt = 0; mt < 4; ++mt) sa[mt] = (f32x4){0.f, 0.f, 0.f, 0.f};
#pragma unroll
                    for (int ks = 0; ks < 2; ++ks)
#pragma unroll
                        for (int mt = 0; mt < 4; ++mt) { const bf16x8 kf = *(const LAS bf16x8*)(L + tl * 8192 + mt * 2048 + kof[ks]); sa[mt] = __builtin_amdgcn_mfma_f32_16x16x32_bf16(kf, qf[ks], sa[mt], 0, 0, 0); }
#pragma unroll
                    for (int mt = 0; mt < 4; ++mt)
#pragma unroll
                        for (int i = 0; i < 4; ++i) { const int n = 64 * tl + 16 * mt + kbl + i;
                            const float v = n < nvalid ? sa[mt][i] * LOG2E - slope2 * ((float)(tq - 16 * n) - 15.5f) : -1e30f; sc[tl][mt][i] = v; tmax = fmaxf(tmax, v); }
                } else {
#pragma unroll
                    for (int mt = 0; mt < 4; ++mt)
#pragma unroll
                        for (int i = 0; i < 4; ++i) sc[tl][mt][i] = -1e30f;
                }
            }
            tmax = fmaxf(tmax, __shfl_xor(tmax, 16)); tmax = fmaxf(tmax, __shfl_xor(tmax, 32));
            float ls = 0.f;
#pragma unroll
            for (int tl = 0; tl < 2; ++tl)
#pragma unroll
                for (int mt = 0; mt < 4; ++mt)
#pragma unroll
                    for (int i = 0; i < 4; ++i) { const float p = sc[tl][mt][i] > -1e29f ? __builtin_amdgcn_exp2f(sc[tl][mt][i] - tmax) : 0.f; sc[tl][mt][i] = p; ls += p; }
            ls += __shfl_xor(ls, 16); ls += __shfl_xor(ls, 32);
            const float inv = ls > 0.f ? 1.0f / ls : 0.f;
            f32x4 o[4];
#pragma unroll
            for (int dt = 0; dt < 4; ++dt) o[dt] = (f32x4){0.f, 0.f, 0.f, 0.f};
#pragma unroll
            for (int tl = 0; tl < 2; ++tl) {
                if (tl < ntile) {
#pragma unroll
                    for (int mt = 0; mt < 4; ++mt) {
#pragma unroll
                        for (int i = 0; i < 4; ++i) sc[tl][mt][i] *= inv;
                        float a = sc[tl][mt][0] + sc[tl][mt][1] + sc[tl][mt][2] + 0.5f * sc[tl][mt][3], bb = 0.5f * sc[tl][mt][3];
                        a += __shfl_xor(a, 1); a += __shfl_xor(a, 2); bb += __shfl_xor(bb, 1); bb += __shfl_xor(bb, 2);
                        if ((c & 3) == 0) { const int j = 16 * tl + 4 * mt + 2 * (g4 & 1) + (g4 >> 1); scA[tlq * 32 + j] = a; scB[tlq * 32 + j] = bb; }
                    }
#pragma unroll
                    for (int s = 0; s < 2; ++s) { u32x4 pw; pw.x = pk2(sc[tl][2 * s][0], sc[tl][2 * s][1]); pw.y = pk2(sc[tl][2 * s][2], sc[tl][2 * s][3]); pw.z = pk2(sc[tl][2 * s + 1][0], sc[tl][2 * s + 1][1]); pw.w = pk2(sc[tl][2 * s + 1][2], sc[tl][2 * s + 1][3]);
                        const bf16x8 pf = __builtin_bit_cast(bf16x8, pw);
#pragma unroll
                        for (int dt = 0; dt < 4; ++dt) { const LAS unsigned char* vp = L + 16384 + tl * 8192 + vb + 4096 * s + 512 * (dt >> 1) + vx[dt & 1];
                            const s16x4 lo = __builtin_bit_cast(s16x4, __builtin_amdgcn_ds_read_tr16_b64_v4i16((LAS s16x4*)vp));
                            const s16x4 hi = __builtin_bit_cast(s16x4, __builtin_amdgcn_ds_read_tr16_b64_v4i16((LAS s16x4*)(vp + 2048)));
                            const bf16x8 vf = (bf16x8){lo[0], lo[1], lo[2], lo[3], hi[0], hi[1], hi[2], hi[3]};
                            o[dt] = __builtin_amdgcn_mfma_f32_16x16x32_bf16(vf, pf, o[dt], 0, 0, 0); } }
                }
            }
            const size_t tok = (size_t)(b * S + tq);
            const float sg = sigmoidf_(small[tok * 32 + hq]);
#pragma unroll
            for (int dt = 0; dt < 4; ++dt) *(f32x4*)(oacc + tok * 512 + hq * 64 + 16 * dt + 4 * g4) = o[dt] * sg;
        }
        __syncthreads();
        if (F.tid < 64) { const int tlq = F.tid, t = t0 + tlq, cur = qb; unsigned mask;
            if (cur < 8) mask = (1u << (cur + 1)) - 1u;
            else { mask = 1u | (1u << cur);
                float sv[31];
#pragma unroll
                for (int j = 1; j < 31; ++j) sv[j] = j < cur ? scA[tlq * 32 + j] + scB[tlq * 32 + j - 1] : -1.0f;
#pragma unroll
                for (int it = 0; it < 6; ++it) { float best = -1.0f; int bj = 0;
#pragma unroll
                    for (int j = 1; j < 31; ++j) { const bool ok = sv[j] > best; best = ok ? sv[j] : best; bj = ok ? j : bj; }
                    mask |= 1u << bj;
#pragma unroll
                    for (int j = 1; j < 31; ++j) sv[j] = (j == bj) ? -1.0f : sv[j]; }
                mask &= ~1u; mask |= 1u; }
            selm[(size_t)(b * 2 + g) * S + t] = mask; }
    }
}

struct AttnW { f32x4 o[2][4]; float m[2], l[2]; };
template <int PHASE>
__device__ __forceinline__ void attn_tile(const bool EDGE, AttnW& st, const LAS unsigned char* Kb, const LAS unsigned char* Vb, const LAS bf16x8* qfl, const int (&kof)[2], int vb, const int (&vx)[2],
                                          int kt, int kbl, int t0, const int (&tq)[2], const unsigned (&smask)[2], float slope2) {
    f32x4 bias[4];
    { const float tbs = slope2 * (float)(64 * kt + kbl - t0 - 63);
#pragma unroll
      for (int mt = 0; mt < 4; ++mt)
#pragma unroll
          for (int i = 0; i < 4; ++i) bias[mt][i] = __builtin_fmaf(slope2, (float)(16 * mt + i), tbs); }
    bool selb[2], act[2];
#pragma unroll
    for (int nt = 0; nt < 2; ++nt) { selb[nt] = PHASE == 0 ? true : ((smask[nt] >> kt) & 1u); act[nt] = PHASE == 0 ? true : (bool)__any(selb[nt]); }
    f32x4 sa[2][4];
#pragma unroll
    for (int nt = 0; nt < 2; ++nt) {
        if (!act[nt]) continue;
#pragma unroll
        for (int mt = 0; mt < 4; ++mt) sa[nt][mt] = bias[mt];
#pragma unroll
        for (int ks = 0; ks < 2; ++ks)
#pragma unroll
            for (int mt = 0; mt < 4; ++mt) { const bf16x8 kf = *(const LAS bf16x8*)(Kb + mt * 2048 + kof[ks]); sa[nt][mt] = __builtin_amdgcn_mfma_f32_16x16x32_bf16(kf, qfl[(nt * 2 + ks) * 64], sa[nt][mt], 0, 0, 0); }
    }
#pragma unroll
    for (int nt = 0; nt < 2; ++nt) {
        if (!act[nt]) continue;
        if (EDGE) { const int dbase = tq[nt] - 64 * kt - kbl;
#pragma unroll
            for (int mt = 0; mt < 4; ++mt)
#pragma unroll
                for (int i = 0; i < 4; ++i) { const int dist = dbase - (16 * mt + i); const bool valid = PHASE == 0 ? (dist >= 0 && dist < 256) : (dist >= 0); sa[nt][mt][i] = valid ? sa[nt][mt][i] : -1e30f; } }
        float tmax = fmaxf(fmaxf(sa[nt][0][0], sa[nt][0][1]), sa[nt][0][2]);
#pragma unroll
        for (int mt = 0; mt < 4; ++mt) { if (mt > 0) tmax = fmaxf(fmaxf(tmax, sa[nt][mt][0]), sa[nt][mt][1]), tmax = fmaxf(tmax, sa[nt][mt][2]); tmax = fmaxf(tmax, sa[nt][mt][3]); }
        if (PHASE == 1) tmax = selb[nt] ? tmax : -1e30f;
        tmax = fmaxf(tmax, __shfl_xor(tmax, 16)); tmax = fmaxf(tmax, __shfl_xor(tmax, 32));
        float mn = st.m[nt];
        if (__any(tmax > mn)) { mn = fmaxf(mn, tmax); const float alpha = __builtin_amdgcn_exp2f(st.m[nt] - mn); st.m[nt] = mn; st.l[nt] *= alpha;
#pragma unroll
            for (int dt = 0; dt < 4; ++dt) st.o[nt][dt] *= alpha; }
        if (PHASE == 1) mn = selb[nt] ? mn : 3.0e38f;
        float ls = 0.f;
#pragma unroll
        for (int mt = 0; mt < 4; ++mt)
#pragma unroll
            for (int i = 0; i < 4; ++i) { const float p = __builtin_amdgcn_exp2f(sa[nt][mt][i] - mn); sa[nt][mt][i] = p; ls += p; }
        st.l[nt] += ls;
        bf16x8 pf[2];
#pragma unroll
        for (int s = 0; s < 2; ++s) { u32x4 w; w.x = pk2(sa[nt][2 * s][0], sa[nt][2 * s][1]); w.y = pk2(sa[nt][2 * s][2], sa[nt][2 * s][3]); w.z = pk2(sa[nt][2 * s + 1][0], sa[nt][2 * s + 1][1]); w.w = pk2(sa[nt][2 * s + 1][2], sa[nt][2 * s + 1][3]);
            pf[s] = __builtin_bit_cast(bf16x8, w); }
#pragma unroll
        for (int dt = 0; dt < 4; ++dt)
#pragma unroll
            for (int s = 0; s < 2; ++s) { const LAS unsigned char* vp = Vb + vb + 4096 * s + 512 * (dt >> 1) + vx[dt & 1];
                const s16x4 lo = __builtin_bit_cast(s16x4, __builtin_amdgcn_ds_read_tr16_b64_v4i16((LAS s16x4*)vp));
                const s16x4 hi = __builtin_bit_cast(s16x4, __builtin_amdgcn_ds_read_tr16_b64_v4i16((LAS s16x4*)(vp + 2048)));
                const bf16x8 vf = (bf16x8){lo[0], lo[1], lo[2], lo[3], hi[0], hi[1], hi[2], hi[3]};
                st.o[nt][dt] = __builtin_amdgcn_mfma_f32_16x16x32_bf16(vf, pf[s], st.o[nt][dt], 0, 0, 0); }
    }
}

__device__ __forceinline__ void p5_attn(Frame& F, int qslot) {
    constexpr float LOG2E = 1.4426950408889634f, QS = 0.125f * LOG2E;
    const bf16* proj = (const bf16*)(F.ws + WS_PROJ); const float* small = (const float*)(F.ws + WS_SMALL);
    const bf16* kcb = (const bf16*)(F.ws + WS_KCB); const bf16* vcb = kcb + (size_t)16 * 2 * 128 * 64;
    bf16* onsa = (bf16*)(F.ws + WS_OY);
    unsigned* qctr = (unsigned*)(F.ws + WS_CTL) + 8 + qslot;
    LAS unsigned char* L = F.lds;
    volatile LAS unsigned* sched = (volatile LAS unsigned*)(F.lds + 32768);
    LAS unsigned* sml = (LAS unsigned*)(F.lds + 32768 + 256);
    LAS float* scA = (LAS float*)(F.lds + 40960); LAS float* scB = (LAS float*)(F.lds + 49152);
    const int w = F.wave;
    for (;;) {
        __syncthreads();
        if (F.tid == 0) sched[0] = atomicAdd(qctr, 1u);
        __syncthreads();
        const int qi = (int)__builtin_amdgcn_readfirstlane(sched[0]);
        if (qi >= 1792) break;
        const int qa = qi / 14, qr = qi - 14 * qa;
        const int cslot = qr == 0 ? 0 : qr == 2 ? 1 : qr == 4 ? 2 : qr == 7 ? 3 : qr == 9 ? 4 : qr == 11 ? 5 : -1;
        if (cslot >= 0) {
            const int chunk = 6 * qa + cslot;
            LAS float* scr = (LAS float*)(F.lds + 40960 + w * 8448);
            for (int j = 0; j < 8; ++j) { const int it = chunk * 64 + w * 8 + j;
                if (it < 32 * 1024) { const int e = it >> 10; transpose_item8<2>(F.in[26] + (size_t)e * 1024 * 2048, 2048, 1024, (unsigned char*)(F.ws + WS_WUP) + (size_t)e * 2048 * 1024, 64, it & 1023, scr, F.lane); }
                else { const int r2 = it - 32 * 1024, e = r2 >> 9; transpose_item8<0>(F.in[28] + (size_t)e * 1024 * 1024, 1024, 1024, (unsigned char*)(F.ws + WS_WDN) + (size_t)e * 1024 * 1024, 32, r2 & 511, scr, F.lane); } }
            continue;
        }
        const int unit = 8 * qa + (qr - 1 - (qr > 2 ? 1 : 0) - (qr > 4 ? 1 : 0) - (qr > 7 ? 1 : 0) - (qr > 9 ? 1 : 0) - (qr > 11 ? 1 : 0));
        const int lane = opaque_i(F.lane), c = lane & 15, g4 = lane >> 4;
        const int pr = 8 * ((c >> 2) & 1) + 4 * (c >> 3) + (c & 3), k7 = pr & 7;
        int kof[2]; kof[0] = pr * 128 + (((0 + g4) ^ k7) << 4); kof[1] = pr * 128 + (((4 + g4) ^ k7) << 4);
        const int q4 = c >> 2, p4 = c & 3, xr = 2 * (g4 & 1) + (g4 >> 1);
        const int vb = 1024 * (g4 & 1) + 64 * (4 * (g4 >> 1) + q4) + 8 * (p4 & 1);
        int vx[2]; vx[0] = 16 * ((0 + (p4 >> 1)) ^ xr); vx[1] = 16 * ((2 + (p4 >> 1)) ^ xr);
        const int kbl = 8 * (g4 & 1) + 4 * (g4 >> 1);
        const int tid_ = opaque_i(F.tid), skey = tid_ >> 3, sch = tid_ & 7;
        const int kst = skey * 128 + ((sch ^ (skey & 7)) << 4);
        const int vst = 16384 + 1024 * (skey >> 3) + 512 * (sch >> 2) + 64 * (skey & 7) + 16 * ((sch & 3) ^ ((skey >> 2) & 3));
        const int qb = 31 - (unit >> 5), b = (unit & 31) >> 1, g = unit & 1, t0 = qb * 64;
        const int ntile = qb >= 16 ? 2 : 1;
        for (int tl = 0; tl < ntile; ++tl) { const bf16* sp = kcb + ((size_t)(b * 2 + g) * 128 + 64 * tl + skey) * 64 + sch * 8;
            *(LAS u32x4*)(L + tl * 8192 + kst) = *(const u32x4*)sp; *(LAS u32x4*)(L + tl * 8192 + vst) = *(const u32x4*)(sp + (vcb - kcb)); }
        int tq[2]; unsigned smask[2]; LAS bf16x8* qfl = (LAS bf16x8*)(F.lds + 106496 + w * 4096) + lane;
        const int hq = 4 * g + (c & 3);
        const float slope2 = exp2f(-(float)(hq + 1)) * LOG2E;
#pragma unroll
        for (int nt = 0; nt < 2; ++nt) { const int tl = 8 * w + 4 * nt + (c >> 2); tq[nt] = t0 + tl;
            const bf16* qp = proj + (size_t)(b * S + tq[nt]) * PP + C_Q + hq * 64 + 8 * g4;
#pragma unroll
            for (int ks = 0; ks < 2; ++ks) { const u32x4 v = *(const u32x4*)(qp + 32 * ks); u32x4 o;
                o.x = pk2(bflo(v.x) * QS, bfhi(v.x) * QS); o.y = pk2(bflo(v.y) * QS, bfhi(v.y) * QS); o.z = pk2(bflo(v.z) * QS, bfhi(v.z) * QS); o.w = pk2(bflo(v.w) * QS, bfhi(v.w) * QS);
                qfl[(nt * 2 + ks) * 64] = __builtin_bit_cast(bf16x8, o); } }
        const bf16* rowb = proj + (size_t)(b * S + skey) * PP + g * 64 + sch * 8;
        u32x4 rk, rv;
        { const bf16* sp = rowb + (size_t)(64 * qb) * PP + C_KWIN; rk = *(const u32x4*)sp; rv = *(const u32x4*)(sp + 128); }
        __syncthreads();
        f32x4 ocm[2][4];
#pragma unroll
        for (int nt = 0; nt < 2; ++nt) {
            const int tlq = 8 * w + 4 * nt + (c >> 2);
            float sc[2][4][4]; float tmax = -1e30f;
            const int nvalid = tq[nt] >= 31 ? ((tq[nt] - 31) >> 4) + 1 : 0;
#pragma unroll
            for (int tl = 0; tl < 2; ++tl) {
                if (tl < ntile) {
                    f32x4 sa[4];
#pragma unroll
                    for (int mt = 0; mt < 4; ++mt) sa[mt] = (f32x4){0.f, 0.f, 0.f, 0.f};
#pragma unroll
                    for (int ks = 0; ks < 2; ++ks)
#pragma unroll
                        for (int mt = 0; mt < 4; ++mt) { const bf16x8 kf = *(const LAS bf16x8*)(L + tl * 8192 + mt * 2048 + kof[ks]); sa[mt] = __builtin_amdgcn_mfma_f32_16x16x32_bf16(kf, qfl[(nt * 2 + ks) * 64], sa[mt], 0, 0, 0); }
#pragma unroll
                    for (int mt = 0; mt < 4; ++mt)
#pragma unroll
                        for (int i = 0; i < 4; ++i) { const int n = 64 * tl + 16 * mt + kbl + i;
                            const float v = n < nvalid ? sa[mt][i] - slope2 * ((float)(tq[nt] - 16 * n) - 15.5f) : -1e30f; sc[tl][mt][i] = v; tmax = fmaxf(tmax, v); }
                } else {
#pragma unroll
                    for (int mt = 0; mt < 4; ++mt)
#pragma unroll
                        for (int i = 0; i < 4; ++i) sc[tl][mt][i] = -1e30f;
                }
            }
            tmax = fmaxf(tmax, __shfl_xor(tmax, 16)); tmax = fmaxf(tmax, __shfl_xor(tmax, 32));
            float ls = 0.f;
#pragma unroll
            for (int tl = 0; tl < 2; ++tl)
#pragma unroll
                for (int mt = 0; mt < 4; ++mt)
#pragma unroll
                    for (int i = 0; i < 4; ++i) { const float p = sc[tl][mt][i] > -1e29f ? __builtin_amdgcn_exp2f(sc[tl][mt][i] - tmax) : 0.f; sc[tl][mt][i] = p; ls += p; }
            ls += __shfl_xor(ls, 16); ls += __shfl_xor(ls, 32);
            const float inv = ls > 0.f ? 1.0f / ls : 0.f;
#pragma unroll
            for (int dt = 0; dt < 4; ++dt) ocm[nt][dt] = (f32x4){0.f, 0.f, 0.f, 0.f};
#pragma unroll
            for (int tl = 0; tl < 2; ++tl) {
                if (tl < ntile) {
#pragma unroll
                    for (int mt = 0; mt < 4; ++mt) {
#pragma unroll
                        for (int i = 0; i < 4; ++i) sc[tl][mt][i] *= inv;
                        float a = sc[tl][mt][0] + sc[tl][mt][1] + sc[tl][mt][2] + 0.5f * sc[tl][mt][3], bb = 0.5f * sc[tl][mt][3];
                        a += __shfl_xor(a, 1); a += __shfl_xor(a, 2); bb += __shfl_xor(bb, 1); bb += __shfl_xor(bb, 2);
                        if ((c & 3) == 0) { const int j = 16 * tl + 4 * mt + 2 * (g4 & 1) + (g4 >> 1); scA[tlq * 32 + j] = a; scB[tlq * 32 + j] = bb; }
                    }
#pragma unroll
                    for (int s = 0; s < 2; ++s) { u32x4 pw; pw.x = pk2(sc[tl][2 * s][0], sc[tl][2 * s][1]); pw.y = pk2(sc[tl][2 * s][2], sc[tl][2 * s][3]); pw.z = pk2(sc[tl][2 * s + 1][0], sc[tl][2 * s + 1][1]); pw.w = pk2(sc[tl][2 * s + 1][2], sc[tl][2 * s + 1][3]);
                        const bf16x8 pf = __builtin_bit_cast(bf16x8, pw);
#pragma unroll
                        for (int dt = 0; dt < 4; ++dt) { const LAS unsigned char* vp = L + 16384 + tl * 8192 + vb + 4096 * s + 512 * (dt >> 1) + vx[dt & 1];
                            const s16x4 lo = __builtin_bit_cast(s16x4, __builtin_amdgcn_ds_read_tr16_b64_v4i16((LAS s16x4*)vp));
                            const s16x4 hi = __builtin_bit_cast(s16x4, __builtin_amdgcn_ds_read_tr16_b64_v4i16((LAS s16x4*)(vp + 2048)));
                            const bf16x8 vf = (bf16x8){lo[0], lo[1], lo[2], lo[3], hi[0], hi[1], hi[2], hi[3]};
                            ocm[nt][dt] = __builtin_amdgcn_mfma_f32_16x16x32_bf16(vf, pf, ocm[nt][dt], 0, 0, 0); } }
                }
            }
            const float sg = sigmoidf_(small[(size_t)(b * S + tq[nt]) * 32 + hq]);
#pragma unroll
            for (int dt = 0; dt < 4; ++dt) ocm[nt][dt] *= sg;
        }
        __syncthreads();
        if (F.tid < 64) { const int tlq = F.tid, cur = qb; unsigned mask;
            if (cur < 8) mask = (1u << (cur + 1)) - 1u;
            else { mask = 1u | (1u << cur);
                float sv[31];
#pragma unroll
                for (int j = 1; j < 31; ++j) sv[j] = j < cur ? scA[tlq * 32 + j] + scB[tlq * 32 + j - 1] : -1.0f;
#pragma unroll
                for (int it = 0; it < 6; ++it) { float best = -1.0f; int bj = 0;
#pragma unroll
                    for (int j = 1; j < 31; ++j) { const bool ok = sv[j] > best; best = ok ? sv[j] : best; bj = ok ? j : bj; }
                    mask |= 1u << bj;
#pragma unroll
                    for (int j = 1; j < 31; ++j) sv[j] = (j == bj) ? -1.0f : sv[j]; }
                mask &= ~1u; mask |= 1u; }
            sml[tlq] = mask; }
        __syncthreads();
        const unsigned mreg = sml[lane];
        unsigned um = mreg;
#pragma unroll
        for (int o = 1; o < 64; o <<= 1) um |= (unsigned)__shfl_xor((int)um, o);
        um = (unsigned)__builtin_amdgcn_readfirstlane((int)um);
        AttnW st; LAS f32x4* owl = (LAS f32x4*)(F.lds + 40960 + w * 8192) + lane;
#pragma unroll
        for (int nt = 0; nt < 2; ++nt) { smask[nt] = sml[8 * w + 4 * nt + (c >> 2)]; st.m[nt] = -1e30f; st.l[nt] = 0.f;
#pragma unroll
            for (int dt = 0; dt < 4; ++dt) { owl[(nt * 4 + dt) * 64] = ocm[nt][dt]; st.o[nt][dt] = (f32x4){0.f, 0.f, 0.f, 0.f}; } }
        int phase = 0, kt = qb, wleft = qb + 1 < 5 ? qb + 1 : 5; unsigned rem = um;
        int buf = 0;
        while (phase != 2) {
            *(LAS u32x4*)(L + buf * 8192 + kst) = rk; *(LAS u32x4*)(L + buf * 8192 + vst) = rv;
            __syncthreads();
            int nphase = phase, nkt = kt;
            if (phase == 0) { --wleft; if (wleft > 0) nkt = kt - 1; else { nphase = 1; nkt = 31 - __builtin_clz(rem); rem &= ~(1u << nkt); } }
            else { if (rem) { nkt = 31 - __builtin_clz(rem); rem &= ~(1u << nkt); } else nphase = 2; }
            if (nphase != 2) { const bf16* sp = rowb + (size_t)(64 * nkt) * PP + (nphase == 0 ? C_KWIN : C_KSLC); rk = *(const u32x4*)sp; rv = *(const u32x4*)(sp + 128); }
            if (phase == 0) attn_tile<0>(kt == qb || kt == qb - 4, st, L + buf * 8192, L + 16384 + buf * 8192, qfl, kof, vb, vx, kt, kbl, t0, tq, smask, slope2);
            else            attn_tile<1>(kt == qb, st, L + buf * 8192, L + 16384 + buf * 8192, qfl, kof, vb, vx, kt, kbl, t0, tq, smask, slope2);
            if (nphase != phase) {
#pragma unroll
                for (int nt = 0; nt < 2; ++nt) {
                    float lt = st.l[nt]; lt += __shfl_xor(lt, 16); lt += __shfl_xor(lt, 32);
                    const size_t tok = (size_t)(b * S + tq[nt]);
                    if (phase == 0) { const float sg = sigmoidf_(small[tok * 32 + 16 + hq]) / lt;
#pragma unroll
                        for (int dt = 0; dt < 4; ++dt) { owl[(nt * 4 + dt) * 64] += st.o[nt][dt] * sg; st.o[nt][dt] = (f32x4){0.f, 0.f, 0.f, 0.f}; }
                        st.m[nt] = -1e30f; st.l[nt] = 0.f; }
                    else { const float sg = sigmoidf_(small[tok * 32 + 8 + hq]) / lt;
#pragma unroll
                        for (int dt = 0; dt < 4; ++dt) { const size_t oi = tok * 1024 + hq * 64 + 16 * dt + 4 * g4;
                            const f32x4 r = owl[(nt * 4 + dt) * 64] + st.o[nt][dt] * sg;
                            u32x2 o2; o2.x = pk2(r[0], r[1]); o2.y = pk2(r[2], r[3]); *(u32x2*)(onsa + oi) = o2; } }
                }
            }
            phase = nphase; kt = nkt; buf ^= 1;
        }
    }
}

__device__ __forceinline__ int sw256(int r, int col) { return r * 256 + ((((col >> 3) ^ (r & 15))) << 4) + (col & 7) * 2; }
__device__ __forceinline__ void ml_gates(Frame& F, const float* small, size_t tok0, int h, LAS float* Fa, LAS float* ia) {
    if (F.wave == 0) {
        const int l = F.lane; const float fb = F.in[18][h];
        const float f0 = small[(tok0 + 2 * l) * 32 + 28 + h] + fb, f1 = small[(tok0 + 2 * l + 1) * 32 + 28 + h] + fb;
        const float a = fminf(f0, 0.f) - log1pf(__expf(-fabsf(f0))), bq = fminf(f1, 0.f) - log1pf(__expf(-fabsf(f1)));
        float s = a + bq;
#pragma unroll
        for (int o = 1; o < 64; o <<= 1) { const float v = __shfl_up(s, o); if (l >= o) s += v; }
        const float pre = s - (a + bq);
        Fa[2 * l] = pre + a; Fa[2 * l + 1] = pre + a + bq;
        ia[2 * l] = small[(tok0 + 2 * l) * 32 + 24 + h]; ia[2 * l + 1] = small[(tok0 + 2 * l + 1) * 32 + 24 + h];
    }
}

__device__ __forceinline__ void p3_mlstate(Frame& F) {
    const bf16* proj = (const bf16*)(F.ws + WS_PROJ); const float* small = (const float*)(F.ws + WS_SMALL);
    bf16* qml = (bf16*)(F.ws + WS_QML); bf16* kml = (bf16*)(F.ws + WS_KML); bf16* vtg = (bf16*)(F.ws + WS_VML);
    const bf16* wqt = (const bf16*)(F.ws + WS_WQT); const bf16* wkt = wqt + 4 * 16384; const bf16* wvt = wqt + 8 * 16384;
    float* cloct = (float*)(F.ws + WS_CLOC); float* nloc = (float*)(F.ws + WS_NLOC); float* mloc = (float*)(F.ws + WS_MLOC); float* flast = (float*)(F.ws + WS_FLAST);
    const float* cw = F.in[13]; const float* cb = F.in[14];
    LAS unsigned char* L = F.lds;
    LAS float* Fa = (LAS float*)(F.lds + 131072); LAS float* ia = Fa + 128; LAS float* wa = ia + 128; LAS float* red = wa + 128;
    const int lane = F.lane, w = F.wave, c = lane & 15, g4 = lane >> 4;
    for (int u = F.bid; u < 1024; u += F.G) {
        const int b = u >> 6, h = (u >> 4) & 3, ch = u & 15, t0 = ch * 128;
        const size_t tok0 = (size_t)b * S + t0;
        __syncthreads();
        for (int it = F.tid; it < 2048; it += NTHREADS) { const int t = it >> 4, c8 = (it & 15) * 8, cc = h * 128 + c8;
            float a[8]; u32x4 xm3 = (u32x4){0u, 0u, 0u, 0u};
#pragma unroll
            for (int i = 0; i < 8; ++i) a[i] = cb[cc + i];
#pragma unroll
            for (int j = 0; j < 4; ++j) { const int tt = t0 + t - 3 + j;
                if (tt >= 0) { const u32x4 xv = *(const u32x4*)(proj + ((size_t)b * S + tt) * PP + C_XM + cc);
                    const f32x4 w0 = *(const f32x4*)(cw + j * 512 + cc), w1 = *(const f32x4*)(cw + j * 512 + cc + 4);
                    a[0] += w0.x * bflo(xv.x); a[1] += w0.y * bfhi(xv.x); a[2] += w0.z * bflo(xv.y); a[3] += w0.w * bfhi(xv.y);
                    a[4] += w1.x * bflo(xv.z); a[5] += w1.y * bfhi(xv.z); a[6] += w1.z * bflo(xv.w); a[7] += w1.w * bfhi(xv.w);
                    if (j == 3) xm3 = xv; } }
#pragma unroll
            for (int i = 0; i < 8; ++i) a[i] = a[i] * __builtin_amdgcn_rcpf(1.0f + __expf(-a[i]));
            u32x4 o; o.x = pk2(a[0], a[1]); o.y = pk2(a[2], a[3]); o.z = pk2(a[4], a[5]); o.w = pk2(a[6], a[7]);
            *(LAS u32x4*)(L + sw256(t, c8)) = xm3; *(LAS u32x4*)(L + 32768 + sw256(t, c8)) = o; }
        ml_gates(F, small, tok0, h, Fa, ia);
        if (F.wave == 0) { LDS_WAIT(); const float FL = Fa[127]; float m = fmaxf(FL - Fa[2 * lane] + ia[2 * lane], FL - Fa[2 * lane + 1] + ia[2 * lane + 1]);
#pragma unroll
            for (int o = 1; o < 64; o <<= 1) m = fmaxf(m, __shfl_xor(m, o));
            wa[2 * lane] = __expf(FL - Fa[2 * lane] + ia[2 * lane] - m); wa[2 * lane + 1] = __expf(FL - Fa[2 * lane + 1] + ia[2 * lane + 1] - m);
            if (lane == 0) { mloc[u] = m; flast[u] = FL; } }
        __syncthreads();
        {
            const size_t wo = (size_t)(h * 128 + 16 * w + c) * 128 + 8 * g4;
            const size_t ro0 = ((size_t)(b * 4 + h) * S + t0) * 128 + 16 * w + 4 * g4; const int e = 16 * w + 4 * g4;
            f32x4 acc[8];
#pragma unroll
            for (int tt = 0; tt < 8; ++tt) acc[tt] = (f32x4){0.f, 0.f, 0.f, 0.f};
#pragma unroll
            for (int ks = 0; ks < 4; ++ks) { const bf16x8 wf = *(const bf16x8*)(wqt + wo + 32 * ks);
#pragma unroll
                for (int tt = 0; tt < 8; ++tt) acc[tt] = __builtin_amdgcn_mfma_f32_16x16x32_bf16(wf, *(const LAS bf16x8*)(L + 32768 + sw256(16 * tt + c, 32 * ks + 8 * g4)), acc[tt], 0, 0, 0); }
#pragma unroll
            for (int tt = 0; tt < 8; ++tt) { u32x2 qv; qv.x = pk2(acc[tt][0], acc[tt][1]); qv.y = pk2(acc[tt][2], acc[tt][3]); *(u32x2*)(qml + ro0 + (size_t)(16 * tt + c) * 128) = qv; }
#pragma unroll
            for (int tt = 0; tt < 8; ++tt) acc[tt] = (f32x4){0.f, 0.f, 0.f, 0.f};
#pragma unroll
            for (int ks = 0; ks < 4; ++ks) { const bf16x8 wf = *(const bf16x8*)(wkt + wo + 32 * ks);
#pragma unroll
                for (int tt = 0; tt < 8; ++tt) acc[tt] = __builtin_amdgcn_mfma_f32_16x16x32_bf16(wf, *(const LAS bf16x8*)(L + 32768 + sw256(16 * tt + c, 32 * ks + 8 * g4)), acc[tt], 0, 0, 0); }
#pragma unroll
            for (int tt = 0; tt < 8; ++tt) { const int t = 16 * tt + c; const float wt = wa[t];
                const float k0 = acc[tt][0] * 0.08838834764831845f, k1 = acc[tt][1] * 0.08838834764831845f, k2 = acc[tt][2] * 0.08838834764831845f, k3 = acc[tt][3] * 0.08838834764831845f;
                u32x2 kv; kv.x = pk2(k0, k1); kv.y = pk2(k2, k3); *(u32x2*)(kml + ro0 + (size_t)t * 128) = kv;
                *(LAS bf16*)(L + 65536 + sw256(e + 0, t)) = (bf16)f2bf(k0 * wt); *(LAS bf16*)(L + 65536 + sw256(e + 1, t)) = (bf16)f2bf(k1 * wt);
                *(LAS bf16*)(L + 65536 + sw256(e + 2, t)) = (bf16)f2bf(k2 * wt); *(LAS bf16*)(L + 65536 + sw256(e + 3, t)) = (bf16)f2bf(k3 * wt); }
#pragma unroll
            for (int tt = 0; tt < 8; ++tt) acc[tt] = (f32x4){0.f, 0.f, 0.f, 0.f};
#pragma unroll
            for (int ks = 0; ks < 4; ++ks) { const bf16x8 wf = *(const bf16x8*)(wvt + wo + 32 * ks);
#pragma unroll
                for (int tt = 0; tt < 8; ++tt) acc[tt] = __builtin_amdgcn_mfma_f32_16x16x32_bf16(*(const LAS bf16x8*)(L + sw256(16 * tt + c, 32 * ks + 8 * g4)), wf, acc[tt], 0, 0, 0); }
#pragma unroll
            for (int tt = 0; tt < 8; ++tt) { u32x2 vv; vv.x = pk2(acc[tt][0], acc[tt][1]); vv.y = pk2(acc[tt][2], acc[tt][3]); *(LAS u32x2*)(L + 98304 + sw256(16 * w + c, 16 * tt + 4 * g4)) = vv; }
        }
        __syncthreads();
        {
            f32x4 ac[8];
#pragma unroll
            for (int et = 0; et < 8; ++et) ac[et] = (f32x4){0.f, 0.f, 0.f, 0.f};
#pragma unroll
            for (int ks = 0; ks < 4; ++ks) {
                const bf16x8 kf = *(const LAS bf16x8*)(L + 65536 + sw256(16 * w + c, 32 * ks + 8 * g4));
#pragma unroll
                for (int et = 0; et < 8; ++et) { const bf16x8 vf = *(const LAS bf16x8*)(L + 98304 + sw256(16 * et + c, 32 * ks + 8 * g4)); ac[et] = __builtin_amdgcn_mfma_f32_16x16x32_bf16(kf, vf, ac[et], 0, 0, 0); }
            }
#pragma unroll
            for (int et = 0; et < 8; ++et) *(f32x4*)(cloct + (size_t)u * 16384 + (size_t)(16 * et + c) * 128 + 16 * w + 4 * g4) = ac[et];
        }
        if (F.tid < 128) { float s = 0.f;
#pragma unroll
            for (int k = 0; k < 16; ++k) { const u32x4 v = *(const LAS u32x4*)(L + 65536 + F.tid * 256 + k * 16); s += (bflo(v.x) + bfhi(v.x)) + (bflo(v.y) + bfhi(v.y)) + (bflo(v.z) + bfhi(v.z)) + (bflo(v.w) + bfhi(v.w)); }
            nloc[u * 128 + F.tid] = s; }
#pragma unroll
        for (int j = 0; j < 4; ++j) { const int id = F.tid + NTHREADS * j, e = id >> 4, ci = id & 15;
            *(u32x4*)(vtg + (size_t)u * 16384 + e * 128 + ci * 8) = *(const LAS u32x4*)(L + 98304 + e * 256 + ((ci ^ (e & 15)) << 4)); }
    }
}

__device__ __forceinline__ void p4_mlscan(Frame& F) {
    const float* cloct = (const float*)(F.ws + WS_CLOC); const float* nloc = (const float*)(F.ws + WS_NLOC); const float* mloc = (const float*)(F.ws + WS_MLOC); const float* flast = (const float*)(F.ws + WS_FLAST);
    bf16* cint = (bf16*)(F.ws + WS_CIN); float* nin = (float*)(F.ws + WS_NIN); float* min_ = (float*)(F.ws + WS_MIN);
    const int gtid = F.bid * NTHREADS + F.tid, gsz = F.G * NTHREADS;
    for (int idx = gtid; idx < 64 * (8192 + 64); idx += gsz) {
        const int bh = idx / (8192 + 64), de = (idx - bh * (8192 + 64)) * 2;
        float C0 = 0.f, C1 = 0.f, m = 0.f;
        for (int cch = 0; cch < 16; ++cch) { const int u = bh * 16 + cch;
            f32x2 loc;
            if (de < 16384) { *(unsigned*)(cint + (size_t)u * 16384 + de) = pk2(C0, C1); loc = *(const f32x2*)(cloct + (size_t)u * 16384 + de); if (de == 0) min_[u] = m; }
            else { *(f32x2*)(nin + u * 128 + (de - 16384)) = (f32x2){C0, C1}; loc = *(const f32x2*)(nloc + u * 128 + (de - 16384)); }
            const float FL = flast[u], ml = mloc[u], mn = fmaxf(FL + m, ml), dA = __expf(FL + m - mn), dB = __expf(ml - mn);
            C0 = dA * C0 + dB * loc.x; C1 = dA * C1 + dB * loc.y; m = mn; }
    }
}

__device__ __forceinline__ void p5_mlout(Frame& F) {
    const bf16* proj = (const bf16*)(F.ws + WS_PROJ); const float* small = (const float*)(F.ws + WS_SMALL);
    const bf16* qml = (const bf16*)(F.ws + WS_QML); const bf16* kml = (const bf16*)(F.ws + WS_KML); const bf16* vtg = (const bf16*)(F.ws + WS_VML);
    const bf16* cint = (const bf16*)(F.ws + WS_CIN); const float* nin = (const float*)(F.ws + WS_NIN); const float* min_ = (const float*)(F.ws + WS_MIN);
    bf16* yml = (bf16*)(F.ws + WS_OY) + 512;
    LAS unsigned char* L = F.lds;
    LAS float* Fa = (LAS float*)(F.lds + 98304); LAS float* ia = Fa + 128; LAS float* pm = ia + 128;
    const int lane = F.lane, w = F.wave, c = lane & 15, g4 = lane >> 4;
    for (int u = F.bid; u < 1024; u += F.G) {
        const int b = u >> 6, h = (u >> 4) & 3, ch = u & 15, t0 = ch * 128;
        const size_t tok0 = (size_t)b * S + t0; const size_t bhrow = ((size_t)(b * 4 + h) * S + t0);
        __syncthreads();
#pragma unroll
        for (int j = 0; j < 4; ++j) { const int id = F.tid + NTHREADS * j, r = id >> 4, ci = id & 15;
            *(LAS u32x4*)(L + r * 256 + ((ci ^ (r & 15)) << 4)) = *(const u32x4*)(kml + (bhrow + r) * 128 + ci * 8);
            *(LAS u32x4*)(L + 32768 + r * 256 + ((ci ^ (r & 15)) << 4)) = *(const u32x4*)(vtg + (size_t)u * 16384 + r * 128 + ci * 8);
            *(LAS u32x4*)(L + 65536 + r * 256 + ((ci ^ (r & 15)) << 4)) = *(const u32x4*)(cint + (size_t)u * 16384 + r * 128 + ci * 8); }
        ml_gates(F, small, tok0, h, Fa, ia);
        __syncthreads();
        if (F.wave == 0) {
            const float g0 = ia[2 * lane] - Fa[2 * lane], g1 = ia[2 * lane + 1] - Fa[2 * lane + 1];
            float s = fmaxf(g0, g1);
#pragma unroll
            for (int o = 1; o < 64; o <<= 1) { const float v = __shfl_up(s, o); if (lane >= o) s = fmaxf(s, v); }
            const float prev = __shfl_up(s, 1);
            pm[2 * lane] = lane > 0 ? fmaxf(prev, g0) : g0; pm[2 * lane + 1] = s;
            ia[2 * lane] = g0; ia[2 * lane + 1] = g1; }
        __syncthreads();
        const int t = 16 * w + c;
        const float mm = min_[u], mref = fmaxf(mm, pm[t]), wi = __expf(mm - mref);
        bf16x8 qf[4]; float qn = 0.f;
#pragma unroll
        for (int ks = 0; ks < 4; ++ks) { const u32x4 qv = *(const u32x4*)(qml + (bhrow + t) * 128 + 32 * ks + 8 * g4); qf[ks] = __builtin_bit_cast(bf16x8, qv);
            const f32x4 n0 = *(const f32x4*)(nin + u * 128 + 32 * ks + 8 * g4), n1 = *(const f32x4*)(nin + u * 128 + 32 * ks + 8 * g4 + 4);
            qn += bflo(qv.x) * n0.x + bfhi(qv.x) * n0.y + bflo(qv.y) * n0.z + bfhi(qv.y) * n0.w + bflo(qv.z) * n1.x + bfhi(qv.z) * n1.y + bflo(qv.w) * n1.z + bfhi(qv.w) * n1.w; }
        qn += __shfl_xor(qn, 16); qn += __shfl_xor(qn, 32);
        f32x4 aI[8], aP[8];
#pragma unroll
        for (int et = 0; et < 8; ++et) { aI[et] = (f32x4){0.f, 0.f, 0.f, 0.f}; aP[et] = aI[et]; }
#pragma unroll
        for (int ks = 0; ks < 4; ++ks)
            {
#pragma unroll
              for (int et = 0; et < 8; ++et) aI[et] = __builtin_amdgcn_mfma_f32_16x16x32_bf16(*(const LAS bf16x8*)(L + 65536 + sw256(16 * et + c, 32 * ks + 8 * g4)), qf[ks], aI[et], 0, 0, 0); __builtin_amdgcn_sched_barrier(0); }
        float den = 0.f;
        for (int ss = 0; 2 * ss <= w; ++ss) {
            float p[2][4];
#pragma unroll
            for (int hh = 0; hh < 2; ++hh) { const int st = 2 * ss + hh;
                if (st <= w) { f32x4 sa = (f32x4){0.f, 0.f, 0.f, 0.f};
#pragma unroll
                    for (int ks = 0; ks < 4; ++ks) sa = __builtin_amdgcn_mfma_f32_16x16x32_bf16(*(const LAS bf16x8*)(L + sw256(16 * st + c, 32 * ks + 8 * g4)), qf[ks], sa, 0, 0, 0);
#pragma unroll
                    for (int i = 0; i < 4; ++i) { const int s = 16 * st + 4 * g4 + i; const float v = s <= t ? sa[i] * __expf(ia[s] - mref) : 0.f; p[hh][i] = v; den += v; } }
                else {
#pragma unroll
                    for (int i = 0; i < 4; ++i) p[hh][i] = 0.f; } }
            u32x4 pw; pw.x = pk2(p[0][0], p[0][1]); pw.y = pk2(p[0][2], p[0][3]); pw.z = pk2(p[1][0], p[1][1]); pw.w = pk2(p[1][2], p[1][3]);
            const bf16x8 pf = __builtin_bit_cast(bf16x8, pw);
#pragma unroll
            for (int et = 0; et < 8; ++et) { const u32x2 lo = *(const LAS u32x2*)(L + 32768 + sw256(16 * et + c, 32 * ss + 4 * g4)), hi = *(const LAS u32x2*)(L + 32768 + sw256(16 * et + c, 32 * ss + 16 + 4 * g4));
                const u32x4 vw = (u32x4){lo.x, lo.y, hi.x, hi.y};
                aP[et] = __builtin_amdgcn_mfma_f32_16x16x32_bf16(__builtin_bit_cast(bf16x8, vw), pf, aP[et], 0, 0, 0); }
        }
        den += __shfl_xor(den, 16); den += __shfl_xor(den, 32);
        den += wi * qn;
        const float mt = Fa[t] + mref, dd = 1.0f / fmaxf(fabsf(den), __expf(-mt));
        float s1 = 0.f;
#pragma unroll
        for (int et = 0; et < 8; ++et)
#pragma unroll
            for (int i = 0; i < 4; ++i) { const float v = (aP[et][i] + wi * aI[et][i]) * dd; aP[et][i] = v; s1 += v; }
        s1 += __shfl_xor(s1, 16); s1 += __shfl_xor(s1, 32);
        const float mu = s1 * (1.0f / 128.0f); float s2 = 0.f;
#pragma unroll
        for (int et = 0; et < 8; ++et)
#pragma unroll
            for (int i = 0; i < 4; ++i) { const float v = aP[et][i] - mu; aP[et][i] = v; s2 += v * v; }
        s2 += __shfl_xor(s2, 16); s2 += __shfl_xor(s2, 32);
        const float rstd = rsqrtf(s2 * (1.0f / 128.0f) + 1e-5f);
        const size_t tok = tok0 + t;
#pragma unroll
        for (int et = 0; et < 8; ++et) { const int col = h * 128 + 16 * et + 4 * g4;
            const unsigned ow8 = *(const unsigned*)((const unsigned char*)(F.ws + WS_GATE8) + tok * GP + G_OPRE + col); const f32x2 o01 = __builtin_amdgcn_cvt_pk_f32_fp8((int)ow8, false), o23 = __builtin_amdgcn_cvt_pk_f32_fp8((int)ow8, true); const f32x4 ng = *(const f32x4*)(F.in[19] + col);
            u32x2 y; y.x = pk2(sigmoidf_(o01.x) * aP[et][0] * rstd * ng.x, sigmoidf_(o01.y) * aP[et][1] * rstd * ng.y);
            y.y = pk2(sigmoidf_(o23.x) * aP[et][2] * rstd * ng.z, sigmoidf_(o23.y) * aP[et][3] * rstd * ng.w);
            *(u32x2*)(yml + tok * 1024 + col) = y; }
    }
}

__device__ __forceinline__ void p9_route(Frame& F, const bool dup) {
    const bf16* x1 = (const bf16*)(F.ws + WS_OY); const float* mod = (const float*)(F.ws + WS_MOD); const float* g2 = F.in[23]; const float* rb = F.in[25];
    const bf16* rwh = (const bf16*)(F.ws + WS_RWT); const bf16* rwl = rwh + 32 * 1024;
    bf16* h2 = (bf16*)(F.ws + WS_XN);
    int* re = (int*)(F.ws + (dup ? WS_ACT : WS_RE)); float* rwt = (float*)(F.ws + (dup ? WS_ACT + MiB : WS_RW)); int* rs = (int*)(F.ws + (dup ? WS_ACT + 2 * MiB : WS_RS)); unsigned* cnt = (unsigned*)(F.ws + WS_CTL) + (dup ? 16 : 0);
    const int gw = F.bid * NWAVES + F.wave, NGW = F.G * NWAVES, lane = F.lane, c = lane & 15, g4 = lane >> 4;
    LAS unsigned* lcnt = (LAS unsigned*)F.lds;
    for (int grp = gw; grp < T / 16; grp += NGW) {
        const int tkn = grp * 16 + c, b = tkn >> 11;
        const bf16* xr = x1 + (size_t)tkn * D + 8 * g4; const float* sh = mod + (size_t)b * 6144 + 3 * 1024 + 8 * g4; const float* scp = mod + (size_t)b * 6144 + 4 * 1024 + 8 * g4;
        float ss = 0.f;
#pragma unroll 8
        for (int ks = 0; ks < 32; ++ks) { const u32x4 xv = *(const u32x4*)(xr + 32 * ks); const f32x4 a = (f32x4){bflo(xv.x), bfhi(xv.x), bflo(xv.y), bfhi(xv.y)}, bq = (f32x4){bflo(xv.z), bfhi(xv.z), bflo(xv.w), bfhi(xv.w)};
            ss += (a.x * a.x + a.y * a.y) + (a.z * a.z + a.w * a.w) + (bq.x * bq.x + bq.y * bq.y) + (bq.z * bq.z + bq.w * bq.w); }
        ss += __shfl_xor(ss, 16); ss += __shfl_xor(ss, 32);
        const float rsq = rsqrtf(ss * (1.0f / D) + 1e-5f);
        f32x4 acc[2]; acc[0] = (f32x4){0.f, 0.f, 0.f, 0.f}; acc[1] = acc[0];
#pragma unroll 4
        for (int ks = 0; ks < 32; ++ks) {
            float y[8];
            { const u32x4 xv = *(const u32x4*)(xr + 32 * ks); const f32x4 a = (f32x4){bflo(xv.x), bfhi(xv.x), bflo(xv.y), bfhi(xv.y)}, bq = (f32x4){bflo(xv.z), bfhi(xv.z), bflo(xv.w), bfhi(xv.w)};
              const f32x4 ga = *(const f32x4*)(g2 + 32 * ks + 8 * g4), gb = *(const f32x4*)(g2 + 32 * ks + 8 * g4 + 4);
              const f32x4 sa = *(const f32x4*)(scp + 32 * ks), sb = *(const f32x4*)(scp + 32 * ks + 4), ha = *(const f32x4*)(sh + 32 * ks), hb = *(const f32x4*)(sh + 32 * ks + 4);
#pragma unroll
              for (int i = 0; i < 4; ++i) { y[i] = a[i] * rsq * ga[i] * (1.0f + sa[i]) + ha[i]; y[4 + i] = bq[i] * rsq * gb[i] * (1.0f + sb[i]) + hb[i]; } }
            unsigned hi[8], lo[8];
#pragma unroll
            for (int i = 0; i < 8; ++i) { hi[i] = f2bf(y[i]); lo[i] = f2bf(y[i] - __builtin_bit_cast(float, hi[i] << 16)); }
            const u32x4 yhw = (u32x4){hi[0] | (hi[1] << 16), hi[2] | (hi[3] << 16), hi[4] | (hi[5] << 16), hi[6] | (hi[7] << 16)};
            const u32x4 ylw = (u32x4){lo[0] | (lo[1] << 16), lo[2] | (lo[3] << 16), lo[4] | (lo[5] << 16), lo[6] | (lo[7] << 16)};
            { u32x2 y8; y8.x = pk4_fp8(y[0], y[1], y[2], y[3]); y8.y = pk4_fp8(y[4], y[5], y[6], y[7]); *(u32x2*)((unsigned char*)h2 + (size_t)tkn * D + 32 * ks + 8 * g4) = y8; }
            const bf16x8 yh = __builtin_bit_cast(bf16x8, yhw), yl = __builtin_bit_cast(bf16x8, ylw);
#pragma unroll
            for (int et = 0; et < 2; ++et) { const size_t wo = (size_t)(16 * et + c) * 1024 + 32 * ks + 8 * g4;
                const bf16x8 wh = *(const bf16x8*)(rwh + wo), wl = *(const bf16x8*)(rwl + wo);
                acc[et] = __builtin_amdgcn_mfma_f32_16x16x32_bf16(wh, yh, acc[et], 0, 0, 0);
                acc[et] = __builtin_amdgcn_mfma_f32_16x16x32_bf16(wl, yh, acc[et], 0, 0, 0);
                acc[et] = __builtin_amdgcn_mfma_f32_16x16x32_bf16(wh, yl, acc[et], 0, 0, 0); }
        }
        float lg[32];
#pragma unroll
        for (int gs = 0; gs < 4; ++gs)
#pragma unroll
            for (int et = 0; et < 2; ++et)
#pragma unroll
                for (int i = 0; i < 4; ++i) { const int e = 16 * et + 4 * gs + i; lg[e] = __shfl(acc[et][i], c + 16 * gs) + rb[e]; }
        int te[4]; float tv[4]; unsigned used = 0u;
#pragma unroll
        for (int k = 0; k < 4; ++k) { float best = -3.0e38f; int bi = 0;
#pragma unroll
            for (int e = 0; e < 32; ++e) { const bool ok = !((used >> e) & 1u) && lg[e] > best; best = ok ? lg[e] : best; bi = ok ? e : bi; }
            te[k] = bi; tv[k] = best; used |= 1u << bi; }
        const float e1 = __expf(tv[1] - tv[0]), e2 = __expf(tv[2] - tv[0]), e3 = __expf(tv[3] - tv[0]); const float inv = 1.0f / (1.0f + e1 + e2 + e3);
        { const int ek = g4 == 0 ? te[0] : g4 == 1 ? te[1] : g4 == 2 ? te[2] : te[3];
          const float wk = (g4 == 0 ? 1.0f : g4 == 1 ? e1 : g4 == 2 ? e2 : e3) * inv;
          __syncthreads();
          if (F.tid < 32) lcnt[F.tid] = 0u;
          __syncthreads();
          const unsigned rnk = __hip_atomic_fetch_add(lcnt + ek, 1u, __ATOMIC_RELAXED, __HIP_MEMORY_SCOPE_WORKGROUP);
          __syncthreads();
          if (F.tid < 32) lcnt[32 + F.tid] = atomicAdd(cnt + F.tid * 32, lcnt[F.tid]);
          __syncthreads();
          const unsigned slot = lcnt[32 + ek] + rnk;
          re[tkn * 4 + g4] = ek; rwt[tkn * 4 + g4] = wk; rs[tkn * 4 + g4] = (int)slot; }
    }
}

__device__ __forceinline__ void p10_gather(Frame& F) {
    const unsigned* cnt = (const unsigned*)(F.ws + WS_CTL);
    const int* re = (const int*)(F.ws + WS_RE); const int* rs = (const int*)(F.ws + WS_RS); int* dest = (int*)(F.ws + WS_DEST); int* blke = (int*)(F.ws + WS_BLKE);
    int* rowidx = (int*)(F.ws + WS_ROWIDX);
    LAS int* off = (LAS int*)F.lds;
    __syncthreads();
    if (F.tid == 0) { int o = 0; for (int e = 0; e < 32; ++e) { const int c = (int)__hip_atomic_load(cnt + e * 32, __ATOMIC_RELAXED, __HIP_MEMORY_SCOPE_AGENT); const int p = (c + 255) & ~255; off[e] = o; off[32 + e] = c; off[64 + e] = p; o += p; } off[96] = o; }
    __syncthreads();
    if (F.bid == 0) { const int nblk = off[96] >> 8;
        for (int i = F.tid; i < nblk; i += NTHREADS) { int e = 0; for (int k = 1; k < 32; ++k) if (i * 256 >= off[k]) e = k; blke[i] = e; }
        if (F.tid == 0) blke[1000] = nblk; }
    const int gtid = F.bid * NTHREADS + F.tid, gsz = F.G * NTHREADS;
    for (int i = gtid; i < T * 4; i += gsz) { const int dr = off[re[i]] + rs[i]; dest[i] = dr; rowidx[dr] = i >> 2; }
    for (int i = gtid; i < 32 * 256; i += gsz) { const int e = i >> 8, r = i & 255; if (off[32 + e] + r < off[64 + e]) rowidx[off[e] + off[32 + e] + r] = 0; }
}

__device__ __forceinline__ void p13_final(Frame& F, const bool dup) {
    const float* mod = (const float*)(F.ws + WS_MOD); const float* fg = F.in[30];
    const float* rwt = (const float*)(F.ws + WS_RW); const int* dest = (const int*)(F.ws + WS_DEST); const bf16* ypad = (const bf16*)(F.ws + WS_PROJ);
    const int gw = F.bid * NWAVES + F.wave, NGW = F.G * NWAVES, lane = F.lane;
    for (int grp = gw; grp < T / 16; grp += NGW) {
        const int dl = dest[grp * 64 + lane]; const float wl = rwt[grp * 64 + lane];
        const int b = (grp * 16) >> 11; const float* g2 = mod + (size_t)b * 6144 + 5 * 1024;
#pragma unroll 4
        for (int tk = 0; tk < 16; ++tk) {
            const int tkn = grp * 16 + tk; const bf16* xr = (const bf16*)(F.ws + WS_OY) + (size_t)tkn * D; float* xo = (dup ? (float*)(F.ws + WS_ACT) : F.out) + (size_t)tkn * D;
            float acc[16];
#pragma unroll
            for (int i = 0; i < 16; ++i) acc[i] = 0.f;
#pragma unroll
            for (int k = 0; k < 4; ++k) { const int dr = __shfl(dl, 4 * tk + k); const float w = __shfl(wl, 4 * tk + k); const u32x4* yp = (const u32x4*)(ypad + (size_t)dr * D);
#pragma unroll
                for (int j = 0; j < 2; ++j) { const u32x4 y = yp[64 * j + lane];
                    acc[8 * j + 0] += w * bflo(y.x); acc[8 * j + 1] += w * bfhi(y.x); acc[8 * j + 2] += w * bflo(y.y); acc[8 * j + 3] += w * bfhi(y.y);
                    acc[8 * j + 4] += w * bflo(y.z); acc[8 * j + 5] += w * bfhi(y.z); acc[8 * j + 6] += w * bflo(y.w); acc[8 * j + 7] += w * bfhi(y.w); } }
            float ss = 0.f;
#pragma unroll
            for (int j = 0; j < 2; ++j) { const int d0 = (64 * j + lane) * 8; const u32x4 xw = *(const u32x4*)(xr + d0);
#pragma unroll
                for (int q = 0; q < 2; ++q) { const f32x4 xv = q == 0 ? (f32x4){bflo(xw.x), bfhi(xw.x), bflo(xw.y), bfhi(xw.y)} : (f32x4){bflo(xw.z), bfhi(xw.z), bflo(xw.w), bfhi(xw.w)}; const f32x4 gv = *(const f32x4*)(g2 + d0 + 4 * q);
#pragma unroll
                    for (int i = 0; i < 4; ++i) { const float y = xv[i] + gv[i] * acc[8 * j + 4 * q + i]; acc[8 * j + 4 * q + i] = y; ss += y * y; } } }
            const float rsq = rsqrtf(wave_sum(ss) * (1.0f / D) + 1e-5f);
#pragma unroll
            for (int j = 0; j < 2; ++j) { const int d0 = (64 * j + lane) * 8;
#pragma unroll
                for (int q = 0; q < 2; ++q) { const f32x4 gv = *(const f32x4*)(fg + d0 + 4 * q);
                    *(f32x4*)(xo + d0 + 4 * q) = (f32x4){acc[8 * j + 4 * q] * rsq * gv.x, acc[8 * j + 4 * q + 1] * rsq * gv.y, acc[8 * j + 4 * q + 2] * rsq * gv.z, acc[8 * j + 4 * q + 3] * rsq * gv.w}; } }
        }
    }
}

#define XB_TMO      128
#define XB_XCNT(j)  (256  + 64 * (j))
#define XB_XSUB(j)  (1280 + 64 * (j))
#define XB_XGEN(j)  (2304 + 64 * (j))
#define XB_TOP      3328
#define XB_TOPGEN   3392
#define XCD_BAR_WORDS 3456
#define XB_SPIN_CAP (1u << 18)
__device__ __forceinline__ unsigned xb_ld(unsigned* p)              { return __hip_atomic_load(p, __ATOMIC_RELAXED, __HIP_MEMORY_SCOPE_AGENT); }
__device__ __forceinline__ unsigned xb_add(unsigned* p, unsigned v) { return __hip_atomic_fetch_add(p, v, __ATOMIC_RELAXED, __HIP_MEMORY_SCOPE_AGENT); }
__device__ __forceinline__ unsigned xb_xcc_id() { return (unsigned)__builtin_amdgcn_s_getreg((3 << 11) | 20) & 0xFu; }
#define XB_SPIN(cond, bar) do { unsigned _sp = 0; while (cond) { __builtin_amdgcn_s_sleep(1); \
    if ((++_sp & 255u) == 0u) { if (xb_ld(&(bar)[XB_TMO])) break; if (_sp > XB_SPIN_CAP) { atomicAdd(&(bar)[XB_TMO], 1u); break; } } } } while (0)
struct XcdBarrier { unsigned* bar; unsigned x; volatile LAS unsigned* st; };
__device__ __forceinline__ XcdBarrier xcd_barrier_post(unsigned* bar, volatile LAS unsigned* st) {
    XcdBarrier b; b.bar = bar; b.x = xb_xcc_id(); b.st = st;
    if (threadIdx.x == 0) (void)xb_add(&bar[XB_XCNT(b.x)], 1u);
    return b;
}
__device__ __forceinline__ void xcd_barrier_complete(unsigned* bar, unsigned x, unsigned& nloc, unsigned& nx) {
    const unsigned G = gridDim.x * gridDim.y * gridDim.z;
    unsigned sum, cnt, mine, sp = 0u;
    for (;;) {
        sum = 0u; cnt = 0u; mine = 0u;
#pragma unroll
        for (unsigned j = 0; j < 16; ++j) { const unsigned c = xb_ld(&bar[XB_XCNT(j)]); sum += c; cnt += (c > 0u) ? 1u : 0u; mine = (j == x) ? c : mine; }
        if (sum == G) break;
        __builtin_amdgcn_s_sleep(1);
        if ((++sp & 255u) == 0u) { if (xb_ld(&bar[XB_TMO])) break; if (sp > XB_SPIN_CAP) { atomicAdd(&bar[XB_TMO], 1u); break; } }
    }
    nloc = mine > 0u ? mine : 1u; nx = cnt > 0u ? cnt : 1u;
}
__device__ __forceinline__ void xcd_barrier(const XcdBarrier& b) {
    asm volatile("s_waitcnt vmcnt(0)" ::: "memory");
    __syncthreads();
    if (threadIdx.x == 0) {
        unsigned* bar = b.bar;
        __builtin_amdgcn_s_waitcnt(0);
        unsigned nloc = b.st[0], nx = b.st[1];
        if (nloc == 0u) { xcd_barrier_complete(bar, b.x, nloc, nx); b.st[0] = nloc; b.st[1] = nx; }
        const unsigned old = xb_add(&bar[XB_XSUB(b.x)], 1u);
        const unsigned gen = old / nloc;
        if (old + 1u == (gen + 1u) * nloc) {
            __builtin_amdgcn_fence(__ATOMIC_RELEASE, "agent");
            asm volatile("s_waitcnt vmcnt(0)" ::: "memory");
            const unsigned og = xb_add(&bar[XB_TOP], 1u);
            const unsigned tg = og / nx;
            if (og + 1u == (tg + 1u) * nx) xb_add(&bar[XB_TOPGEN], 1u);
            else XB_SPIN(xb_ld(&bar[XB_TOPGEN]) == tg, bar);
            __builtin_amdgcn_fence(__ATOMIC_ACQUIRE, "agent");
            xb_add(&bar[XB_XGEN(b.x)], 1u);
            asm volatile("s_waitcnt vmcnt(0)" ::: "memory");
        } else {
            XB_SPIN(xb_ld(&bar[XB_XGEN(b.x)]) == gen, bar);
            __builtin_amdgcn_fence(__ATOMIC_ACQUIRE, "agent");
            asm volatile("s_waitcnt vmcnt(0)" ::: "memory");
        }
    }
    __syncthreads();
}

#ifndef PH_MASK
#define PH_MASK 0xFFFFFFFFu
#endif
#define PH(k) ((PH_MASK >> (k)) & 1u)
#ifndef DUP_MASK
#define DUP_MASK 0u
#endif
#define DUP(k) ((DUP_MASK >> (k)) & 1u)
#define REFRESH() do { F.tid = opaque_i(threadIdx.x); F.lane = F.tid & 63; F.wave = __builtin_amdgcn_readfirstlane(F.tid >> 6); } while (0)
__global__ void __launch_bounds__(NTHREADS, 2) fwd_mega(Args args) {
    extern __shared__ __attribute__((aligned(16))) unsigned char lds_raw[];
    cg::grid_group grid = cg::this_grid();
    Frame F;
    F.lds = (LAS unsigned char*)lds_raw; F.ws = args.ws; F.in = args.in; F.out = args.out;
    F.tid = threadIdx.x; F.lane = F.tid & 63; F.wave = __builtin_amdgcn_readfirstlane(F.tid >> 6); F.G = gridDim.x; F.bid = blockIdx.x;
    unsigned char* ws = args.ws;
    volatile LAS unsigned* bst = (volatile LAS unsigned*)(F.lds + LDS_BYTES - 64);
    if (F.tid < 16) bst[F.tid] = 0u;
    __syncthreads();
    const XcdBarrier xbar = xcd_barrier_post((unsigned*)(ws + WS_CTL) + 1024, bst);
#define GSYNC() do { xcd_barrier(xbar); REFRESH(); } while (0)

    if (PH(0)) { p0_adaln(F); __syncthreads(); p0_cpe(F); }
    if (DUP(0)) { __syncthreads(); p0_adaln(F); __syncthreads(); p0_cpe(F); }
    if (__builtin_expect(args.ws == nullptr, 0)) grid.sync();
    GSYNC();
    if (PH(1)) p1_prologue(F);
    if (DUP(1)) { __syncthreads(); p1_prologue(F); }
    GSYNC();
    if (PH(2)) {
        { pg8::Gemm g{(const bf16*)(ws + WS_XN), (const bf16*)(ws + WS_WIN), 1024}; pg8::StaticOrder So; So.init(T, NPROJ_A, F.G, F.bid);
          pg8::EpiProj E{(bf16*)(ws + WS_PROJ), (float*)(ws + WS_SMALL), (const float*)(ws + WS_BIN), (unsigned char*)(ws + WS_GATE8), 0, -1, 1000};
          pg8::gemm_phase<pg8::EpiProj, pg8::StaticOrder, true, true>(F.lds, g, So, E);
          if (DUP(2)) { __syncthreads(); pg8::gemm_phase<pg8::EpiProj, pg8::StaticOrder, true, true>(F.lds, g, So, E); } }
        __syncthreads();
        { pg8::Gemm g{(const bf16*)(ws + WS_OY), (const bf16*)(ws + WS_WIN + 4 * MiB), 1024}; pg8::StaticOrder So; So.init(T, NPROJ_B, F.G, F.bid);
          pg8::EpiProj E{(bf16*)(ws + WS_PROJ) + NPROJ_A, (float*)(ws + WS_SMALL), (const float*)(ws + WS_BIN) + NPROJ_A, (unsigned char*)(ws + WS_GATE8), NPROJ_A, 5, 6};
          pg8::gemm_phase<pg8::EpiProj, pg8::StaticOrder, true, true, true>(F.lds, g, So, E);
          if (DUP(20)) { __syncthreads(); pg8::gemm_phase<pg8::EpiProj, pg8::StaticOrder, true, true, true>(F.lds, g, So, E); } }
    }
    GSYNC();
    if (PH(3)) { p3_compress(F); __syncthreads(); }
    if (DUP(3)) { p3_compress(F); __syncthreads(); }
    REFRESH(); if (PH(4)) { p3_mlstate(F); __syncthreads(); }
    if (DUP(4)) { p3_mlstate(F); __syncthreads(); }
    GSYNC();
    REFRESH(); if (PH(7)) p4_mlscan(F);
    if (DUP(7)) p4_mlscan(F);
    GSYNC();
    if (PH(8)) { p5_attn(F, 0); __syncthreads(); }
    if (DUP(8)) { p5_attn(F, 1); __syncthreads(); }
    REFRESH(); if (PH(9)) p5_mlout(F);
    if (DUP(9)) { __syncthreads(); p5_mlout(F); }
    GSYNC();
    if (DUP(21)) { GSYNC(); GSYNC(); GSYNC(); GSYNC(); }
    if (PH(11)) {
        pg8::StaticOrder So; So.init(T, 1024, F.G, F.bid);
        for (int rep7 = 0; rep7 < (DUP(11) ? 2 : 1); ++rep7) {
        { pg8::Gemm g{(const bf16*)(ws + WS_OY), (const bf16*)(ws + WS_WPA), 1024};
          pg8::EpiMix2 E{(bf16*)(ws + WS_XN), (const unsigned char*)(ws + WS_GATE8)};
          pg8::gemm_phase<pg8::EpiMix2, pg8::StaticOrder, true, true>(F.lds, g, So, E); }
        __syncthreads(); }
    }
    GSYNC();
    if (PH(12)) {
        pg8::Gemm g{(const bf16*)(ws + WS_XN), (const bf16*)(ws + WS_WOUT), 1024}; pg8::StaticOrder So; So.init(T, 1024, F.G, F.bid);
        pg8::EpiWout E{F.in[0], (bf16*)(ws + WS_OY), (const float*)(ws + WS_MOD) + 2 * 1024};
        pg8::gemm_phase<pg8::EpiWout, pg8::StaticOrder, true, true, true>(F.lds, g, So, E);
        if (DUP(12)) { __syncthreads(); pg8::gemm_phase<pg8::EpiWout, pg8::StaticOrder, true, true, true>(F.lds, g, So, E); }
        if (DUP(19)) { __syncthreads(); pg8::EpiNull En{(float*)(ws + WS_ACT)}; pg8::gemm_phase<pg8::EpiNull, pg8::StaticOrder, true, true, true>(F.lds, g, So, En); }
    }
    GSYNC();
    if (PH(13)) p9_route(F, false);
    if (DUP(13)) p9_route(F, true);
    GSYNC();
    if (PH(14)) p10_gather(F);
    if (DUP(14)) { __syncthreads(); p10_gather(F); }
    GSYNC();
    if (PH(15)) {
        const int* blkg = (const int*)(ws + WS_BLKE); const int nblk = __builtin_amdgcn_readfirstlane(blkg[1000]);
        LAS int* blke = (LAS int*)(F.lds + 134144);
        for (int i = F.tid; i < nblk; i += NTHREADS) blke[i] = blkg[i];
        __syncthreads();
        { pg8::MoeOrderG Mo; Mo.blk_e = blke; Mo.rows = (const int*)(ws + WS_ROWIDX); Mo.nblk = nblk; Mo.x = F.bid & 7; Mo.y = F.bid >> 3; Mo.ny = F.G >> 3; Mo.nN = 8; Mo.nPerE = 2048;
          pg8::Gemm g{(const bf16*)(ws + WS_XN), (const bf16*)(ws + WS_WUP), 1024};
          pg8::EpiSwiglu E{(bf16*)(ws + WS_ACT), F.in[27]};
          pg8::gemm_phase<pg8::EpiSwiglu, pg8::MoeOrderG, true, true, true>(F.lds, g, Mo, E);
          if (DUP(17)) { __syncthreads(); pg8::gemm_phase<pg8::EpiSwiglu, pg8::MoeOrderG, true, true, true>(F.lds, g, Mo, E); } }
        pg8::MoeOrder Mo; Mo.blk_e = blke; Mo.rows = nullptr; Mo.nblk = nblk; Mo.x = F.bid & 7; Mo.y = F.bid >> 3; Mo.ny = F.G >> 3;
        GSYNC();
        { Mo.nN = 4; Mo.nPerE = 1024;
          pg8::Gemm g{(const bf16*)(ws + WS_ACT), (const bf16*)(ws + WS_WDN), 1024};
          pg8::EpiDown E{(bf16*)(ws + WS_PROJ), F.in[29]};
          pg8::gemm_phase<pg8::EpiDown, pg8::MoeOrder, true, true, true>(F.lds, g, Mo, E);
          if (DUP(18)) { __syncthreads(); pg8::gemm_phase<pg8::EpiDown, pg8::MoeOrder, true, true, true>(F.lds, g, Mo, E); } }
    }
    GSYNC();
    if (PH(16)) p13_final(F, false);
    if (DUP(16)) p13_final(F, true);
}

extern "C" void kernel_launch(void* const* d_in, const int* in_sizes, int n_in, void* d_out, int out_size, void* d_ws, size_t ws_size, hipStream_t stream) {
    static int grid = 0;
    if (grid == 0) {
        if (n_in != 31 || out_size != T * D || ws_size < WS_END) { fprintf(stderr, "kernel_launch: unexpected problem (n_in %d out %d ws %zu)\n", n_in, out_size, ws_size); grid = -1; return; }
        int dev = 0, cus = 0, per_cu = 0;
        if (hipGetDevice(&dev) != hipSuccess || hipDeviceGetAttribute(&cus, hipDeviceAttributeMultiprocessorCount, dev) != hipSuccess) { grid = -1; return; }
        if (hipFuncSetAttribute((const void*)fwd_mega, hipFuncAttributeMaxDynamicSharedMemorySize, LDS_BYTES) != hipSuccess) { fprintf(stderr, "kernel_launch: hipFuncSetAttribute failed\n"); grid = -1; return; }
        if (hipOccupancyMaxActiveBlocksPerMultiprocessor(&per_cu, (const void*)fwd_mega, NTHREADS, LDS_BYTES) != hipSuccess || per_cu < 1) { fprintf(stderr, "kernel_launch: occupancy query says %d\n", per_cu); (void)hipGetLastError(); grid = -1; return; }
        grid = cus;
        if (grid % 8 != 0) grid -= grid % 8;
        fprintf(stderr, "kernel_launch: cus %d per_cu %d grid %d ws %zu\n", cus, per_cu, grid, ws_size);
    }
    if (grid < 0) return;
    (void)hipMemsetAsync((char*)d_ws + WS_CTL, 0, 32768, stream);
    Args a{};
    for (int i = 0; i < 31; ++i) a.in[i] = (const float*)d_in[i];
    a.out = (float*)d_out; a.ws = (unsigned char*)d_ws;
    void* kargs[] = {&a};
    hipError_t e = hipLaunchCooperativeKernel((const void*)fwd_mega, dim3(grid), dim3(NTHREADS), kargs, LDS_BYTES, stream);
    if (e != hipSuccess) fprintf(stderr, "kernel_launch: cooperative launch failed: %s\n", hipGetErrorString(e));
}
```
